# Optimizing an MI355X kernel written in HIP

```python
import jax, jax.numpy as jnp
from jax import lax
import numpy as np

D_MODEL = 1024
BATCH = 8
SEQ = 4096
DEPTH = 1

SB_HEADS = 8
SB_HEAD_DIM = 64
SB_WIDTH = SB_HEADS * SB_HEAD_DIM
Q_BLOCK = 128
HG_HEADS = 4
HG_KEY_DIM = 128
HG_VAL_DIM = 128
HG_KEY_WIDTH = HG_HEADS * HG_KEY_DIM
HG_WIDTH = HG_HEADS * HG_VAL_DIM
HG_CHUNK = 64
MIX_WIDTH = SB_WIDTH + HG_WIDTH
FFN_HIDDEN = -(-8 * D_MODEL // (3 * 256)) * 256
IN_SIZES = (SB_WIDTH, SB_WIDTH, SB_WIDTH, HG_KEY_WIDTH, HG_KEY_WIDTH,
            HG_WIDTH, HG_WIDTH, D_MODEL, D_MODEL)
IN_WIDTH = sum(IN_SIZES)
EPS = 1e-6

kernel_name = "stickbreaking_hgrn2_gated_hybrid_block"


def rms_norm(x, g):
    xf = x.astype(jnp.float32)
    y = xf * lax.rsqrt(jnp.mean(xf * xf, axis=-1, keepdims=True) + EPS)
    return (y * g.astype(jnp.float32)).astype(x.dtype)


def split_cols(t, sizes):
    idx, acc = [], 0
    for s in sizes[:-1]:
        acc += s
        idx.append(acc)
    return jnp.split(t, idx, axis=-1)


def stick_breaking_attention(q, k, v):
    seq = q.shape[2]
    scale = SB_HEAD_DIM ** -0.5
    outs = []
    for blk in range(seq // Q_BLOCK):
        t0 = blk * Q_BLOCK
        end = t0 + Q_BLOCK
        qb, kb, vb = q[:, :, t0:end], k[:, :, :end], v[:, :, :end]
        z = jnp.einsum('bhtd,bhsd->bhts', qb, kb).astype(jnp.float32) * scale
        t_idx = t0 + jnp.arange(Q_BLOCK)[:, None]
        s_idx = jnp.arange(end)[None, :]
        causal = s_idx < t_idx
        sp = jnp.where(causal, jax.nn.softplus(z), 0.0)
        rest = lax.cumsum(sp, axis=3, reverse=True) - sp
        w = jnp.where(causal, jnp.exp(jax.nn.log_sigmoid(z) - rest), 0.0)
        outs.append(jnp.einsum('bhts,bhsd->bhtd', w.astype(vb.dtype), vb))
    return jnp.concatenate(outs, axis=2)


def hgrn2_mixer(q_in, f_in, i_in, g_in, lb, norm_g):
    B, S, _ = q_in.shape
    n_chunks = S // HG_CHUNK
    f = lb + (1.0 - lb) * jax.nn.sigmoid(f_in.astype(jnp.float32))
    log_f = jnp.log(f)
    key = 1.0 - f
    q = jax.nn.silu(q_in.astype(jnp.float32))
    val = i_in.astype(jnp.float32)

    def to_chunks(t):
        return t.reshape(B, n_chunks, HG_CHUNK, HG_HEADS, -1).transpose(1, 0, 3, 2, 4)

    mask = jnp.tril(jnp.ones((HG_CHUNK, HG_CHUNK), dtype=bool))[:, :, None]

    def step(state, xs):
        qc, kc, vc, gc = xs
        b = jnp.cumsum(gc, axis=2)
        diff = b[:, :, :, None, :] - b[:, :, None, :, :]
        decay = jnp.exp(jnp.where(mask, diff, -jnp.inf))
        attn = jnp.einsum('bhtk,bhsk,bhtsk->bhts', qc, kc, decay)
        o_intra = jnp.einsum('bhts,bhsv->bhtv', attn, vc)
        o_inter = jnp.einsum('bhtk,bhkv->bhtv', qc * jnp.exp(b), state)
        b_last = b[:, :, -1:, :]
        new_state = jnp.exp(b_last[:, :, 0, :])[..., None] * state + \
            jnp.einsum('bhsk,bhsv->bhkv', kc * jnp.exp(b_last - b), vc)
        return new_state, o_intra + o_inter

    s0 = jnp.zeros((B, HG_HEADS, HG_KEY_DIM, HG_VAL_DIM), jnp.float32)
    _, o = lax.scan(step, s0, (to_chunks(q), to_chunks(key), to_chunks(val), to_chunks(log_f)))
    o = o.transpose(1, 0, 3, 2, 4).reshape(B, S, HG_HEADS, HG_VAL_DIM)
    o = rms_norm(o, norm_g)
    gate = jax.nn.silu(g_in.astype(jnp.float32)).reshape(B, S, HG_HEADS, HG_VAL_DIM)
    return (o * gate).reshape(B, S, HG_WIDTH).astype(q_in.dtype)


def hybrid_layer(x, norm1_g, w_in, q_norm_g, k_norm_g, lb, hg_norm_g, w_branch, w_out,
                 norm2_g, w_gate, w_up, w_down):
    B, S, _ = x.shape
    xn = rms_norm(x, norm1_g)
    proj = xn @ w_in
    q_sb, k_sb, v_sb, q_hg, f_hg, i_hg, g_hg, gate_sb, gate_hg = split_cols(proj, IN_SIZES)

    def heads(t):
        return t.reshape(B, S, SB_HEADS, SB_HEAD_DIM).transpose(0, 2, 1, 3)

    q = rms_norm(heads(q_sb), q_norm_g)
    k = rms_norm(heads(k_sb), k_norm_g)
    o_sb = stick_breaking_attention(q, k, heads(v_sb))
    o_sb = o_sb.transpose(0, 2, 1, 3).reshape(B, S, SB_WIDTH)

    o_hg = hgrn2_mixer(q_hg, f_hg, i_hg, g_hg, lb, hg_norm_g)

    y_sb = o_sb @ w_branch[:SB_WIDTH]
    y_hg = o_hg @ w_branch[SB_WIDTH:]
    mixed = jax.nn.sigmoid(gate_sb) * y_sb + jax.nn.sigmoid(gate_hg) * y_hg
    h = x + mixed @ w_out

    hn = rms_norm(h, norm2_g)
    ffn = (jax.nn.silu(hn @ w_gate) * (hn @ w_up)) @ w_down
    return h + ffn


def setup_inputs(seed: int = 0) -> dict:
    key = jax.random.key(seed)
    ks = jax.random.split(key, 13)
    n = jax.random.normal
    f32 = jnp.float32
    return {
        "x": n(ks[0], (BATCH, SEQ, D_MODEL), f32),
        "norm1_g": 1.0 + 0.02 * n(ks[1], (DEPTH, D_MODEL), f32),
        "w_in": n(ks[2], (DEPTH, D_MODEL, IN_WIDTH), f32) * D_MODEL ** -0.5,
        "q_norm_g": 1.0 + 0.02 * n(ks[3], (DEPTH, SB_HEAD_DIM), f32),
        "k_norm_g": 1.0 + 0.02 * n(ks[4], (DEPTH, SB_HEAD_DIM), f32),
        "lb_table": 0.5 * n(ks[5], (DEPTH + 1, HG_KEY_WIDTH), f32),
        "hg_norm_g": 1.0 + 0.02 * n(ks[6], (DEPTH, HG_VAL_DIM), f32),
        "w_branch": n(ks[7], (DEPTH, MIX_WIDTH, D_MODEL), f32) * SB_WIDTH ** -0.5,
        "w_out": n(ks[8], (DEPTH, D_MODEL, D_MODEL), f32) * D_MODEL ** -0.5,
        "norm2_g": 1.0 + 0.02 * n(ks[9], (DEPTH, D_MODEL), f32),
        "w_ffn_gate": n(ks[10], (DEPTH, D_MODEL, FFN_HIDDEN), f32) * D_MODEL ** -0.5,
        "w_ffn_up": n(ks[11], (DEPTH, D_MODEL, FFN_HIDDEN), f32) * D_MODEL ** -0.5,
        "w_ffn_down": n(ks[12], (DEPTH, FFN_HIDDEN, D_MODEL), f32) * FFN_HIDDEN ** -0.5,
    }


def reference(x, norm1_g, w_in, q_norm_g, k_norm_g, lb_table, hg_norm_g, w_branch, w_out,
              norm2_g, w_ffn_gate, w_ffn_up, w_ffn_down):
    lower_bounds = jnp.cumsum(jax.nn.softmax(lb_table.astype(jnp.float32), axis=0), axis=0)
    h = x
    for layer in range(DEPTH):
        h = hybrid_layer(h, norm1_g[layer], w_in[layer], q_norm_g[layer], k_norm_g[layer],
                         lower_bounds[layer], hg_norm_g[layer], w_branch[layer], w_out[layer],
                         norm2_g[layer], w_ffn_gate[layer], w_ffn_up[layer], w_ffn_down[layer])
    return h
```

```cpp
#include <hip/hip_runtime.h>
#include <cstdio>
#include <cstdint>
namespace pg8 {
#define PG8_LAS __attribute__((address_space(3)))
typedef unsigned short bf16_t;
typedef short bf16x8 __attribute__((ext_vector_type(8)));
typedef float f32x4 __attribute__((ext_vector_type(4)));
typedef unsigned u32x4 __attribute__((ext_vector_type(4)));
constexpr int BM = 256, BK = 64, HALF = 128, HTB = HALF * BK * 2  , STAGE_BYTES = 8 * HTB, NXCD = 8, WGM = 8;

__host__ __device__ __forceinline__ int lds_byte(int r, int c) { const int st = (r >> 4) * 2 + (c >> 5), rr = r & 15, cc = c & 31, ob = rr * 64 + cc * 2; return st * 1024 + (ob ^ (((ob >> 9) & 1) << 5)); }
__host__ __device__ __forceinline__ void stage_rc(int b, int& R, int& C) { const int st = b / 1024, sb = b % 1024, swz = sb ^ (((sb >> 9) & 1) << 5); R = (st >> 1) * 16 + swz / 64; C = (st & 1) * 32 + (swz % 64) / 2; }
__host__ __device__ __forceinline__ int perm32(int rho) { const int n = rho >> 4, i = rho & 15; return 8 * (i >> 2) + 4 * n + (i & 3); }

struct Unit { int pm, pn; };
struct Gemm { const bf16_t* A; const bf16_t* Bt; int M, N, K, lda, ldb; };

struct StaticOrder {
    int nM, nN, nwg, G, c;
    __host__ __device__ void init(int M, int N, int G_, int c_) { nM = M / BM; nN = N / BM; nwg = nM * nN; G = G_; c = c_; }
    __host__ __device__ bool next(int i, Unit& u) const {
        const long L = (long)i * G + c; if (L >= nwg) return false;
        int wgid = (int)L; { const int q = nwg / NXCD, r = nwg % NXCD, xcd = wgid % NXCD, off = wgid / NXCD; wgid = (xcd < r ? xcd * (q + 1) : r * (q + 1) + (xcd - r) * q) + off; }
        const int nig = WGM * nN, gid = wgid / nig, fm = gid * WGM, gsz = (nM - fm) < WGM ? (nM - fm) : WGM;
        u.pm = fm + ((wgid % nig) % gsz); u.pn = (wgid % nig) / gsz; return true;
    }
    __device__ __forceinline__ void a_ready(const Unit&) const {}
    __device__ __forceinline__ void done(const Unit&) const {}
};

typedef float f32x2_t __attribute__((ext_vector_type(2))); typedef __bf16 bf16x2_t __attribute__((ext_vector_type(2)));
__device__ __forceinline__ unsigned cvt_pk_bf16(float lo, float hi) { const f32x2_t v = {lo, hi}; const bf16x2_t b = __builtin_convertvector(v, bf16x2_t); return __builtin_bit_cast(unsigned, b); }
typedef unsigned u32x2 __attribute__((ext_vector_type(2)));
__device__ __forceinline__ float ex2(float x) { return __builtin_amdgcn_exp2f(x); }
__device__ __forceinline__ float sigm(float x) { return __builtin_amdgcn_rcpf(1.0f + ex2(x * -1.4426950408889634f)); }
__device__ __forceinline__ u32x4 pack8(const f32x4 a, const f32x4 b) { u32x4 w; w.x = cvt_pk_bf16(a[0], a[1]); w.y = cvt_pk_bf16(a[2], a[3]); w.z = cvt_pk_bf16(b[0], b[1]); w.w = cvt_pk_bf16(b[2], b[3]); return w; }
__device__ __forceinline__ f32x4 bf4_lo(const u32x4 w) { return (f32x4){__uint_as_float(w.x << 16), __uint_as_float(w.x & 0xffff0000u), __uint_as_float(w.y << 16), __uint_as_float(w.y & 0xffff0000u)}; }
__device__ __forceinline__ f32x4 bf4_hi(const u32x4 w) { return (f32x4){__uint_as_float(w.z << 16), __uint_as_float(w.z & 0xffff0000u), __uint_as_float(w.w << 16), __uint_as_float(w.w & 0xffff0000u)}; }

struct EpiProj {
    static constexpr bool PERM = true, AFTER_DRAIN = false;
    bf16_t *Q, *Kq, *V, *HQ, *HI, *HGG, *GS, *GH; float* LOGF; const float *gq, *gk, *lbt; float qscale, eps;
    __device__ __forceinline__ void operator()(const f32x4 (&acc)[2][2][4][2], const Unit& u, int wr, int wc, int fr, int fq) const {
        const int pn = u.pn, row0 = u.pm * BM + wr * 64 + fr;
        if (pn < 4) {
            const bool isq = pn < 2; const int head = 4 * (pn & 1) + wc;
            bf16_t* base = (isq ? Q : Kq) + head * 64 + 8 * fq; const float* g = (isq ? gq : gk) + 8 * fq; const float sc = isq ? qscale : 1.0f;
            f32x4 gv[2][2];
#pragma unroll
            for (int bj = 0; bj < 2; ++bj)
#pragma unroll
                for (int n = 0; n < 2; ++n) gv[bj][n] = *(const f32x4*)(g + 32 * bj + 4 * n) * sc;
#pragma unroll
            for (int ai = 0; ai < 2; ++ai)
#pragma unroll
                for (int m = 0; m < 4; ++m) {
                    float ss = 0.f;
#pragma unroll
                    for (int bj = 0; bj < 2; ++bj)
#pragma unroll
                        for (int n = 0; n < 2; ++n) { const f32x4 x = acc[ai][bj][m][n]; ss += (x[0] * x[0] + x[1] * x[1]) + (x[2] * x[2] + x[3] * x[3]); }
                    ss += __shfl_xor(ss, 16); ss += __shfl_xor(ss, 32);
                    const float rs = 1.0f / sqrtf(ss * (1.0f / 64.0f) + eps);
                    bf16_t* rowp = base + (size_t)(row0 + ai * HALF + m * 16) * 512;
#pragma unroll
                    for (int bj = 0; bj < 2; ++bj) *(u32x4*)(rowp + 32 * bj) = pack8(acc[ai][bj][m][0] * rs * gv[bj][0], acc[ai][bj][m][1] * rs * gv[bj][1]);
                }
        } else if (pn == 8 || pn == 9) {
            const int cb = 256 * (pn - 8) + 32 * wc + 8 * fq;
            f32x4 lb[2][2];
#pragma unroll
            for (int bj = 0; bj < 2; ++bj)
#pragma unroll
                for (int n = 0; n < 2; ++n) { const f32x4 t0 = *(const f32x4*)(lbt + cb + 128 * bj + 4 * n), t1 = *(const f32x4*)(lbt + 512 + cb + 128 * bj + 4 * n);
#pragma unroll
                    for (int j = 0; j < 4; ++j) lb[bj][n][j] = sigm(t0[j] - t1[j]); }
#pragma unroll
            for (int ai = 0; ai < 2; ++ai)
#pragma unroll
                for (int m = 0; m < 4; ++m) { float* rowp = LOGF + (size_t)(row0 + ai * HALF + m * 16) * 512 + cb;
#pragma unroll
                    for (int bj = 0; bj < 2; ++bj)
#pragma unroll
                        for (int n = 0; n < 2; ++n) { f32x4 o; const f32x4 x = acc[ai][bj][m][n];
#pragma unroll
                            for (int j = 0; j < 4; ++j) { const float l = lb[bj][n][j]; o[j] = __logf(l + (1.0f - l) * sigm(x[j])); }
                            *(f32x4*)(rowp + 128 * bj + 4 * n) = o; } }
        } else {
            const int cw = 32 * wc + 8 * fq;
            if (pn < 6) store_tile<0>(acc, V, 512, row0, 256 * (pn - 4) + cw);
            else if (pn < 8) store_tile<1>(acc, HQ, 512, row0, 256 * (pn - 6) + cw);
            else if (pn < 12) store_tile<0>(acc, HI, 512, row0, 256 * (pn - 10) + cw);
            else if (pn < 14) store_tile<1>(acc, HGG, 512, row0, 256 * (pn - 12) + cw);
            else if (pn < 18) store_tile<2>(acc, GS, 1024, row0, 256 * (pn - 14) + cw);
            else store_tile<2>(acc, GH, 1024, row0, 256 * (pn - 18) + cw);
        }
    }
    template <int MODE  > static __device__ __forceinline__ void store_tile(const f32x4 (&acc)[2][2][4][2], bf16_t* ob, int ld, int row0, int cb) {
#pragma unroll
        for (int ai = 0; ai < 2; ++ai)
#pragma unroll
            for (int m = 0; m < 4; ++m) { bf16_t* rowp = ob + (size_t)(row0 + ai * HALF + m * 16) * ld + cb;
#pragma unroll
                for (int bj = 0; bj < 2; ++bj) { f32x4 v[2];
#pragma unroll
                    for (int n = 0; n < 2; ++n) { const f32x4 x = acc[ai][bj][m][n];
                        if (MODE == 0) v[n] = x;
                        else {
#pragma unroll
                            for (int j = 0; j < 4; ++j) { const float s = sigm(x[j]); v[n][j] = MODE == 1 ? x[j] * s : s; } } }
                    *(u32x4*)(rowp + 128 * bj) = pack8(v[0], v[1]); } }
    }
};
struct EpiGate {
    static constexpr bool PERM = true, AFTER_DRAIN = false;
    const bf16_t* gate; const bf16_t* addin; bf16_t* out;
    __device__ __forceinline__ void operator()(const f32x4 (&acc)[2][2][4][2], const Unit& u, int wr, int wc, int fr, int fq) const {
        const int row0 = u.pm * BM + wr * 64 + fr, col0 = u.pn * BM + wc * 32 + 8 * fq;
#pragma unroll
        for (int ai = 0; ai < 2; ++ai)
#pragma unroll
            for (int m = 0; m < 4; ++m) { const size_t off = (size_t)(row0 + ai * HALF + m * 16) * 1024 + col0;
#pragma unroll
                for (int bj = 0; bj < 2; ++bj) { const u32x4 gw = *(const u32x4*)(gate + off + bj * HALF);
                    f32x4 v0 = acc[ai][bj][m][0] * bf4_lo(gw), v1 = acc[ai][bj][m][1] * bf4_hi(gw);
                    if (addin) { const u32x4 aw = *(const u32x4*)(addin + off + bj * HALF); v0 += bf4_lo(aw); v1 += bf4_hi(aw); }
                    *(u32x4*)(out + off + bj * HALF) = pack8(v0, v1); } }
    }
};
struct EpiRes {
    static constexpr bool PERM = false, AFTER_DRAIN = false;
    const float* base; float* out;
    __device__ __forceinline__ void operator()(const f32x4 (&acc)[2][2][4][2], const Unit& u, int wr, int wc, int fr, int fq) const {
        const int row0 = u.pm * BM + wr * 64 + fr, col0 = u.pn * BM + wc * 32 + 4 * fq;
#pragma unroll
        for (int ai = 0; ai < 2; ++ai)
#pragma unroll
            for (int m = 0; m < 4; ++m) { const size_t off = (size_t)(row0 + ai * HALF + m * 16) * 1024 + col0;
#pragma unroll
                for (int bj = 0; bj < 2; ++bj)
#pragma unroll
                    for (int n = 0; n < 2; ++n) { const f32x4 b = *(const f32x4*)(base + off + bj * HALF + n * 16); *(f32x4*)(out + off + bj * HALF + n * 16) = b + acc[ai][bj][m][n]; } }
    }
};
struct EpiSwiglu {
    static constexpr bool PERM = true, AFTER_DRAIN = false;
    bf16_t* out; int ldc;
    __device__ __forceinline__ void operator()(const f32x4 (&acc)[2][2][4][2], const Unit& u, int wr, int wc, int fr, int fq) const {
        const int row0 = u.pm * BM + wr * 64 + fr, col0 = u.pn * HALF + wc * 32 + 8 * fq;
#pragma unroll
        for (int ai = 0; ai < 2; ++ai)
#pragma unroll
            for (int m = 0; m < 4; ++m) { f32x4 v[2];
#pragma unroll
                for (int n = 0; n < 2; ++n) { const f32x4 gt = acc[ai][0][m][n], up = acc[ai][1][m][n];
#pragma unroll
                    for (int j = 0; j < 4; ++j) v[n][j] = gt[j] * sigm(gt[j]) * up[j]; }
                *(u32x4*)(out + (size_t)(row0 + ai * HALF + m * 16) * ldc + col0) = pack8(v[0], v[1]); }
    }
};
template <class Epi, class Sched, bool ALIGN_EPI = false, bool SP2 = false>
__device__ __forceinline__ void gemm_phase(PG8_LAS unsigned char* lds, const Gemm g, const Sched& S, const Epi& E) {
    const int tid = threadIdx.x, wid = __builtin_amdgcn_readfirstlane(tid >> 6), lane = tid & 63, wr = wid >> 2, wc = wid & 3, fr = lane & 15, fq = lane >> 4;
    const int K = g.K, nt = K / BK;
    unsigned voffA[2], voffB[2];
#pragma unroll
    for (int i = 0; i < 2; ++i) { int R, C; stage_rc(tid * 16 + i * 8192, R, C); const int Rb = Epi::PERM ? ((R & ~31) + perm32(R & 31)) : R;
        voffA[i] = (unsigned)(R * g.lda + C) * 2u; voffB[i] = (unsigned)(Rb * g.ldb + C) * 2u; }
    const size_t kstep = (size_t)(BK * 2);
    const size_t hstepA = (size_t)HALF * g.lda * 2, hstepB = (size_t)HALF * g.ldb * 2;
    const size_t tstepA = 2 * hstepA, tstepB = 2 * hstepB;
    const unsigned ldsw = (unsigned)wid * 1024u;
    const int aoff = lds_byte(wr * 64 + fr, fq * 8), boff = lds_byte(wc * 32 + fr, fq * 8);
#define PG8_SA(b, h) (((b) * 2 + (h)) * HTB)
#define PG8_SB(b, h) ((4 + (b) * 2 + (h)) * HTB)
#define PG8_STAGE(bufoff, gbase, voff) do { _Pragma("unroll") for (int _i = 0; _i < 2; ++_i) \
        __builtin_amdgcn_global_load_lds((const unsigned*)((const char*)(gbase) + (voff)[_i]), (PG8_LAS unsigned*)(lds + (bufoff) + ldsw + _i * 8192), 16, 0, 0); } while (0)
#define PG8_LDA(dst, b, h) do { _Pragma("unroll") for (int m = 0; m < 4; ++m) _Pragma("unroll") for (int k = 0; k < 2; ++k) dst[m][k] = *(const PG8_LAS bf16x8*)(lds + PG8_SA(b, h) + aoff + m * 2048 + k * 1024); } while (0)
#define PG8_LDB(dst, b, h) do { _Pragma("unroll") for (int n = 0; n < 2; ++n) _Pragma("unroll") for (int k = 0; k < 2; ++k) dst[n][k] = *(const PG8_LAS bf16x8*)(lds + PG8_SB(b, h) + boff + n * 2048 + k * 1024); } while (0)
#define PG8_MMA(ai, bj, At, Bt) do { __builtin_amdgcn_s_setprio(1); _Pragma("unroll") for (int m = 0; m < 4; ++m) _Pragma("unroll") for (int n = 0; n < 2; ++n) _Pragma("unroll") for (int k = 0; k < 2; ++k) \
        acc[ai][bj][m][n] = __builtin_amdgcn_mfma_f32_16x16x32_bf16(Bt[n][k], At[m][k], acc[ai][bj][m][n], 0, 0, 0); __builtin_amdgcn_s_setprio(0); } while (0)
#define PG8_WAIT_V(n) asm volatile("s_waitcnt vmcnt(" #n ")" ::: "memory")
#define PG8_WAIT_L(n) asm volatile("s_waitcnt lgkmcnt(" #n ")" ::: "memory")
#define PG8_BAR __builtin_amdgcn_s_barrier()
#define PG8_SCHED __builtin_amdgcn_sched_barrier(0)
    Unit cur, nxt; int ui = 0;
    if (!S.next(0, cur)) return;
    f32x4 acc[2][2][4][2];
#pragma unroll
    for (int a = 0; a < 2; ++a)
#pragma unroll
        for (int b = 0; b < 2; ++b)
#pragma unroll
            for (int m = 0; m < 4; ++m)
#pragma unroll
                for (int n = 0; n < 2; ++n) acc[a][b][m][n] = (f32x4){0.f, 0.f, 0.f, 0.f};
    bf16x8 At[4][2], B0[2][2], B1[2][2];
    const char* cA = (const char*)g.A + (size_t)cur.pm * tstepA; const char* cB = (const char*)g.Bt + (size_t)cur.pn * tstepB;
    S.a_ready(cur);
    if constexpr (SP2) {
        PG8_STAGE(PG8_SB(0, 0), cB, voffB); PG8_STAGE(PG8_SB(0, 1), cB + hstepB, voffB); PG8_STAGE(PG8_SA(0, 0), cA, voffA); PG8_STAGE(PG8_SA(0, 1), cA + hstepA, voffA);
        if (wr == 1) PG8_BAR;
        PG8_WAIT_V(2); PG8_BAR;
        PG8_STAGE(PG8_SB(1, 0), cB + kstep, voffB); PG8_STAGE(PG8_SA(1, 0), cA + kstep, voffA); PG8_STAGE(PG8_SB(1, 1), cB + hstepB + kstep, voffB);
        PG8_WAIT_V(6); PG8_BAR;
    } else {
        PG8_STAGE(PG8_SB(0, 0), cB, voffB); PG8_STAGE(PG8_SA(0, 0), cA, voffA); PG8_STAGE(PG8_SB(0, 1), cB + hstepB, voffB); PG8_STAGE(PG8_SA(0, 1), cA + hstepA, voffA);
        if (wr == 1) PG8_BAR;
        PG8_WAIT_V(4); PG8_BAR;
        PG8_STAGE(PG8_SB(1, 0), cB + kstep, voffB); PG8_STAGE(PG8_SA(1, 0), cA + kstep, voffA); PG8_STAGE(PG8_SB(1, 1), cB + hstepB + kstep, voffB);
        PG8_WAIT_V(6); PG8_BAR;
    }
    for (;;) {
        const bool has_next = S.next(ui + 1, nxt);
        const char* nA = has_next ? (const char*)g.A + (size_t)nxt.pm * tstepA : cA; const char* nB = has_next ? (const char*)g.Bt + (size_t)nxt.pn * tstepB : cB;
        for (int t = 0; t < nt; t += 2) {
            const bool last = (t == nt - 2);
            const char* a1 = cA + (size_t)(t + 1) * kstep;
            const char* a2 = last ? nA : cA + (size_t)(t + 2) * kstep; const char* b2 = last ? nB : cB + (size_t)(t + 2) * kstep;
            const char* a3 = a2 + kstep; const char* b3 = b2 + kstep;
            if (last && has_next) S.a_ready(nxt);
            if constexpr (SP2) {
            PG8_LDB(B0, 0, 0); PG8_LDB(B1, 0, 1); PG8_SCHED; PG8_LDA(At, 0, 0); PG8_STAGE(PG8_SA(1, 1), a1 + hstepA, voffA);
            PG8_WAIT_V(8); PG8_WAIT_L(0); PG8_BAR; PG8_MMA(0, 0, At, B0); PG8_MMA(0, 1, At, B1); PG8_BAR; PG8_SCHED;
            PG8_LDA(At, 0, 1); PG8_STAGE(PG8_SB(0, 0), b2, voffB); PG8_STAGE(PG8_SB(0, 1), b2 + hstepB, voffB); PG8_STAGE(PG8_SA(0, 0), a2, voffA);
            PG8_WAIT_V(8); PG8_WAIT_L(0); PG8_BAR; PG8_MMA(1, 0, At, B0); PG8_MMA(1, 1, At, B1); PG8_BAR; PG8_SCHED;
            PG8_LDB(B0, 1, 0); PG8_LDB(B1, 1, 1); PG8_SCHED; PG8_LDA(At, 1, 0); PG8_STAGE(PG8_SA(0, 1), a2 + hstepA, voffA);
            PG8_WAIT_V(8); PG8_WAIT_L(0); PG8_BAR; PG8_MMA(0, 0, At, B0); PG8_MMA(0, 1, At, B1); PG8_BAR; PG8_SCHED;
            PG8_LDA(At, 1, 1); PG8_STAGE(PG8_SB(1, 0), b3, voffB); PG8_STAGE(PG8_SB(1, 1), b3 + hstepB, voffB); PG8_STAGE(PG8_SA(1, 0), a3, voffA);
            PG8_WAIT_V(8); PG8_WAIT_L(0); PG8_BAR; PG8_MMA(1, 0, At, B0); PG8_MMA(1, 1, At, B1); PG8_BAR; PG8_SCHED;
            } else {
            PG8_LDB(B0, 0, 0); PG8_SCHED; PG8_LDA(At, 0, 0); PG8_STAGE(PG8_SA(1, 1), a1 + hstepA, voffA);
            PG8_WAIT_L(8); PG8_BAR; PG8_WAIT_L(0); PG8_MMA(0, 0, At, B0); PG8_BAR; PG8_SCHED;
            PG8_LDB(B1, 0, 1); PG8_STAGE(PG8_SB(0, 0), b2, voffB);
            PG8_BAR; PG8_WAIT_L(0); PG8_MMA(0, 1, At, B1); PG8_BAR;
            PG8_LDA(At, 0, 1); PG8_STAGE(PG8_SA(0, 0), a2, voffA);
            PG8_BAR; PG8_WAIT_L(0); PG8_MMA(1, 0, At, B0); PG8_BAR; PG8_SCHED;
            PG8_STAGE(PG8_SB(0, 1), b2 + hstepB, voffB);
            PG8_WAIT_V(6); PG8_BAR; PG8_MMA(1, 1, At, B1); PG8_BAR;
            PG8_LDB(B0, 1, 0); PG8_SCHED; PG8_LDA(At, 1, 0); PG8_STAGE(PG8_SA(0, 1), a2 + hstepA, voffA);
            PG8_WAIT_L(8); PG8_BAR; PG8_WAIT_L(0); PG8_MMA(0, 0, At, B0); PG8_BAR; PG8_SCHED;
            PG8_LDB(B1, 1, 1); PG8_STAGE(PG8_SB(1, 0), b3, voffB);
            PG8_BAR; PG8_WAIT_L(0); PG8_MMA(0, 1, At, B1); PG8_BAR;
            PG8_LDA(At, 1, 1); PG8_STAGE(PG8_SA(1, 0), a3, voffA);
            PG8_BAR; PG8_WAIT_L(0); PG8_MMA(1, 0, At, B0); PG8_BAR; PG8_SCHED;
            PG8_STAGE(PG8_SB(1, 1), b3 + hstepB, voffB);
            PG8_WAIT_V(6); PG8_BAR; PG8_MMA(1, 1, At, B1); PG8_BAR;
            }
        }
        if constexpr (ALIGN_EPI) { if (wr == 0) PG8_BAR; }
        if constexpr (!Epi::AFTER_DRAIN) { E(acc, cur, wr, wc, fr, fq); S.done(cur); }
        if (!has_next) break;
#pragma unroll
        for (int a = 0; a < 2; ++a)
#pragma unroll
            for (int b = 0; b < 2; ++b)
#pragma unroll
                for (int m = 0; m < 4; ++m)
#pragma unroll
                    for (int n = 0; n < 2; ++n) acc[a][b][m][n] = (f32x4){0.f, 0.f, 0.f, 0.f};
        cur = nxt; cA = nA; cB = nB; ++ui;
        if constexpr (ALIGN_EPI) { if (wr == 1) PG8_BAR; }
    }
    PG8_WAIT_V(0);
    if constexpr (!ALIGN_EPI) { if (wr == 0) PG8_BAR; }
    PG8_BAR;
    if constexpr (Epi::AFTER_DRAIN) { E.fused(acc, cur, wr, wc, fr, fq, lds, wid, lane); S.done(cur); }
#undef PG8_SA
#undef PG8_SB
#undef PG8_STAGE
#undef PG8_LDA
#undef PG8_LDB
#undef PG8_MMA
#undef PG8_WAIT_V
#undef PG8_WAIT_L
#undef PG8_BAR
#undef PG8_SCHED
}
}
constexpr int NWAVES = 8;
#ifndef MK_ONE_LAUNCH
#define MK_ONE_LAUNCH 0
#endif
constexpr int N_PHASES = 10;

constexpr int BATCH = 8, SEQ = 4096, D = 1024, M = BATCH * SEQ;
constexpr int SBH = 8, SBD = 64, SBW = 512, HGH = 4, HGD = 128, HGW = 512, NIN = 5632, FFN = 2816;
constexpr float EPS = 1e-6f;
constexpr float QSCALE = 0.125f * 1.4426950408889634f;

constexpr size_t MiB = 1u << 20;
constexpr size_t WS_CTL = 0, CTL_ZERO_BYTES = 1 * MiB;
constexpr size_t WS_WIN = 1 * MiB, WS_WBR = 12 * MiB, WS_WOUT = 14 * MiB, WS_WGU = 16 * MiB, WS_WDN = 27 * MiB;
constexpr size_t WS_XN = 33 * MiB;
constexpr size_t WS_Q = 97 * MiB, WS_K = 129 * MiB, WS_V = 161 * MiB, WS_HQ = 193 * MiB, WS_LOGF = 225 * MiB, WS_HI = 289 * MiB, WS_HGG = 321 * MiB, WS_GS = 353 * MiB, WS_GH = 417 * MiB;
constexpr size_t WS_MIXED = 97 * MiB, WS_STASH = 161 * MiB;
constexpr size_t WS_ACT = 225 * MiB;
constexpr size_t WS_END = 481 * MiB;
static_assert(WS_ACT + (size_t)M * FFN * 2 <= WS_GH + 64 * MiB && WS_WDN + (size_t)D * FFN * 2 <= WS_XN, "d_ws map");
constexpr int CW_TMO = 0, CW_CODE = 1, CW_BAR = 4096;

constexpr int RING_OFF = 0, RING_BYTES = 131072;
constexpr int LDSCTL_OFF = RING_BYTES, MISC_OFF = LDSCTL_OFF + 320;
constexpr int LDS_BYTES = 147456;
#define GAS __attribute__((address_space(1)))
#define LAS __attribute__((address_space(3)))
typedef unsigned short bf16;
typedef unsigned v4u __attribute__((ext_vector_type(4)));
typedef float f32x4 __attribute__((ext_vector_type(4)));
typedef short bf16x8 __attribute__((ext_vector_type(8)));
typedef GAS unsigned gu32;
typedef GAS unsigned long long gu64;
#define RLX_AGENT __ATOMIC_RELAXED, __HIP_MEMORY_SCOPE_AGENT
#define LDS_WAIT() asm volatile("s_waitcnt lgkmcnt(0)" ::: "memory")
#define VM_WAIT() asm volatile("s_waitcnt vmcnt(0)" ::: "memory")
__device__ __forceinline__ unsigned long long rt() { return __builtin_amdgcn_s_memrealtime(); }
__device__ __forceinline__ unsigned f2bf(float f) { unsigned u = __builtin_bit_cast(unsigned, f); return (u + 0x7fffu + ((u >> 16) & 1u)) >> 16; }
__device__ __forceinline__ unsigned pk2(float lo, float hi) { return f2bf(lo) | (f2bf(hi) << 16); }

#define XB_TMO      128
#define XB_XCNT(j)  (256  + 64 * (j))
#define XB_XSUB(j)  (1280 + 64 * (j))
#define XB_XGEN(j)  (2304 + 64 * (j))
#define XB_TOP      3328
#define XB_TOPGEN   3392
#define XCD_BAR_WORDS 3456
#define XB_SPIN_CAP (1u << 18)

__device__ __forceinline__ unsigned xb_ld(unsigned* p)              { return __hip_atomic_load(p, __ATOMIC_RELAXED, __HIP_MEMORY_SCOPE_AGENT); }
__device__ __forceinline__ unsigned xb_add(unsigned* p, unsigned v) { return __hip_atomic_fetch_add(p, v, __ATOMIC_RELAXED, __HIP_MEMORY_SCOPE_AGENT); }
__device__ __forceinline__ unsigned xb_xcc_id() { return (unsigned)__builtin_amdgcn_s_getreg((3 << 11) | 20) & 0xFu; }
#define XB_SPIN(cond, bar) do { unsigned _sp = 0; while (cond) { __builtin_amdgcn_s_sleep(1); \
    if ((++_sp & 255u) == 0u) { if (xb_ld(&(bar)[XB_TMO])) break; if (_sp > XB_SPIN_CAP) { atomicAdd(&(bar)[XB_TMO], 1u); break; } } } } while (0)

struct XcdBarrier {
    unsigned* bar; unsigned x;
    volatile LAS unsigned* st;
};

__device__ __forceinline__ XcdBarrier xcd_barrier_post(unsigned* bar, volatile LAS unsigned* st) {
    XcdBarrier b; b.bar = bar; b.x = xb_xcc_id(); b.st = st;
    if (threadIdx.x == 0) (void)xb_add(&bar[XB_XCNT(b.x)], 1u);
    return b;
}
__device__ __forceinline__ void xcd_barrier_complete(unsigned* bar, unsigned x, unsigned& nloc, unsigned& nx) {
    const unsigned G = gridDim.x * gridDim.y * gridDim.z;
    unsigned sum, cnt, mine, sp = 0u;
    for (;;) {
        sum = 0u; cnt = 0u; mine = 0u;
#pragma unroll
        for (unsigned j = 0; j < 16; ++j) { const unsigned c = xb_ld(&bar[XB_XCNT(j)]); sum += c; cnt += (c > 0u) ? 1u : 0u; mine = (j == x) ? c : mine; }
        if (sum == G) break;
        __builtin_amdgcn_s_sleep(1);
        if ((++sp & 255u) == 0u) { if (xb_ld(&bar[XB_TMO])) break; if (sp > XB_SPIN_CAP) { atomicAdd(&bar[XB_TMO], 1u); break; } }
    }
    nloc = mine > 0u ? mine : 1u; nx = cnt > 0u ? cnt : 1u;
}

__device__ __forceinline__ void xcd_barrier(const XcdBarrier& b) {
    asm volatile("s_waitcnt vmcnt(0)" ::: "memory");
    __syncthreads();
    if (threadIdx.x == 0) {
        unsigned* bar = b.bar;
        __builtin_amdgcn_s_waitcnt(0);
        unsigned nloc = b.st[0], nx = b.st[1];
        if (nloc == 0u) { xcd_barrier_complete(bar, b.x, nloc, nx); b.st[0] = nloc; b.st[1] = nx; }
        const unsigned old = xb_add(&bar[XB_XSUB(b.x)], 1u);
        const unsigned gen = old / nloc;
        if (old + 1u == (gen + 1u) * nloc) {
            __builtin_amdgcn_fence(__ATOMIC_RELEASE, "agent");
            asm volatile("s_waitcnt vmcnt(0)" ::: "memory");
            const unsigned og = xb_add(&bar[XB_TOP], 1u);
            const unsigned tg = og / nx;
            if (og + 1u == (tg + 1u) * nx) xb_add(&bar[XB_TOPGEN], 1u);
            else XB_SPIN(xb_ld(&bar[XB_TOPGEN]) == tg, bar);
            __builtin_amdgcn_fence(__ATOMIC_ACQUIRE, "agent");
            xb_add(&bar[XB_XGEN(b.x)], 1u);
            asm volatile("s_waitcnt vmcnt(0)" ::: "memory");
        } else {
            XB_SPIN(xb_ld(&bar[XB_XGEN(b.x)]) == gen, bar);
            __builtin_amdgcn_fence(__ATOMIC_ACQUIRE, "agent");
            asm volatile("s_waitcnt vmcnt(0)" ::: "memory");
        }
    }
    __syncthreads();
}
struct Frame {
    LAS unsigned char* lds; volatile LAS unsigned* MISC; gu32* ctl;
    int tid, lane, wave, vcu, G;
    const float *x, *n1g, *w_in, *gq, *gk, *lbt, *hgn, *w_br, *w_out, *n2g, *w_gate, *w_up, *w_dn; float* out;
    bf16 *WIN, *WBR, *WOUT, *WGU, *WDN, *XN, *Q, *K, *V, *HQ, *HI, *HGG, *GS, *GH, *MIXED, *STASH, *ACT; float* LOGF;
};
__device__ __forceinline__ float wave_sum(float v) {
#pragma unroll
    for (int o = 1; o < 64; o <<= 1) v += __shfl_xor(v, o);
    return v;
}
__device__ __forceinline__ float bf2f(unsigned short h) { return __uint_as_float((unsigned)h << 16); }
__device__ __forceinline__ void p0_transpose_item(const float* W, int Nsrc, int ns, bf16* WT, int ldd, int nd, int k0, LAS float* scr, int lane) {
#pragma unroll 8
    for (int i = 0; i < 32; ++i) { const int kk = 2 * i + (lane >> 5); scr[kk * 33 + (lane & 31)] = W[(size_t)(k0 + kk) * Nsrc + ns + (lane & 31)]; }
    LDS_WAIT(); asm volatile("" ::: "memory");
    const int c = lane & 7;
#pragma unroll
    for (int j = 0; j < 4; ++j) { const int n = (lane >> 3) + 8 * j; const LAS float* s = scr + (8 * c) * 33 + n;
        v4u o; o.x = pk2(s[0 * 33], s[1 * 33]); o.y = pk2(s[2 * 33], s[3 * 33]); o.z = pk2(s[4 * 33], s[5 * 33]); o.w = pk2(s[6 * 33], s[7 * 33]);
        *(GAS v4u*)(WT + (size_t)(nd + n) * ldd + k0 + 8 * c) = o; }
    LDS_WAIT(); asm volatile("" ::: "memory");
}
__device__ __forceinline__ void rms_row_to_bf16(int lane, const float* xrow, const float* gain, bf16* orow) {
    const GAS f32x4* xr = (const GAS f32x4*)xrow + lane; const GAS f32x4* gr = (const GAS f32x4*)gain + lane;
    f32x4 v[4]; float s = 0.f;
#pragma unroll
    for (int j = 0; j < 4; ++j) { v[j] = xr[64 * j]; s += (v[j].x * v[j].x + v[j].y * v[j].y) + (v[j].z * v[j].z + v[j].w * v[j].w); }
    const float rs = 1.0f / sqrtf(wave_sum(s) * (1.0f / 1024.0f) + EPS);
    GAS unsigned long long* o8 = (GAS unsigned long long*)orow + lane;
#pragma unroll
    for (int j = 0; j < 4; ++j) { const f32x4 g = gr[64 * j]; o8[64 * j] = (unsigned long long)pk2(v[j].x * rs * g.x, v[j].y * rs * g.y) | ((unsigned long long)pk2(v[j].z * rs * g.z, v[j].w * rs * g.w) << 32); }
}
__device__ __forceinline__ void p0_prologue(Frame& F) {
    LAS float* scr = (LAS float*)(F.lds + RING_OFF + F.wave * 16384);
    const int gw = F.vcu * NWAVES + F.wave, NGW = F.G * NWAVES;
    constexpr int I_IN = 16 * 176, I_BR = 16 * 32, I_OUT = 16 * 32, I_G = 16 * 88, I_U = 16 * 88, I_DN = 44 * 32;
    constexpr int NITEMS = I_IN + I_BR + I_OUT + I_G + I_U + I_DN;
    for (int it = gw; it < NITEMS; it += NGW) {
        int r = it;
        if (r < I_IN) { const int kb = r / 176, nb = r % 176; int sb = nb;
            if (nb < 32) { const int pn = nb >> 3, rem = nb & 7, bj = rem >> 2, wc = rem & 3; sb = 8 * pn + 2 * wc + bj; }
            p0_transpose_item(F.w_in, NIN, 32 * sb, F.WIN, D, 32 * nb, 64 * kb, scr, F.lane); continue; } r -= I_IN;
        if (r < I_BR) { p0_transpose_item(F.w_br, D, 32 * (r % 32), F.WBR, D, 32 * (r % 32), 64 * (r / 32), scr, F.lane); continue; } r -= I_BR;
        if (r < I_OUT) { p0_transpose_item(F.w_out, D, 32 * (r % 32), F.WOUT, D, 32 * (r % 32), 64 * (r / 32), scr, F.lane); continue; } r -= I_OUT;
        if (r < I_G + I_U) { const bool up = r >= I_G; if (up) r -= I_G; const int kb = r / 88, sb = r % 88;
            p0_transpose_item(up ? F.w_up : F.w_gate, FFN, 32 * sb, F.WGU, D, 256 * (sb >> 2) + (up ? 128 : 0) + 32 * (sb & 3), 64 * kb, scr, F.lane); continue; } r -= I_G + I_U;
        p0_transpose_item(F.w_dn, D, 32 * (r % 32), F.WDN, FFN, 32 * (r % 32), 64 * (r / 32), scr, F.lane);
    }
    for (int m = gw; m < M; m += NGW) rms_row_to_bf16(F.lane, F.x + (size_t)m * D, F.n1g, F.XN + (size_t)m * D);
}

__device__ __forceinline__ void attn_naive(Frame& F) {
    const long NT = (long)F.G * 512;
    for (long idx = (long)blockIdx.x * 512 + F.tid; idx < (long)BATCH * SBH * SEQ; idx += NT) {
        const int t = (int)(idx & (SEQ - 1)), bh = (int)(idx >> 12), b = bh >> 3, h = bh & 7;
        const size_t rowb = (size_t)b * SEQ;
        float q[64], o[64];
        { const GAS v4u* qp = (const GAS v4u*)(F.Q + (rowb + t) * SBW + h * 64);
#pragma unroll
          for (int c = 0; c < 8; ++c) { const v4u w = qp[c];
#pragma unroll
              for (int e = 0; e < 4; ++e) { q[8 * c + 2 * e] = __uint_as_float(w[e] << 16); q[8 * c + 2 * e + 1] = __uint_as_float(w[e] & 0xffff0000u); } } }
#pragma unroll
        for (int d = 0; d < 64; ++d) o[d] = 0.f;
        float R = 0.f;
        for (int s = t - 1; s >= 0; --s) {
            const GAS v4u* kp = (const GAS v4u*)(F.K + (rowb + s) * SBW + h * 64); const GAS v4u* vp = (const GAS v4u*)(F.V + (rowb + s) * SBW + h * 64);
            float z = 0.f;
#pragma unroll
            for (int c = 0; c < 8; ++c) { const v4u w = kp[c];
#pragma unroll
                for (int e = 0; e < 4; ++e) { z += q[8 * c + 2 * e] * __uint_as_float(w[e] << 16); z += q[8 * c + 2 * e + 1] * __uint_as_float(w[e] & 0xffff0000u); } }
            const float sp = __builtin_amdgcn_logf(1.0f + __builtin_amdgcn_exp2f(z));
            const float wgt = __builtin_amdgcn_exp2f(z - sp - R);
            R += sp;
#pragma unroll
            for (int c = 0; c < 8; ++c) { const v4u w = vp[c];
#pragma unroll
                for (int e = 0; e < 4; ++e) { o[8 * c + 2 * e] += wgt * __uint_as_float(w[e] << 16); o[8 * c + 2 * e + 1] += wgt * __uint_as_float(w[e] & 0xffff0000u); } }
        }
        GAS v4u* op = (GAS v4u*)(F.XN + (rowb + t) * D + h * 64);
#pragma unroll
        for (int c = 0; c < 8; ++c) { v4u w;
#pragma unroll
            for (int e = 0; e < 4; ++e) w[e] = pk2(o[8 * c + 2 * e], o[8 * c + 2 * e + 1]);
            op[c] = w; }
    }
}
__device__ __forceinline__ void hgrn_naive(Frame& F, float* oraw) {
    if (blockIdx.x >= 8) return;
    const int grp = F.tid >> 7, c = F.tid & 127, bh = blockIdx.x * 4 + grp, b = bh >> 2, h = bh & 3;
    LAS float* Lf = (LAS float*)(F.lds + grp * 24576); LAS float* Lk = Lf + 2048; LAS float* Lq = Lk + 2048;
    float S[128];
#pragma unroll
    for (int k = 0; k < 128; ++k) S[k] = 0.f;
    for (int t0 = 0; t0 < SEQ; t0 += 16) {
        for (int i = 0; i < 16; ++i) { const size_t row = (size_t)b * SEQ + t0 + i; const float f = __expf(F.LOGF[row * HGW + h * 128 + c]);
            Lf[i * 128 + c] = f; Lk[i * 128 + c] = 1.0f - f; Lq[i * 128 + c] = bf2f(F.HQ[row * HGW + h * 128 + c]); }
        __syncthreads();
        for (int i = 0; i < 16; ++i) { const size_t row = (size_t)b * SEQ + t0 + i; const float val = bf2f(F.HI[row * HGW + h * 128 + c]); float o = 0.f;
#pragma unroll
            for (int k4 = 0; k4 < 32; ++k4) { const f32x4 f = *(const LAS f32x4*)(Lf + i * 128 + 4 * k4), ky = *(const LAS f32x4*)(Lk + i * 128 + 4 * k4), qq = *(const LAS f32x4*)(Lq + i * 128 + 4 * k4);
#pragma unroll
                for (int j = 0; j < 4; ++j) { S[4 * k4 + j] = f[j] * S[4 * k4 + j] + ky[j] * val; o += qq[j] * S[4 * k4 + j]; } }
            oraw[row * HGW + h * 128 + c] = o; }
        __syncthreads();
    }
}
__device__ __forceinline__ void hg_post(Frame& F, const float* oraw) {
    const int gw = F.vcu * NWAVES + F.wave, NGW = F.G * NWAVES;
    for (int it = gw; it < M * HGH; it += NGW) { const size_t row = it >> 2; const int h = it & 3, v = 2 * F.lane;
        const float a = oraw[row * HGW + h * 128 + v], b2 = oraw[row * HGW + h * 128 + v + 1];
        const float rs = 1.0f / sqrtf(wave_sum(a * a + b2 * b2) * (1.0f / 128.0f) + EPS);
        const unsigned gw2 = *(const unsigned*)(F.HGG + row * HGW + h * 128 + v);
        *(unsigned*)(F.XN + row * D + 512 + h * 128 + v) = pk2(a * rs * F.hgn[v] * __uint_as_float(gw2 << 16), b2 * rs * F.hgn[v + 1] * __uint_as_float(gw2 & 0xffff0000u)); }
}

struct Args { const float* in[13]; float* out; unsigned char* ws; int ph_lo, ph_hi; };
__global__ void __launch_bounds__(NWAVES * 64, 2) skel_fwd(Args args) {
    extern __shared__ __attribute__((aligned(16))) unsigned char lds[];
    Frame F;
    F.lds = (LAS unsigned char*)lds; F.MISC = (volatile LAS unsigned*)(F.lds + MISC_OFF);
    F.tid = threadIdx.x; F.lane = F.tid & 63; F.wave = __builtin_amdgcn_readfirstlane(F.tid >> 6);
    F.G = gridDim.x; { const int bx = blockIdx.x; F.vcu = (F.G % 8 == 0) ? (bx % 8) * (F.G / 8) + bx / 8 : bx; }
    unsigned char* ws = args.ws;
    F.ctl = (gu32*)(ws + WS_CTL);
    F.x = args.in[0]; F.n1g = args.in[1]; F.w_in = args.in[2]; F.gq = args.in[3]; F.gk = args.in[4]; F.lbt = args.in[5]; F.hgn = args.in[6]; F.w_br = args.in[7]; F.w_out = args.in[8];
    F.n2g = args.in[9]; F.w_gate = args.in[10]; F.w_up = args.in[11]; F.w_dn = args.in[12]; F.out = args.out;
    F.WIN = (bf16*)(ws + WS_WIN); F.WBR = (bf16*)(ws + WS_WBR); F.WOUT = (bf16*)(ws + WS_WOUT); F.WGU = (bf16*)(ws + WS_WGU); F.WDN = (bf16*)(ws + WS_WDN);
    F.XN = (bf16*)(ws + WS_XN); F.Q = (bf16*)(ws + WS_Q); F.K = (bf16*)(ws + WS_K); F.V = (bf16*)(ws + WS_V); F.HQ = (bf16*)(ws + WS_HQ); F.LOGF = (float*)(ws + WS_LOGF);
    F.HI = (bf16*)(ws + WS_HI); F.HGG = (bf16*)(ws + WS_HGG); F.GS = (bf16*)(ws + WS_GS); F.GH = (bf16*)(ws + WS_GH); F.MIXED = (bf16*)(ws + WS_MIXED); F.STASH = (bf16*)(ws + WS_STASH); F.ACT = (bf16*)(ws + WS_ACT);
    for (int u = F.tid; u < (LDS_BYTES - LDSCTL_OFF) / 4; u += NWAVES * 64) ((LAS unsigned*)(F.lds + LDSCTL_OFF))[u] = 0u;
    __syncthreads();
    XcdBarrier bar; bar.bar = (unsigned*)(F.ctl + CW_BAR); bar.x = 0; bar.st = nullptr;
    if (MK_ONE_LAUNCH) bar = xcd_barrier_post((unsigned*)(F.ctl + CW_BAR), F.MISC + 8);
    const int lo = args.ph_lo, hi = args.ph_hi;
#define IN(k) (lo <= (k) && (k) < hi)
#define SEAM(k) do { if (IN(k) && IN((k) + 1)) xcd_barrier(bar); } while (0)
    float* oraw = F.out;

    if (IN(0)) { p0_prologue(F); } SEAM(0);
    if (IN(1)) {
        pg8::Gemm g{F.XN, F.WIN, M, NIN, D, D, D}; pg8::StaticOrder S; S.init(M, NIN, F.G, (int)blockIdx.x);
        pg8::EpiProj E{F.Q, F.K, F.V, F.HQ, F.HI, F.HGG, F.GS, F.GH, F.LOGF, F.gq, F.gk, F.lbt, QSCALE, EPS};
        pg8::gemm_phase<pg8::EpiProj, pg8::StaticOrder, true, true>(F.lds + RING_OFF, g, S, E);
    } SEAM(1);
    if (IN(2)) { hgrn_naive(F, oraw); attn_naive(F); } SEAM(2);
    if (IN(3)) { hg_post(F, oraw); } SEAM(3);
    if (IN(4)) {
        pg8::Gemm g{F.XN, F.WBR, M, D, 512, D, D}; pg8::StaticOrder S; S.init(M, D, F.G, (int)blockIdx.x);
        pg8::EpiGate E{F.GS, nullptr, F.STASH};
        pg8::gemm_phase<pg8::EpiGate, pg8::StaticOrder, true, true>(F.lds + RING_OFF, g, S, E);
    } SEAM(4);
    if (IN(5)) {
        pg8::Gemm g{F.XN + 512, F.WBR + 512, M, D, 512, D, D}; pg8::StaticOrder S; S.init(M, D, F.G, (int)blockIdx.x);
        pg8::EpiGate E{F.GH, F.STASH, F.MIXED};
        pg8::gemm_phase<pg8::EpiGate, pg8::StaticOrder, true, true>(F.lds + RING_OFF, g, S, E);
    } SEAM(5);
    if (IN(6)) {
        pg8::Gemm g{F.MIXED, F.WOUT, M, D, D, D, D}; pg8::StaticOrder S; S.init(M, D, F.G, (int)blockIdx.x);
        pg8::EpiRes E{F.x, F.out};
        pg8::gemm_phase<pg8::EpiRes, pg8::StaticOrder, true, true>(F.lds + RING_OFF, g, S, E);
    } SEAM(6);
    if (IN(7)) { const int gw = F.vcu * NWAVES + F.wave, NGW = F.G * NWAVES;
        for (int m = gw; m < M; m += NGW) rms_row_to_bf16(F.lane, F.out + (size_t)m * D, F.n2g, F.XN + (size_t)m * D); } SEAM(7);
    if (IN(8)) {
        pg8::Gemm g{F.XN, F.WGU, M, NIN, D, D, D}; pg8::StaticOrder S; S.init(M, NIN, F.G, (int)blockIdx.x);
        pg8::EpiSwiglu E{F.ACT, FFN};
        pg8::gemm_phase<pg8::EpiSwiglu, pg8::StaticOrder, true, true>(F.lds + RING_OFF, g, S, E);
    } SEAM(8);
    if (IN(9)) {
        pg8::Gemm g{F.ACT, F.WDN, M, D, FFN, FFN, FFN}; pg8::StaticOrder S; S.init(M, D, F.G, (int)blockIdx.x);
        pg8::EpiRes E{F.out, F.out};
        pg8::gemm_phase<pg8::EpiRes, pg8::StaticOrder, true, true>(F.lds + RING_OFF, g, S, E);
    }
#undef IN
#undef SEAM
}

extern "C" void kernel_launch(void* const* d_in, const int* in_sizes, int n_in, void* d_out, int out_size, void* d_ws, size_t ws_size, hipStream_t stream) {
    static int grid = 0;
    if (grid == 0) {
        if (n_in != 13 || in_sizes[0] != M * D || out_size != M * D || ws_size < WS_END) { fprintf(stderr, "kernel_launch: unexpected shapes / workspace (n_in %d, ws %zu); nothing launched\n", n_in, ws_size); grid = -1; return; }
        int dev = 0, cus = 0;
        if (hipGetDevice(&dev) != hipSuccess || hipDeviceGetAttribute(&cus, hipDeviceAttributeMultiprocessorCount, dev) != hipSuccess) { grid = -1; return; }
        if (hipFuncSetAttribute((const void*)skel_fwd, hipFuncAttributeMaxDynamicSharedMemorySize, LDS_BYTES) != hipSuccess) { grid = -1; return; }
        int per_cu = 0;
        if (hipOccupancyMaxActiveBlocksPerMultiprocessor(&per_cu, (const void*)skel_fwd, NWAVES * 64, LDS_BYTES) != hipSuccess || per_cu < 1) { fprintf(stderr, "kernel_launch: occupancy query says %d\n", per_cu); }
        (void)hipGetLastError();
        grid = cus;
    }
    if (grid < 0) return;
    (void)hipMemsetAsync((char*)d_ws + WS_CTL, 0, CTL_ZERO_BYTES, stream);
    Args a{};
    for (int i = 0; i < 13; ++i) a.in[i] = (const float*)d_in[i];
    a.out = (float*)d_out; a.ws = (unsigned char*)d_ws;
    if (MK_ONE_LAUNCH) { a.ph_lo = 0; a.ph_hi = N_PHASES; hipLaunchKernelGGL(skel_fwd, dim3(grid), dim3(NWAVES * 64), LDS_BYTES, stream, a); }
    else for (int p = 0; p < N_PHASES; ++p) { a.ph_lo = p; a.ph_hi = p + 1; hipLaunchKernelGGL(skel_fwd, dim3(grid), dim3(NWAVES * 64), LDS_BYTES, stream, a); }
}
```

```cpp
#include <hip/hip_runtime.h>
#include <cstdio>
#include <cstdint>
namespace pg8 {
#define PG8_LAS __attribute__((address_space(3)))
typedef unsigned short bf16_t;
typedef short bf16x8 __attribute__((ext_vector_type(8)));
typedef float f32x4 __attribute__((ext_vector_type(4)));
typedef unsigned u32x4 __attribute__((ext_vector_type(4)));
constexpr int BM = 256, BK = 64, HALF = 128, HTB = HALF * BK * 2  , STAGE_BYTES = 8 * HTB, NXCD = 8, WGM = 4;

__host__ __device__ __forceinline__ int lds_byte(int r, int c) { const int st = (r >> 4) * 2 + (c >> 5), rr = r & 15, cc = c & 31, ob = rr * 64 + cc * 2; return st * 1024 + (ob ^ (((ob >> 9) & 1) << 5)); }
__host__ __device__ __forceinline__ void stage_rc(int b, int& R, int& C) { const int st = b / 1024, sb = b % 1024, swz = sb ^ (((sb >> 9) & 1) << 5); R = (st >> 1) * 16 + swz / 64; C = (st & 1) * 32 + (swz % 64) / 2; }
__host__ __device__ __forceinline__ int perm32(int rho) { const int n = rho >> 4, i = rho & 15; return 8 * (i >> 2) + 4 * n + (i & 3); }

struct Unit { int pm, pn; };
struct Gemm { const bf16_t* A; const bf16_t* Bt; int M, N, K, lda, ldb; };

struct StaticOrder {
    int nM, nN, nwg, G, c;
    __host__ __device__ void init(int M, int N, int G_, int c_) { nM = M / BM; nN = N / BM; nwg = nM * nN; G = G_; c = c_; }
    __host__ __device__ bool next(int i, Unit& u) const {
        const long L = (long)i * G + c; if (L >= nwg) return false;
        int wgid = (int)L; { const int q = nwg / NXCD, r = nwg % NXCD, xcd = wgid % NXCD, off = wgid / NXCD; wgid = (xcd < r ? xcd * (q + 1) : r * (q + 1) + (xcd - r) * q) + off; }
        const int nig = WGM * nN, gid = wgid / nig, fm = gid * WGM, gsz = (nM - fm) < WGM ? (nM - fm) : WGM;
        u.pm = fm + ((wgid % nig) % gsz); u.pn = (wgid % nig) / gsz; return true;
    }
    __device__ __forceinline__ void a_ready(const Unit&) const {}
    __device__ __forceinline__ void done(const Unit&) const {}
};

typedef float f32x2_t __attribute__((ext_vector_type(2))); typedef __bf16 bf16x2_t __attribute__((ext_vector_type(2)));
__device__ __forceinline__ unsigned cvt_pk_bf16(float lo, float hi) { const f32x2_t v = {lo, hi}; const bf16x2_t b = __builtin_convertvector(v, bf16x2_t); return __builtin_bit_cast(unsigned, b); }
typedef unsigned u32x2 __attribute__((ext_vector_type(2)));
__device__ __forceinline__ float ex2(float x) { return __builtin_amdgcn_exp2f(x); }
__device__ __forceinline__ float sigm(float x) { return __builtin_amdgcn_rcpf(1.0f + ex2(x * -1.4426950408889634f)); }
__device__ __forceinline__ u32x4 pack8(const f32x4 a, const f32x4 b) { u32x4 w; w.x = cvt_pk_bf16(a[0], a[1]); w.y = cvt_pk_bf16(a[2], a[3]); w.z = cvt_pk_bf16(b[0], b[1]); w.w = cvt_pk_bf16(b[2], b[3]); return w; }
__device__ __forceinline__ f32x4 bf4_lo(const u32x4 w) { return (f32x4){__uint_as_float(w.x << 16), __uint_as_float(w.x & 0xffff0000u), __uint_as_float(w.y << 16), __uint_as_float(w.y & 0xffff0000u)}; }
__device__ __forceinline__ f32x4 bf4_hi(const u32x4 w) { return (f32x4){__uint_as_float(w.z << 16), __uint_as_float(w.z & 0xffff0000u), __uint_as_float(w.w << 16), __uint_as_float(w.w & 0xffff0000u)}; }

__device__ __forceinline__ u32x2 pack8_fp8(const f32x4 a, const f32x4 b) { u32x2 w; int t = __builtin_amdgcn_cvt_pk_fp8_f32(a[0], a[1], 0, false); t = __builtin_amdgcn_cvt_pk_fp8_f32(a[2], a[3], t, true); w.x = (unsigned)t;
    t = __builtin_amdgcn_cvt_pk_fp8_f32(b[0], b[1], 0, false); t = __builtin_amdgcn_cvt_pk_fp8_f32(b[2], b[3], t, true); w.y = (unsigned)t; return w; }
__device__ __forceinline__ f32x4 fp8x4(unsigned w) { typedef float f2_ __attribute__((ext_vector_type(2))); const f2_ lo = __builtin_amdgcn_cvt_pk_f32_fp8((int)w, false), hi = __builtin_amdgcn_cvt_pk_f32_fp8((int)w, true); return (f32x4){lo.x, lo.y, hi.x, hi.y}; }
struct EpiProj {
    static constexpr bool PERM = true, AFTER_DRAIN = false, MID = false;
    bf16_t *Q, *Kq, *V, *HQ, *HI, *HGG, *GS, *GH; float* LOGF; const float *gq, *gk, *lbt; float qscale, eps;
    __device__ __forceinline__ void operator()(const f32x4 (&acc)[2][2][4][2], const Unit& u, int wr, int wc, int fr, int fq) const {
        const int pn = u.pn, row0 = u.pm * BM + wr * 64 + fr;
        if (pn < 4) {
            const bool isq = pn < 2; const int head = 4 * (pn & 1) + wc;
            bf16_t* base = (isq ? Q : Kq) + head * 64 + 8 * fq; const float* g = (isq ? gq : gk) + 8 * fq; const float sc = isq ? qscale : 1.0f;
            f32x4 gv[2][2];
#pragma unroll
            for (int bj = 0; bj < 2; ++bj)
#pragma unroll
                for (int n = 0; n < 2; ++n) gv[bj][n] = *(const f32x4*)(g + 32 * bj + 4 * n) * sc;
#pragma unroll
            for (int ai = 0; ai < 2; ++ai)
#pragma unroll
                for (int m = 0; m < 4; ++m) {
                    float ss = 0.f;
#pragma unroll
                    for (int bj = 0; bj < 2; ++bj)
#pragma unroll
                        for (int n = 0; n < 2; ++n) { const f32x4 x = acc[ai][bj][m][n]; ss += (x[0] * x[0] + x[1] * x[1]) + (x[2] * x[2] + x[3] * x[3]); }
                    ss += __shfl_xor(ss, 16); ss += __shfl_xor(ss, 32);
                    const float rs = 1.0f / sqrtf(ss * (1.0f / 64.0f) + eps);
                    bf16_t* rowp = base + (size_t)(row0 + ai * HALF + m * 16) * 512;
#pragma unroll
                    for (int bj = 0; bj < 2; ++bj) *(u32x4*)(rowp + 32 * bj) = pack8(acc[ai][bj][m][0] * rs * gv[bj][0], acc[ai][bj][m][1] * rs * gv[bj][1]);
                }
        } else if (pn == 8 || pn == 9) {
            store_tile<0>(acc, (bf16_t*)LOGF, 512, row0, 256 * (pn - 8) + 32 * wc + 8 * fq);
        } else {
            const int cw = 32 * wc + 8 * fq;
            if (pn < 6) store_tile<0>(acc, V, 512, row0, 256 * (pn - 4) + cw);
            else if (pn < 8) store_tile<0>(acc, HQ, 512, row0, 256 * (pn - 6) + cw);
            else if (pn < 12) store_tile<0>(acc, HI, 512, row0, 256 * (pn - 10) + cw);
            else if (pn < 14) store_tile<0>(acc, HGG, 512, row0, 256 * (pn - 12) + cw);
            else if (pn < 18) store_tile8(acc, (unsigned char*)GS, row0, 256 * (pn - 14) + cw);
            else store_tile8(acc, (unsigned char*)GH, row0, 256 * (pn - 18) + cw);
        }
    }
    static __device__ __forceinline__ void store_tile8(const f32x4 (&acc)[2][2][4][2], unsigned char* ob, int row0, int cb) {
#pragma unroll
        for (int ai = 0; ai < 2; ++ai)
#pragma unroll
            for (int m = 0; m < 4; ++m) { unsigned char* rowp = ob + (size_t)(row0 + ai * HALF + m * 16) * 1024 + cb;
#pragma unroll
                for (int bj = 0; bj < 2; ++bj) *(u32x2*)(rowp + 128 * bj) = pack8_fp8(acc[ai][bj][m][0], acc[ai][bj][m][1]); }
    }
    template <int MODE  > static __device__ __forceinline__ void store_tile(const f32x4 (&acc)[2][2][4][2], bf16_t* ob, int ld, int row0, int cb) {
#pragma unroll
        for (int ai = 0; ai < 2; ++ai)
#pragma unroll
            for (int m = 0; m < 4; ++m) { bf16_t* rowp = ob + (size_t)(row0 + ai * HALF + m * 16) * ld + cb;
#pragma unroll
                for (int bj = 0; bj < 2; ++bj) { f32x4 v[2];
#pragma unroll
                    for (int n = 0; n < 2; ++n) { const f32x4 x = acc[ai][bj][m][n];
                        if (MODE == 0) v[n] = x;
                        else {
#pragma unroll
                            for (int j = 0; j < 4; ++j) { const float s = sigm(x[j]); v[n][j] = MODE == 1 ? x[j] * s : s; } } }
                    *(u32x4*)(rowp + 128 * bj) = pack8(v[0], v[1]); } }
    }
};
struct EpiGateK {
    static constexpr bool PERM = true, AFTER_DRAIN = false, MID = true;
    const unsigned char* gs; const unsigned char* gh; bf16_t* out;
    __device__ __forceinline__ void mid(f32x4 (&acc)[2][2][4][2], const Unit& u, int wr, int wc, int fr_, int fq_) const {
        int fr = fr_, fq = fq_; asm volatile("" : "+v"(fr), "+v"(fq));
        const int row0 = u.pm * BM + wr * 64 + fr, col0 = u.pn * BM + wc * 32 + 8 * fq;
#pragma unroll
        for (int ai = 0; ai < 2; ++ai) {
            u32x2 a[4][2], b[4][2];
#pragma unroll
            for (int m = 0; m < 4; ++m)
#pragma unroll
                for (int bj = 0; bj < 2; ++bj) { const size_t off = (size_t)(row0 + ai * HALF + m * 16) * 1024 + col0 + bj * HALF; a[m][bj] = *(const u32x2*)(gs + off); b[m][bj] = *(const u32x2*)(gh + off); }
            asm volatile("" ::: "memory");
#pragma unroll
            for (int m = 0; m < 4; ++m)
#pragma unroll
                for (int bj = 0; bj < 2; ++bj) {
                    const f32x4 es0 = fp8x4(a[m][bj].x) * -1.4426950408889634f, es1 = fp8x4(a[m][bj].y) * -1.4426950408889634f, eh0 = fp8x4(b[m][bj].x) * -1.4426950408889634f, eh1 = fp8x4(b[m][bj].y) * -1.4426950408889634f;
                    f32x4 n0, n1, d0, d1;
#pragma unroll
                    for (int j = 0; j < 4; ++j) { n0[j] = ex2(eh0[j]); n1[j] = ex2(eh1[j]); d0[j] = ex2(es0[j]); d1[j] = ex2(es1[j]); }
                    n0 = n0 + 1.0f; n1 = n1 + 1.0f; d0 = d0 + 1.0f; d1 = d1 + 1.0f;
#pragma unroll
                    for (int j = 0; j < 4; ++j) { d0[j] = __builtin_amdgcn_rcpf(d0[j]); d1[j] = __builtin_amdgcn_rcpf(d1[j]); }
                    acc[ai][bj][m][0] = acc[ai][bj][m][0] * (n0 * d0); acc[ai][bj][m][1] = acc[ai][bj][m][1] * (n1 * d1); }
            asm volatile("" ::: "memory");
        }
    }
    __device__ __forceinline__ void operator()(const f32x4 (&acc)[2][2][4][2], const Unit& u, int wr, int wc, int fr, int fq) const {
        const int row0 = u.pm * BM + wr * 64 + fr, col0 = u.pn * BM + wc * 32 + 8 * fq;
#pragma unroll
        for (int ai = 0; ai < 2; ++ai) {
            u32x2 b[4][2];
#pragma unroll
            for (int m = 0; m < 4; ++m)
#pragma unroll
                for (int bj = 0; bj < 2; ++bj) b[m][bj] = *(const u32x2*)(gh + (size_t)(row0 + ai * HALF + m * 16) * 1024 + col0 + bj * HALF);
            asm volatile("" ::: "memory");
#pragma unroll
            for (int m = 0; m < 4; ++m)
#pragma unroll
                for (int bj = 0; bj < 2; ++bj) { f32x4 g0 = fp8x4(b[m][bj].x), g1 = fp8x4(b[m][bj].y);
#pragma unroll
                    for (int j = 0; j < 4; ++j) { g0[j] = sigm(g0[j]); g1[j] = sigm(g1[j]); }
                    *(u32x4*)(out + (size_t)(row0 + ai * HALF + m * 16) * 1024 + col0 + bj * HALF) = pack8(acc[ai][bj][m][0] * g0, acc[ai][bj][m][1] * g1); }
            asm volatile("" ::: "memory");
        }
    }
};
struct EpiResHn {
    static constexpr bool PERM = false, AFTER_DRAIN = false, MID = false;
    const bf16_t* hn; float* out;
    __device__ __forceinline__ void operator()(const f32x4 (&acc)[2][2][4][2], const Unit& u, int wr, int wc, int fr, int fq) const {
        const int row0 = u.pm * BM + wr * 64 + fr, col0 = u.pn * BM + wc * 32 + 4 * fq;
#pragma unroll
        for (int ai = 0; ai < 2; ++ai) {
            u32x2 pre[4][2][2];
#pragma unroll
            for (int m = 0; m < 4; ++m) {
#pragma unroll
                for (int bj = 0; bj < 2; ++bj)
#pragma unroll
                    for (int n = 0; n < 2; ++n) pre[m][bj][n] = *(const u32x2*)(hn + (size_t)(row0 + ai * HALF + m * 16) * 1024 + col0 + bj * HALF + n * 16); }
            asm volatile("" ::: "memory");
#pragma unroll
            for (int m = 0; m < 4; ++m)
#pragma unroll
                for (int bj = 0; bj < 2; ++bj)
#pragma unroll
                    for (int n = 0; n < 2; ++n) { const u32x2 w = pre[m][bj][n];
                        const f32x4 h = (f32x4){__uint_as_float(w.x << 16), __uint_as_float(w.x & 0xffff0000u), __uint_as_float(w.y << 16), __uint_as_float(w.y & 0xffff0000u)};
                        *(f32x4*)(out + (size_t)(row0 + ai * HALF + m * 16) * 1024 + col0 + bj * HALF + n * 16) = h + acc[ai][bj][m][n]; }
            asm volatile("" ::: "memory");
        }
    }
};
struct EpiResSq {
    static constexpr bool PERM = false, AFTER_DRAIN = false, MID = false;
    const float* base; bf16_t* hb; float* rowss;
    __device__ __forceinline__ void operator()(const f32x4 (&acc)[2][2][4][2], const Unit& u, int wr, int wc, int fr, int fq) const {
        const int row0 = u.pm * BM + wr * 64 + fr, col0 = u.pn * BM + wc * 32 + 4 * fq;
#pragma unroll
        for (int ai = 0; ai < 2; ++ai) {
            f32x4 pre[4][2][2];
#pragma unroll
            for (int m = 0; m < 4; ++m)
#pragma unroll
                for (int bj = 0; bj < 2; ++bj)
#pragma unroll
                    for (int n = 0; n < 2; ++n) pre[m][bj][n] = *(const f32x4*)(base + (size_t)(row0 + ai * HALF + m * 16) * 1024 + col0 + bj * HALF + n * 16);
            asm volatile("" ::: "memory");
#pragma unroll
            for (int m = 0; m < 4; ++m) { float s = 0.f;
#pragma unroll
                for (int bj = 0; bj < 2; ++bj)
#pragma unroll
                    for (int n = 0; n < 2; ++n) { const f32x4 h = pre[m][bj][n] + acc[ai][bj][m][n]; s += (h[0] * h[0] + h[1] * h[1]) + (h[2] * h[2] + h[3] * h[3]);
                        u32x2 w; w.x = cvt_pk_bf16(h[0], h[1]); w.y = cvt_pk_bf16(h[2], h[3]); *(u32x2*)(hb + (size_t)(row0 + ai * HALF + m * 16) * 1024 + col0 + bj * HALF + n * 16) = w; }
                s += __shfl_xor(s, 16); s += __shfl_xor(s, 32);
                if (fq == 0) __hip_atomic_fetch_add(rowss + row0 + ai * HALF + m * 16, s, __ATOMIC_RELAXED, __HIP_MEMORY_SCOPE_AGENT); }
            asm volatile("" ::: "memory");
        }
    }
};
struct EpiSwiglu {
    static constexpr bool PERM = true, AFTER_DRAIN = false, MID = false;
    bf16_t* out; int ldc; const float* rowss; float eps;
    __device__ __forceinline__ void operator()(const f32x4 (&acc)[2][2][4][2], const Unit& u, int wr, int wc, int fr, int fq) const {
        const int row0 = u.pm * BM + wr * 64 + fr, col0 = u.pn * HALF + wc * 32 + 8 * fq;
        float rs[2][4];
#pragma unroll
        for (int ai = 0; ai < 2; ++ai)
#pragma unroll
            for (int m = 0; m < 4; ++m) rs[ai][m] = rowss[row0 + ai * HALF + m * 16];
#pragma unroll
        for (int ai = 0; ai < 2; ++ai)
#pragma unroll
            for (int m = 0; m < 4; ++m) { f32x4 v[2]; const float r = 1.0f / sqrtf(rs[ai][m] * (1.0f / 1024.0f) + eps), cr = -1.4426950408889634f * r, r2 = r * r;
#pragma unroll
                for (int n = 0; n < 2; ++n) {
                    const f32x4 g4 = acc[ai][0][m][n], u4 = acc[ai][1][m][n], t = g4 * cr;
                    f32x4 d; d[0] = ex2(t[0]); d[1] = ex2(t[1]); d[2] = ex2(t[2]); d[3] = ex2(t[3]); d = d + 1.0f;
                    f32x4 s; s[0] = __builtin_amdgcn_rcpf(d[0]); s[1] = __builtin_amdgcn_rcpf(d[1]); s[2] = __builtin_amdgcn_rcpf(d[2]); s[3] = __builtin_amdgcn_rcpf(d[3]);
                    v[n] = (g4 * u4) * (s * r2); }
                *(u32x4*)(out + (size_t)(row0 + ai * HALF + m * 16) * ldc + col0) = pack8(v[0], v[1]); }
    }
};
template <class Epi, class Sched, bool ALIGN_EPI = false, bool SP2 = false>
__device__ __forceinline__ void gemm_phase(PG8_LAS unsigned char* lds, const Gemm g, const Sched& S, const Epi& E) {
    const int tid = threadIdx.x, wid = __builtin_amdgcn_readfirstlane(tid >> 6), lane = tid & 63, wr = wid >> 2, wc = wid & 3, fr = lane & 15, fq = lane >> 4;
    const int K = g.K, nt = K / BK;
    unsigned voffA[2], voffB[2];
#pragma unroll
    for (int i = 0; i < 2; ++i) { int R, C; stage_rc(tid * 16 + i * 8192, R, C); const int Rb = Epi::PERM ? ((R & ~31) + perm32(R & 31)) : R;
        voffA[i] = (unsigned)(R * g.lda + C) * 2u; voffB[i] = (unsigned)(Rb * g.ldb + C) * 2u; }
    const size_t kstep = (size_t)(BK * 2);
    const size_t hstepA = (size_t)HALF * g.lda * 2, hstepB = (size_t)HALF * g.ldb * 2;
    const size_t tstepA = 2 * hstepA, tstepB = 2 * hstepB;
    const unsigned ldsw = (unsigned)wid * 1024u;
    const int aoff = lds_byte(wr * 64 + fr, fq * 8), boff = lds_byte(wc * 32 + fr, fq * 8);
#define PG8_SA(b, h) (((b) * 2 + (h)) * HTB)
#define PG8_SB(b, h) ((4 + (b) * 2 + (h)) * HTB)
#define PG8_STAGE(bufoff, gbase, voff) do { _Pragma("unroll") for (int _i = 0; _i < 2; ++_i) \
        __builtin_amdgcn_global_load_lds((const unsigned*)((const char*)(gbase) + (voff)[_i]), (PG8_LAS unsigned*)(lds + (bufoff) + ldsw + _i * 8192), 16, 0, 0); } while (0)
#define PG8_LDA(dst, b, h) do { _Pragma("unroll") for (int m = 0; m < 4; ++m) _Pragma("unroll") for (int k = 0; k < 2; ++k) dst[m][k] = *(const PG8_LAS bf16x8*)(lds + PG8_SA(b, h) + aoff + m * 2048 + k * 1024); } while (0)
#define PG8_LDB(dst, b, h) do { _Pragma("unroll") for (int n = 0; n < 2; ++n) _Pragma("unroll") for (int k = 0; k < 2; ++k) dst[n][k] = *(const PG8_LAS bf16x8*)(lds + PG8_SB(b, h) + boff + n * 2048 + k * 1024); } while (0)
#define PG8_MMA(ai, bj, At, Bt) do { __builtin_amdgcn_s_setprio(1); _Pragma("unroll") for (int m = 0; m < 4; ++m) _Pragma("unroll") for (int n = 0; n < 2; ++n) _Pragma("unroll") for (int k = 0; k < 2; ++k) \
        acc[ai][bj][m][n] = __builtin_amdgcn_mfma_f32_16x16x32_bf16(Bt[n][k], At[m][k], acc[ai][bj][m][n], 0, 0, 0); __builtin_amdgcn_s_setprio(0); } while (0)
#define PG8_WAIT_V(n) asm volatile("s_waitcnt vmcnt(" #n ")" ::: "memory")
#define PG8_WAIT_L(n) asm volatile("s_waitcnt lgkmcnt(" #n ")" ::: "memory")
#define PG8_BAR __builtin_amdgcn_s_barrier()
#define PG8_SCHED __builtin_amdgcn_sched_barrier(0)
    Unit cur, nxt; int ui = 0;
    if (!S.next(0, cur)) return;
    f32x4 acc[2][2][4][2];
#pragma unroll
    for (int a = 0; a < 2; ++a)
#pragma unroll
        for (int b = 0; b < 2; ++b)
#pragma unroll
            for (int m = 0; m < 4; ++m)
#pragma unroll
                for (int n = 0; n < 2; ++n) acc[a][b][m][n] = (f32x4){0.f, 0.f, 0.f, 0.f};
    bf16x8 At[4][2], B0[2][2], B1[2][2];
    const char* cA = (const char*)g.A + (size_t)cur.pm * tstepA; const char* cB = (const char*)g.Bt + (size_t)cur.pn * tstepB;
    S.a_ready(cur);
    if constexpr (SP2) {
        PG8_STAGE(PG8_SB(0, 0), cB, voffB); PG8_STAGE(PG8_SB(0, 1), cB + hstepB, voffB); PG8_STAGE(PG8_SA(0, 0), cA, voffA); PG8_STAGE(PG8_SA(0, 1), cA + hstepA, voffA);
        if (wr == 1) PG8_BAR;
        PG8_WAIT_V(2); PG8_BAR;
        PG8_STAGE(PG8_SB(1, 0), cB + kstep, voffB); PG8_STAGE(PG8_SA(1, 0), cA + kstep, voffA); PG8_STAGE(PG8_SB(1, 1), cB + hstepB + kstep, voffB);
        PG8_WAIT_V(6); PG8_BAR;
    } else {
        PG8_STAGE(PG8_SB(0, 0), cB, voffB); PG8_STAGE(PG8_SA(0, 0), cA, voffA); PG8_STAGE(PG8_SB(0, 1), cB + hstepB, voffB); PG8_STAGE(PG8_SA(0, 1), cA + hstepA, voffA);
        if (wr == 1) PG8_BAR;
        PG8_WAIT_V(4); PG8_BAR;
        PG8_STAGE(PG8_SB(1, 0), cB + kstep, voffB); PG8_STAGE(PG8_SA(1, 0), cA + kstep, voffA); PG8_STAGE(PG8_SB(1, 1), cB + hstepB + kstep, voffB);
        PG8_WAIT_V(6); PG8_BAR;
    }
    for (;;) {
        const bool has_next = S.next(ui + 1, nxt);
        const char* nA = has_next ? (const char*)g.A + (size_t)nxt.pm * tstepA : cA; const char* nB = has_next ? (const char*)g.Bt + (size_t)nxt.pn * tstepB : cB;
        for (int t = 0; t < nt; t += 2) {
            if constexpr (Epi::MID) { if (t == nt / 2) E.mid(acc, cur, wr, wc, fr, fq); }
            const bool last = (t == nt - 2);
            const char* a1 = cA + (size_t)(t + 1) * kstep;
            const char* a2 = last ? nA : cA + (size_t)(t + 2) * kstep; const char* b2 = last ? nB : cB + (size_t)(t + 2) * kstep;
            const char* a3 = a2 + kstep; const char* b3 = b2 + kstep;
            if (last && has_next) S.a_ready(nxt);
            if constexpr (SP2) {
            PG8_LDB(B0, 0, 0); PG8_LDB(B1, 0, 1); PG8_SCHED; PG8_LDA(At, 0, 0); PG8_STAGE(PG8_SA(1, 1), a1 + hstepA, voffA);
            PG8_WAIT_V(8); PG8_WAIT_L(0); PG8_BAR; PG8_MMA(0, 0, At, B0); PG8_MMA(0, 1, At, B1); PG8_BAR; PG8_SCHED;
            PG8_LDA(At, 0, 1); PG8_STAGE(PG8_SB(0, 0), b2, voffB); PG8_STAGE(PG8_SB(0, 1), b2 + hstepB, voffB); PG8_STAGE(PG8_SA(0, 0), a2, voffA);
            PG8_WAIT_V(8); PG8_WAIT_L(0); PG8_BAR; PG8_MMA(1, 0, At, B0); PG8_MMA(1, 1, At, B1); PG8_BAR; PG8_SCHED;
            PG8_LDB(B0, 1, 0); PG8_LDB(B1, 1, 1); PG8_SCHED; PG8_LDA(At, 1, 0); PG8_STAGE(PG8_SA(0, 1), a2 + hstepA, voffA);
            PG8_WAIT_V(8); PG8_WAIT_L(0); PG8_BAR; PG8_MMA(0, 0, At, B0); PG8_MMA(0, 1, At, B1); PG8_BAR; PG8_SCHED;
            PG8_LDA(At, 1, 1); PG8_STAGE(PG8_SB(1, 0), b3, voffB); PG8_STAGE(PG8_SB(1, 1), b3 + hstepB, voffB); PG8_STAGE(PG8_SA(1, 0), a3, voffA);
            PG8_WAIT_V(8); PG8_WAIT_L(0); PG8_BAR; PG8_MMA(1, 0, At, B0); PG8_MMA(1, 1, At, B1); PG8_BAR; PG8_SCHED;
            } else {
            PG8_LDB(B0, 0, 0); PG8_SCHED; PG8_LDA(At, 0, 0); PG8_STAGE(PG8_SA(1, 1), a1 + hstepA, voffA);
            PG8_WAIT_L(8); PG8_BAR; PG8_WAIT_L(0); PG8_MMA(0, 0, At, B0); PG8_BAR; PG8_SCHED;
            PG8_LDB(B1, 0, 1); PG8_STAGE(PG8_SB(0, 0), b2, voffB);
            PG8_BAR; PG8_WAIT_L(0); PG8_MMA(0, 1, At, B1); PG8_BAR;
            PG8_LDA(At, 0, 1); PG8_STAGE(PG8_SA(0, 0), a2, voffA);
            PG8_BAR; PG8_WAIT_L(0); PG8_MMA(1, 0, At, B0); PG8_BAR; PG8_SCHED;
            PG8_STAGE(PG8_SB(0, 1), b2 + hstepB, voffB);
            PG8_WAIT_V(6); PG8_BAR; PG8_MMA(1, 1, At, B1); PG8_BAR;
            PG8_LDB(B0, 1, 0); PG8_SCHED; PG8_LDA(At, 1, 0); PG8_STAGE(PG8_SA(0, 1), a2 + hstepA, voffA);
            PG8_WAIT_L(8); PG8_BAR; PG8_WAIT_L(0); PG8_MMA(0, 0, At, B0); PG8_BAR; PG8_SCHED;
            PG8_LDB(B1, 1, 1); PG8_STAGE(PG8_SB(1, 0), b3, voffB);
            PG8_BAR; PG8_WAIT_L(0); PG8_MMA(0, 1, At, B1); PG8_BAR;
            PG8_LDA(At, 1, 1); PG8_STAGE(PG8_SA(1, 0), a3, voffA);
            PG8_BAR; PG8_WAIT_L(0); PG8_MMA(1, 0, At, B0); PG8_BAR; PG8_SCHED;
            PG8_STAGE(PG8_SB(1, 1), b3 + hstepB, voffB);
            PG8_WAIT_V(6); PG8_BAR; PG8_MMA(1, 1, At, B1); PG8_BAR;
            }
        }
        if constexpr (ALIGN_EPI) { if (wr == 0) PG8_BAR; }
        if constexpr (!Epi::AFTER_DRAIN) { E(acc, cur, wr, wc, fr, fq); S.done(cur); }
        if (!has_next) break;
#pragma unroll
        for (int a = 0; a < 2; ++a)
#pragma unroll
            for (int b = 0; b < 2; ++b)
#pragma unroll
                for (int m = 0; m < 4; ++m)
#pragma unroll
                    for (int n = 0; n < 2; ++n) acc[a][b][m][n] = (f32x4){0.f, 0.f, 0.f, 0.f};
        cur = nxt; cA = nA; cB = nB; ++ui;
        if constexpr (ALIGN_EPI) { if (wr == 1) PG8_BAR; }
    }
    PG8_WAIT_V(0);
    if constexpr (!ALIGN_EPI) { if (wr == 0) PG8_BAR; }
    PG8_BAR;
    if constexpr (Epi::AFTER_DRAIN) { E.fused(acc, cur, wr, wc, fr, fq, lds, wid, lane); S.done(cur); }
#undef PG8_SA
#undef PG8_SB
#undef PG8_STAGE
#undef PG8_LDA
#undef PG8_LDB
#undef PG8_MMA
#undef PG8_WAIT_V
#undef PG8_WAIT_L
#undef PG8_BAR
#undef PG8_SCHED
}
}
constexpr int NWAVES = 8;
#ifndef MK_ONE_LAUNCH
#define MK_ONE_LAUNCH 1
#endif
constexpr int N_PHASES = 8;

constexpr int BATCH = 8, SEQ = 4096, D = 1024, M = BATCH * SEQ;
constexpr int SBH = 8, SBD = 64, SBW = 512, HGH = 4, HGD = 128, HGW = 512, NIN = 5632, FFN = 2816;
constexpr float EPS = 1e-6f;
constexpr float QSCALE = 0.125f * 1.4426950408889634f;

constexpr size_t MiB = 1u << 20;
constexpr size_t WS_CTL = 0, CTL_ZERO_BYTES = 1 * MiB;
constexpr size_t WS_WIN = 1 * MiB, WS_WBR = 12 * MiB, WS_WOUT = 14 * MiB, WS_WGU = 16 * MiB, WS_WDN = 27 * MiB;
constexpr size_t WS_XN = 33 * MiB;
constexpr size_t WS_Q = 97 * MiB, WS_K = 129 * MiB, WS_V = 161 * MiB, WS_HQ = 193 * MiB, WS_LOGF = 225 * MiB, WS_HI = 289 * MiB, WS_HGG = 321 * MiB, WS_GS = 353 * MiB, WS_GH = 417 * MiB;
constexpr size_t WS_MIXED = 97 * MiB, WS_STASH = 161 * MiB;
constexpr size_t WS_ACT = 225 * MiB;
constexpr size_t WS_END = 481 * MiB;
static_assert(WS_ACT + (size_t)M * FFN * 2 <= WS_GH + 64 * MiB && WS_WDN + (size_t)D * FFN * 2 <= WS_XN, "d_ws map");
constexpr int CW_TMO = 0, CW_CODE = 1, CW_BAR = 4096, CW_SEAM = 16384;

constexpr int RING_OFF = 0, RING_BYTES = 131072;
constexpr int LDSCTL_OFF = RING_BYTES, MISC_OFF = LDSCTL_OFF + 320;
constexpr int LDS_BYTES = 147456;
#define GAS __attribute__((address_space(1)))
#define LAS __attribute__((address_space(3)))
typedef unsigned short bf16;
typedef unsigned v4u __attribute__((ext_vector_type(4)));
typedef float f32x4 __attribute__((ext_vector_type(4)));
typedef short bf16x8 __attribute__((ext_vector_type(8)));
typedef GAS unsigned gu32;
typedef GAS unsigned long long gu64;
#define RLX_AGENT __ATOMIC_RELAXED, __HIP_MEMORY_SCOPE_AGENT
#define LDS_WAIT() asm volatile("s_waitcnt lgkmcnt(0)" ::: "memory")
#define VM_WAIT() asm volatile("s_waitcnt vmcnt(0)" ::: "memory")
__device__ __forceinline__ unsigned long long rt() { return __builtin_amdgcn_s_memrealtime(); }
__device__ __forceinline__ unsigned f2bf(float f) { unsigned u = __builtin_bit_cast(unsigned, f); return (u + 0x7fffu + ((u >> 16) & 1u)) >> 16; }
__device__ __forceinline__ unsigned pk2(float lo, float hi) { return f2bf(lo) | (f2bf(hi) << 16); }

#define XB_TMO      128
#define XB_XCNT(j)  (256  + 64 * (j))
#define XB_XSUB(j)  (1280 + 64 * (j))
#define XB_XGEN(j)  (2304 + 64 * (j))
#define XB_TOP      3328
#define XB_TOPGEN   3392
#define XCD_BAR_WORDS 3456
#define XB_SPIN_CAP (1u << 18)

__device__ __forceinline__ unsigned xb_ld(unsigned* p)              { return __hip_atomic_load(p, __ATOMIC_RELAXED, __HIP_MEMORY_SCOPE_AGENT); }
__device__ __forceinline__ unsigned xb_add(unsigned* p, unsigned v) { return __hip_atomic_fetch_add(p, v, __ATOMIC_RELAXED, __HIP_MEMORY_SCOPE_AGENT); }
__device__ __forceinline__ unsigned xb_xcc_id() { return (unsigned)__builtin_amdgcn_s_getreg((3 << 11) | 20) & 0xFu; }
#define XB_SPIN(cond, bar) do { unsigned _sp = 0; while (cond) { __builtin_amdgcn_s_sleep(1); \
    if ((++_sp & 255u) == 0u) { if (xb_ld(&(bar)[XB_TMO])) break; if (_sp > XB_SPIN_CAP) { atomicAdd(&(bar)[XB_TMO], 1u); break; } } } } while (0)

struct XcdBarrier {
    unsigned* bar; unsigned x;
    volatile LAS unsigned* st;
};

__device__ __forceinline__ XcdBarrier xcd_barrier_post(unsigned* bar, volatile LAS unsigned* st) {
    XcdBarrier b; b.bar = bar; b.x = xb_xcc_id(); b.st = st;
    if (threadIdx.x == 0) (void)xb_add(&bar[XB_XCNT(b.x)], 1u);
    return b;
}
__device__ __forceinline__ void xcd_barrier_complete(unsigned* bar, unsigned x, unsigned& nloc, unsigned& nx) {
    const unsigned G = gridDim.x * gridDim.y * gridDim.z;
    unsigned sum, cnt, mine, sp = 0u;
    for (;;) {
        sum = 0u; cnt = 0u; mine = 0u;
#pragma unroll
        for (unsigned j = 0; j < 16; ++j) { const unsigned c = xb_ld(&bar[XB_XCNT(j)]); sum += c; cnt += (c > 0u) ? 1u : 0u; mine = (j == x) ? c : mine; }
        if (sum == G) break;
        __builtin_amdgcn_s_sleep(1);
        if ((++sp & 255u) == 0u) { if (xb_ld(&bar[XB_TMO])) break; if (sp > XB_SPIN_CAP) { atomicAdd(&bar[XB_TMO], 1u); break; } }
    }
    nloc = mine > 0u ? mine : 1u; nx = cnt > 0u ? cnt : 1u;
}

__device__ __forceinline__ void xcd_barrier(const XcdBarrier& b) {
    asm volatile("s_waitcnt vmcnt(0)" ::: "memory");
    __syncthreads();
    if (threadIdx.x == 0) {
        unsigned* bar = b.bar;
        __builtin_amdgcn_s_waitcnt(0);
        unsigned nloc = b.st[0], nx = b.st[1];
        if (nloc == 0u) { xcd_barrier_complete(bar, b.x, nloc, nx); b.st[0] = nloc; b.st[1] = nx; }
        const unsigned old = xb_add(&bar[XB_XSUB(b.x)], 1u);
        const unsigned gen = old / nloc;
        if (old + 1u == (gen + 1u) * nloc) {
            __builtin_amdgcn_fence(__ATOMIC_RELEASE, "agent");
            asm volatile("s_waitcnt vmcnt(0)" ::: "memory");
            const unsigned og = xb_add(&bar[XB_TOP], 1u);
            const unsigned tg = og / nx;
            if (og + 1u == (tg + 1u) * nx) xb_add(&bar[XB_TOPGEN], 1u);
            else XB_SPIN(xb_ld(&bar[XB_TOPGEN]) == tg, bar);
            __builtin_amdgcn_fence(__ATOMIC_ACQUIRE, "agent");
            xb_add(&bar[XB_XGEN(b.x)], 1u);
            asm volatile("s_waitcnt vmcnt(0)" ::: "memory");
        } else {
            XB_SPIN(xb_ld(&bar[XB_XGEN(b.x)]) == gen, bar);
            __builtin_amdgcn_fence(__ATOMIC_ACQUIRE, "agent");
            asm volatile("s_waitcnt vmcnt(0)" ::: "memory");
        }
    }
    __syncthreads();
}
struct Frame {
    LAS unsigned char* lds; volatile LAS unsigned* MISC; gu32* ctl;
    int tid, lane, wave, vcu, G;
    const float *x, *n1g, *w_in, *gq, *gk, *lbt, *hgn, *w_br, *w_out, *n2g, *w_gate, *w_up, *w_dn; float* out;
    bf16 *WIN, *WBR, *WOUT, *WGU, *WDN, *XN, *Q, *K, *V, *HQ, *HI, *HGG, *GS, *GH, *MIXED, *STASH, *ACT; float* LOGF;
};
__device__ __forceinline__ float wave_sum(float v) {
#pragma unroll
    for (int o = 1; o < 64; o <<= 1) v += __shfl_xor(v, o);
    return v;
}
__device__ __forceinline__ float bf2f(unsigned short h) { return __uint_as_float((unsigned)h << 16); }
__device__ __forceinline__ void p0_transpose_item(const float* W, int Nsrc, int ns, bf16* WT, int ldd, int nd, int k0, LAS float* scr, int lane, const float* kscale = nullptr) {
    { float wv[32];
#pragma unroll
      for (int i = 0; i < 32; ++i) { const int kk = 2 * i + (lane >> 5); wv[i] = W[(size_t)(k0 + kk) * Nsrc + ns + (lane & 31)]; }
      if (kscale) {
#pragma unroll
          for (int i = 0; i < 32; ++i) wv[i] *= kscale[k0 + 2 * i + (lane >> 5)]; }
#pragma unroll
      for (int i = 0; i < 32; ++i) { const int kk = 2 * i + (lane >> 5); scr[kk * 33 + (lane & 31)] = wv[i]; } }
    LDS_WAIT(); asm volatile("" ::: "memory");
    const int c = lane & 7;
#pragma unroll
    for (int j = 0; j < 4; ++j) { const int n = (lane >> 3) + 8 * j; const LAS float* s = scr + (8 * c) * 33 + n;
        v4u o; o.x = pk2(s[0 * 33], s[1 * 33]); o.y = pk2(s[2 * 33], s[3 * 33]); o.z = pk2(s[4 * 33], s[5 * 33]); o.w = pk2(s[6 * 33], s[7 * 33]);
        *(GAS v4u*)(WT + (size_t)(nd + n) * ldd + k0 + 8 * c) = o; }
    LDS_WAIT(); asm volatile("" ::: "memory");
}
template <int PART> __device__ __forceinline__ void p0_prologue(Frame& F) {
    LAS float* scr = (LAS float*)(F.lds + RING_OFF + F.wave * 16384);
    const int gw = PART == 0 ? F.vcu * NWAVES + F.wave : (((int)blockIdx.x >> 4) * 8 + ((int)blockIdx.x & 7)) * NWAVES + F.wave, NGW = PART == 0 ? F.G * NWAVES : (F.G / 2) * NWAVES;
    constexpr int I_IN = 16 * 176, I_BR = 16 * 32, I_OUT = 16 * 32, I_G = 16 * 88, I_U = 16 * 88, I_DN = 44 * 32;
    constexpr int NITEMS = I_IN + I_BR + I_OUT + I_G + I_U + I_DN;
    for (int it = (PART == 0 ? gw : I_IN + gw); it < (PART == 0 ? I_IN : NITEMS); it += NGW) {
        int r = it;
        if (r < I_IN) { const int kb = r / 176, nb = r % 176; int sb = nb;
            if (nb < 32) { const int pn = nb >> 3, rem = nb & 7, bj = rem >> 2, wc = rem & 3; sb = 8 * pn + 2 * wc + bj; }
            p0_transpose_item(F.w_in, NIN, 32 * sb, F.WIN, D, 32 * nb, 64 * kb, scr, F.lane); continue; } r -= I_IN;
        if (r < I_BR) { p0_transpose_item(F.w_br, D, 32 * (r % 32), F.WBR, D, 32 * (r % 32), 64 * (r / 32), scr, F.lane); continue; } r -= I_BR;
        if (r < I_OUT) { p0_transpose_item(F.w_out, D, 32 * (r % 32), F.WOUT, D, 32 * (r % 32), 64 * (r / 32), scr, F.lane); continue; } r -= I_OUT;
        if (r < I_G + I_U) { const bool up = r >= I_G; if (up) r -= I_G; const int kb = r / 88, sb = r % 88;
            p0_transpose_item(up ? F.w_up : F.w_gate, FFN, 32 * sb, F.WGU, D, 256 * (sb >> 2) + (up ? 128 : 0) + 32 * (sb & 3), 64 * kb, scr, F.lane, F.n2g); continue; } r -= I_G + I_U;
        p0_transpose_item(F.w_dn, D, 32 * (r % 32), F.WDN, FFN, 32 * (r % 32), 64 * (r / 32), scr, F.lane);
    }
    if (PART == 0) {
        const GAS f32x4* gr = (const GAS f32x4*)F.n1g + F.lane; f32x4 gv[4];
#pragma unroll
        for (int j = 0; j < 4; ++j) gv[j] = gr[64 * j];
        for (int m0 = gw * 8; m0 < M; m0 += NGW * 8) {
            f32x4 v[8][4];
#pragma unroll
            for (int r = 0; r < 8; ++r)
#pragma unroll
                for (int j = 0; j < 4; ++j) v[r][j] = ((const GAS f32x4*)(F.x + (size_t)(m0 + r) * D) + F.lane)[64 * j];
#pragma unroll
            for (int r = 0; r < 8; ++r) { float s = 0.f;
#pragma unroll
                for (int j = 0; j < 4; ++j) s += (v[r][j].x * v[r][j].x + v[r][j].y * v[r][j].y) + (v[r][j].z * v[r][j].z + v[r][j].w * v[r][j].w);
                const float rs = 1.0f / sqrtf(wave_sum(s) * (1.0f / 1024.0f) + EPS);
                GAS unsigned long long* o8 = (GAS unsigned long long*)(F.XN + (size_t)(m0 + r) * D) + F.lane;
#pragma unroll
                for (int j = 0; j < 4; ++j) o8[64 * j] = (unsigned long long)pk2(v[r][j].x * rs * gv[j].x, v[r][j].y * rs * gv[j].y) | ((unsigned long long)pk2(v[r][j].z * rs * gv[j].z, v[r][j].w * rs * gv[j].w) << 32); }
        }
    }
}

namespace sba {
typedef short bf16x8 __attribute__((ext_vector_type(8)));
typedef short s16x4 __attribute__((ext_vector_type(4)));
typedef float f32x16 __attribute__((ext_vector_type(16)));
typedef unsigned u32x4 __attribute__((ext_vector_type(4)));
typedef unsigned u32x2 __attribute__((ext_vector_type(2)));
#define SBA_MFMA(a, b, c) __builtin_amdgcn_mfma_f32_32x32x16_bf16((a), (b), (c), 0, 0, 0)
__device__ __forceinline__ int crow(int r, int hi) { return (r & 3) + 8 * (r >> 2) + 4 * hi; }
__device__ __forceinline__ bf16x8 pack_step(const f32x16& x, int s) {
    u32x4 p; p.x = pg8::cvt_pk_bf16(x[8 * s], x[8 * s + 1]); p.y = pg8::cvt_pk_bf16(x[8 * s + 2], x[8 * s + 3]); p.z = pg8::cvt_pk_bf16(x[8 * s + 4], x[8 * s + 5]); p.w = pg8::cvt_pk_bf16(x[8 * s + 6], x[8 * s + 7]);
    return __builtin_bit_cast(bf16x8, p); }
typedef short v4i16_t __attribute__((ext_vector_type(4)));
__device__ __forceinline__ s16x4 vtr(LAS const unsigned char* p) { return __builtin_bit_cast(s16x4, __builtin_amdgcn_ds_read_tr16_b64_v4i16((LAS v4i16_t*)p)); }

__device__ __forceinline__ void attn_phase(Frame& F) {
    const int lane = F.lane, r32 = lane & 31, hi = lane >> 5;
    LAS unsigned char* vst = F.lds + F.wave * 8192;
    LAS const unsigned char* vp0 = vst + ((lane >> 4) & 1) * 32 + (lane & 3) * 8 + (4 * hi + ((lane & 15) >> 2)) * 64;
    float gm = fabsf(F.gq[lane]), km = fabsf(F.gk[lane]);
#pragma unroll
    for (int o = 1; o < 64; o <<= 1) { gm = fmaxf(gm, __shfl_xor(gm, o)); km = fmaxf(km, __shfl_xor(km, o)); }
    const float THR = 152.0f + 1.02f * (QSCALE * 64.0f) * gm * km;
    bf16x8 tf0, tf1, ones;
#pragma unroll
    for (int j = 0; j < 8; ++j) { const int k0 = 8 * (j >> 2) + 4 * hi + (j & 3); tf0[j] = (k0 >= r32) ? (short)0x3F80 : (short)0; tf1[j] = (16 + k0 >= r32) ? (short)0x3F80 : (short)0; ones[j] = (short)0x3F80; }
    const int gw = F.vcu * NWAVES + F.wave, NGW = F.G * NWAVES;
    for (int u = gw; u < BATCH * SBH * (SEQ / 32); u += NGW) {
        const int bh = u >> 7, qblk = u & 127, b = bh >> 3, h = bh & 7, t0 = qblk * 32;
        const size_t rowb = (size_t)b * SEQ;
        bf16x8 qf[4];
        { const bf16* qp = F.Q + (rowb + t0 + r32) * SBW + h * 64 + 8 * hi;
#pragma unroll
          for (int d0 = 0; d0 < 4; ++d0) qf[d0] = *(const GAS bf16x8*)(qp + 16 * d0); }
        const bf16* kbase = F.K + rowb * SBW + h * 64 + 8 * hi; const bf16* vbase = F.V + rowb * SBW + h * 64 + (lane & 7) * 8;
        f32x16 o0, o1;
#pragma unroll
        for (int r = 0; r < 16; ++r) { o0[r] = 0.f; o1[r] = 0.f; }
        float Rc = 0.f;
        int kt = t0 >> 6; const int qrel = (t0 & 63) + r32; bool diag = true;
        bf16x8 kn[2][4]; u32x4 vn[8];
#define SBA_LOAD(KT) do { _Pragma("unroll") for (int hf = 0; hf < 2; ++hf) _Pragma("unroll") for (int d0 = 0; d0 < 4; ++d0) kn[hf][d0] = *(const GAS bf16x8*)(kbase + (size_t)(64 * (KT) + 32 * hf + r32) * SBW + 16 * d0); \
        _Pragma("unroll") for (int i = 0; i < 8; ++i) vn[i] = *(const GAS u32x4*)(vbase + (size_t)(64 * (KT) + 8 * i + (lane >> 3)) * SBW); } while (0)
        SBA_LOAD(kt);
        for (;;) {
#pragma unroll
            for (int i = 0; i < 8; ++i) { const int key = 8 * i + (lane >> 3), ch = lane & 7; *(LAS u32x4*)(vst + (ch >> 2) * 4096 + (key >> 4) * 1024 + (key & 15) * 64 + (ch & 3) * 16) = vn[i]; }
            bf16x8 kc[2][4];
#pragma unroll
            for (int hf = 0; hf < 2; ++hf)
#pragma unroll
                for (int d0 = 0; d0 < 4; ++d0) kc[hf][d0] = kn[hf][d0];
            if (kt > 0) SBA_LOAD(kt - 1);
            f32x16 z0, z1;
#pragma unroll
            for (int r = 0; r < 16; ++r) { z0[r] = 0.f; z1[r] = 0.f; }
#pragma unroll
            for (int d0 = 0; d0 < 4; ++d0) { z0 = SBA_MFMA(kc[0][d0], qf[d0], z0); z1 = SBA_MFMA(kc[1][d0], qf[d0], z1); }
            f32x16 s0, s1;
#pragma unroll
            for (int r = 0; r < 16; ++r) {
                s0[r] = __builtin_amdgcn_logf(1.0f + __builtin_amdgcn_exp2f(z0[r])); s1[r] = __builtin_amdgcn_logf(1.0f + __builtin_amdgcn_exp2f(z1[r]));
                if (diag) { if (crow(r, hi) >= qrel) s0[r] = 0.f; if (32 + crow(r, hi) >= qrel) s1[r] = 0.f; } }
            const bf16x8 x00 = pack_step(s0, 0), x01 = pack_step(s0, 1), x10 = pack_step(s1, 0), x11 = pack_step(s1, 1);
            f32x16 c0, c1;
#pragma unroll
            for (int r = 0; r < 16; ++r) { c0[r] = Rc; c1[r] = Rc; }
            c0 = SBA_MFMA(tf0, x00, c0); c0 = SBA_MFMA(tf1, x01, c0); c0 = SBA_MFMA(ones, x10, c0); c0 = SBA_MFMA(ones, x11, c0);
            c1 = SBA_MFMA(tf0, x10, c1); c1 = SBA_MFMA(tf1, x11, c1);
#pragma unroll
            for (int r = 0; r < 16; ++r) {
                z0[r] = __builtin_amdgcn_exp2f(z0[r] - c0[r]); z1[r] = __builtin_amdgcn_exp2f(z1[r] - c1[r]);
                if (diag) { if (crow(r, hi) >= qrel) z0[r] = 0.f; if (32 + crow(r, hi) >= qrel) z1[r] = 0.f; } }
            const bf16x8 w0 = pack_step(z0, 0), w1 = pack_step(z0, 1), w2 = pack_step(z1, 0), w3 = pack_step(z1, 1);
#pragma unroll
            for (int db = 0; db < 2; ++db) {
                s16x4 lo[4], hh[4];
#pragma unroll
                for (int ks = 0; ks < 4; ++ks) { lo[ks] = vtr(vp0 + db * 4096 + ks * 1024); hh[ks] = vtr(vp0 + db * 4096 + ks * 1024 + 512); }
#define SBA_VF(k) (bf16x8){lo[k][0], lo[k][1], lo[k][2], lo[k][3], hh[k][0], hh[k][1], hh[k][2], hh[k][3]}
                if (db == 0) { o0 = SBA_MFMA(SBA_VF(0), w0, o0); o0 = SBA_MFMA(SBA_VF(1), w1, o0); o0 = SBA_MFMA(SBA_VF(2), w2, o0); o0 = SBA_MFMA(SBA_VF(3), w3, o0); }
                else         { o1 = SBA_MFMA(SBA_VF(0), w0, o1); o1 = SBA_MFMA(SBA_VF(1), w1, o1); o1 = SBA_MFMA(SBA_VF(2), w2, o1); o1 = SBA_MFMA(SBA_VF(3), w3, o1); }
#undef SBA_VF
            }
            Rc = __shfl(c0[0], r32);
            if (kt == 0) break;
            if (__all(Rc >= THR)) break;
            --kt; diag = false;
        }
#undef SBA_LOAD
        bf16* op = F.XN + (rowb + t0 + r32) * D + h * 64 + 4 * hi;
#pragma unroll
        for (int g = 0; g < 4; ++g) {
            u32x2 a, c; a.x = pg8::cvt_pk_bf16(o0[4 * g], o0[4 * g + 1]); a.y = pg8::cvt_pk_bf16(o0[4 * g + 2], o0[4 * g + 3]); c.x = pg8::cvt_pk_bf16(o1[4 * g], o1[4 * g + 1]); c.y = pg8::cvt_pk_bf16(o1[4 * g + 2], o1[4 * g + 3]);
            *(GAS u32x2*)(op + 8 * g) = a; *(GAS u32x2*)(op + 32 + 8 * g) = c; }
    }
}
#undef SBA_MFMA
}

namespace hg {
typedef short bf16x8 __attribute__((ext_vector_type(8)));
typedef short s16x4 __attribute__((ext_vector_type(4)));
typedef float f32x16 __attribute__((ext_vector_type(16)));
typedef unsigned u32x4 __attribute__((ext_vector_type(4)));
typedef unsigned u32x2 __attribute__((ext_vector_type(2)));
#define HG_MFMA(a, b, c) __builtin_amdgcn_mfma_f32_32x32x16_bf16((a), (b), (c), 0, 0, 0)
constexpr float LOG2E = 1.4426950408889634f;
__device__ __forceinline__ int imgoff(int row, int ch) { return 256 * row + 16 * (ch ^ (((row & 3) << 2) | ((row >> 2) & 3))); }
__device__ __forceinline__ int crow(int r, int hi) { return (r & 3) + 8 * (r >> 2) + 4 * hi; }
__device__ __forceinline__ s16x4 vtr(LAS const unsigned char* p) { return __builtin_bit_cast(s16x4, __builtin_amdgcn_ds_read_tr16_b64_v4i16((LAS sba::v4i16_t*)p)); }
__device__ __forceinline__ bf16x8 cat8(s16x4 lo, s16x4 hh) { return (bf16x8){lo[0], lo[1], lo[2], lo[3], hh[0], hh[1], hh[2], hh[3]}; }
__device__ __forceinline__ bf16x8 trfrag(LAS const unsigned char* img, int r0, int r1, int c, int lane) {
    const int blk = (lane >> 4) & 1, q = (lane & 15) >> 2, p = lane & 3, ch = 4 * c + 2 * blk + (p >> 1), by = 8 * (p & 1);
    return cat8(vtr(img + imgoff(r0 + q, ch) + by), vtr(img + imgoff(r1 + q, ch) + by));
}
__device__ __forceinline__ bf16x8 rowfrag(LAS const unsigned char* img, int row, int ch) { return *(const LAS bf16x8*)(img + imgoff(row, ch)); }
__device__ __forceinline__ u32x2 pack4(float a, float b, float c, float d) { u32x2 w; w.x = pg8::cvt_pk_bf16(a, b); w.y = pg8::cvt_pk_bf16(c, d); return w; }
__device__ __forceinline__ f32x4 unpack4(u32x2 w) { return (f32x4){__uint_as_float(w.x << 16), __uint_as_float(w.x & 0xffff0000u), __uint_as_float(w.y << 16), __uint_as_float(w.y & 0xffff0000u)}; }
__device__ __forceinline__ bf16x8 pack_step(const f32x16& x, int s) { return sba::pack_step(x, s); }
__device__ __forceinline__ f32x4 vexp2(const f32x4 x) { return (f32x4){__builtin_amdgcn_exp2f(x[0]), __builtin_amdgcn_exp2f(x[1]), __builtin_amdgcn_exp2f(x[2]), __builtin_amdgcn_exp2f(x[3])}; }
__device__ __forceinline__ f32x4 vrcp(const f32x4 x) { return (f32x4){__builtin_amdgcn_rcpf(x[0]), __builtin_amdgcn_rcpf(x[1]), __builtin_amdgcn_rcpf(x[2]), __builtin_amdgcn_rcpf(x[3])}; }
__device__ __forceinline__ f32x4 vlog2(const f32x4 x) { return (f32x4){__builtin_amdgcn_logf(x[0]), __builtin_amdgcn_logf(x[1]), __builtin_amdgcn_logf(x[2]), __builtin_amdgcn_logf(x[3])}; }
__device__ __forceinline__ f32x4 vsigm(const f32x4 x) { return vrcp(vexp2(x * -1.4426950408889634f) + 1.0f); }


constexpr int NUNIT = BATCH * HGH * (SEQ / 64);
__device__ __forceinline__ f32x4 gl_of(const f32x4 x, const f32x4 lb, f32x4& km) {
    const f32x4 f = lb + (1.0f - lb) * vsigm(x); km = 1.0f - f; return vlog2(f); }
constexpr int NSEG = BATCH * HGH * 8;
__device__ __forceinline__ void pass1(Frame& F, bf16* L, float* Dl) {
    const int tid = F.tid, lane = F.lane, kq = tid & 31, tq = tid >> 5, r32 = lane & 31, hi = lane >> 5;
    LAS unsigned char* imgK = F.lds; LAS unsigned char* imgV = F.lds + 16384; LAS float* SEG = (LAS float*)(F.lds + 32768); LAS float* DLS = (LAS float*)(F.lds + 40960);
    const int vb = F.wave & 3, kp = F.wave >> 2;
    u32x2 gx[4]; u32x4 vv[2];
#define HG_P1_LOAD(UNIT) do { const int bh_ = (UNIT) >> 6, c_ = (UNIT) & 63, b_ = bh_ >> 2, h_ = bh_ & 3; const size_t r0_ = (size_t)b_ * SEQ + c_ * 64; \
        _Pragma("unroll") for (int i = 0; i < 4; ++i) gx[i] = *(const GAS u32x2*)((const bf16*)F.LOGF + (r0_ + 4 * tq + i) * HGW + h_ * 128 + 4 * kq); \
        _Pragma("unroll") for (int j = 0; j < 2; ++j) { const int id = tid + 512 * j; vv[j] = *(const GAS u32x4*)(F.HI + (r0_ + (id >> 4)) * HGW + h_ * 128 + 8 * (id & 15)); } } while (0)
    for (int seg = F.vcu; seg < NSEG; seg += F.G) {
        const int h = (seg >> 3) & 3, unit0 = seg * 8;
        f32x4 lb; { const f32x4 t0 = *(const GAS f32x4*)(F.lbt + h * 128 + 4 * kq), t1 = *(const GAS f32x4*)(F.lbt + 512 + h * 128 + 4 * kq);
#pragma unroll
            for (int j = 0; j < 4; ++j) lb[j] = pg8::sigm(t0[j] - t1[j]); }
        f32x16 acc0, acc1; f32x4 dsum = (f32x4){0.f, 0.f, 0.f, 0.f};
#pragma unroll
        for (int r = 0; r < 16; ++r) { acc0[r] = 0.f; acc1[r] = 0.f; }
        HG_P1_LOAD(unit0);
        for (int cc = 0; cc < 8; ++cc) {
            f32x4 g[4], km[4];
#pragma unroll
            for (int i = 0; i < 4; ++i) g[i] = gl_of(unpack4(gx[i]), lb, km[i]);
#pragma unroll
            for (int j = 0; j < 2; ++j) { const int id = tid + 512 * j, row = id >> 4, ch = id & 15; *(LAS u32x4*)(imgV + imgoff(row, ch)) = vv[j]; }
            asm volatile("" : "+v"(g[0]), "+v"(g[1]), "+v"(g[2]), "+v"(g[3]), "+v"(km[0]), "+v"(km[1]), "+v"(km[2]), "+v"(km[3]) :: "memory");
            __builtin_amdgcn_sched_barrier(0); { const int nu = cc < 7 ? unit0 + cc + 1 : unit0 + cc; HG_P1_LOAD(nu); } __builtin_amdgcn_sched_barrier(0);
            f32x4 rs[4]; rs[3] = (f32x4){0.f, 0.f, 0.f, 0.f}; rs[2] = g[3]; rs[1] = g[3] + g[2]; rs[0] = rs[1] + g[1];
            const f32x4 tot = rs[0] + g[0];
            *(LAS f32x4*)(SEG + tq * 128 + 4 * kq) = tot;
            asm volatile("s_waitcnt lgkmcnt(0)" ::: "memory"); __builtin_amdgcn_s_barrier(); asm volatile("" ::: "memory");
            f32x4 suf = (f32x4){0.f, 0.f, 0.f, 0.f}, all = (f32x4){0.f, 0.f, 0.f, 0.f};
#pragma unroll
            for (int s = 0; s < 16; ++s) { const f32x4 t = *(const LAS f32x4*)(SEG + s * 128 + 4 * kq); all += t; if (s > tq) suf += t; }
#pragma unroll
            for (int i = 0; i < 4; ++i) { const f32x4 kh = km[i] * vexp2(suf + rs[i]);
                *(LAS u32x2*)(imgK + imgoff(4 * tq + i, kq >> 1) + 8 * (kq & 1)) = pack4(kh[0], kh[1], kh[2], kh[3]); }
            if (tq == 0) { *(LAS f32x4*)(DLS + 4 * kq) = all; dsum += all; }
            asm volatile("s_waitcnt lgkmcnt(0)" ::: "memory"); __builtin_amdgcn_s_barrier(); asm volatile("" ::: "memory");
            { const float d0 = __builtin_amdgcn_exp2f(DLS[64 * kp + r32]), d1 = __builtin_amdgcn_exp2f(DLS[64 * kp + 32 + r32]);
#pragma unroll
              for (int r = 0; r < 16; ++r) { acc0[r] *= d0; acc1[r] *= d1; } }
#pragma unroll
            for (int ks = 0; ks < 4; ++ks) {
                const bf16x8 af = trfrag(imgV, 16 * ks + 8 * hi, 16 * ks + 8 * hi + 4, vb, lane);
                acc0 = HG_MFMA(af, trfrag(imgK, 16 * ks + 8 * hi, 16 * ks + 8 * hi + 4, 2 * kp, lane), acc0);
                acc1 = HG_MFMA(af, trfrag(imgK, 16 * ks + 8 * hi, 16 * ks + 8 * hi + 4, 2 * kp + 1, lane), acc1);
            }
            asm volatile("s_waitcnt lgkmcnt(0)" ::: "memory"); __builtin_amdgcn_s_barrier(); asm volatile("" ::: "memory");
        }
        bf16* lp = L + (size_t)seg * 16384 + 32 * vb + 4 * hi;
#pragma unroll
        for (int gq = 0; gq < 4; ++gq) {
            *(GAS u32x2*)(lp + (size_t)(64 * kp + r32) * 128 + 8 * gq) = pack4(acc0[4 * gq], acc0[4 * gq + 1], acc0[4 * gq + 2], acc0[4 * gq + 3]);
            *(GAS u32x2*)(lp + (size_t)(64 * kp + 32 + r32) * 128 + 8 * gq) = pack4(acc1[4 * gq], acc1[4 * gq + 1], acc1[4 * gq + 2], acc1[4 * gq + 3]); }
        if (tq == 0) *(GAS f32x4*)(Dl + (size_t)seg * 128 + 4 * kq) = dsum;
    }
#undef HG_P1_LOAD
}
__device__ __forceinline__ void pass3(Frame& F, const bf16* Lseg, const float* Dseg) {
    const int tid = F.tid, lane = F.lane, kq = tid & 31, tq = tid >> 5, r32 = lane & 31, hi = lane >> 5;
    LAS unsigned char* imgQT = F.lds; LAS unsigned char* imgKT = F.lds + 16384; LAS unsigned char* imgQH = F.lds + 32768; LAS unsigned char* imgV = F.lds + 49152; LAS unsigned char* imgS = F.lds + 65536;
    LAS unsigned char* imgKH = F.lds + 98304; LAS float* SEG = (LAS float*)(F.lds + 114688); LAS float* RSS = (LAS float*)(F.lds + 122880); LAS float* DLS = (LAS float*)(F.lds + 123904);
    const int tb = F.wave >> 2, vb = F.wave & 3, kp = F.wave >> 2;
    u32x2 gx[4]; u32x2 qw[4]; u32x4 vv[2];
#define HG_P3_LOAD(UNIT) do { const int bh_ = (UNIT) >> 6, c_ = (UNIT) & 63, b_ = bh_ >> 2, h_ = bh_ & 3; const size_t r0_ = (size_t)b_ * SEQ + c_ * 64; \
        _Pragma("unroll") for (int i = 0; i < 4; ++i) { gx[i] = *(const GAS u32x2*)((const bf16*)F.LOGF + (r0_ + 4 * tq + i) * HGW + h_ * 128 + 4 * kq); qw[i] = *(const GAS u32x2*)(F.HQ + (r0_ + 4 * tq + i) * HGW + h_ * 128 + 4 * kq); } \
        _Pragma("unroll") for (int j = 0; j < 2; ++j) { const int id = tid + 512 * j; vv[j] = *(const GAS u32x4*)(F.HI + (r0_ + (id >> 4)) * HGW + h_ * 128 + 8 * (id & 15)); } } while (0)
    for (int seg = F.vcu; seg < NSEG; seg += F.G) {
        const int bh = seg >> 3, sj = seg & 7, b = bh >> 2, h = bh & 3, unit0 = seg * 8;
        HG_P3_LOAD(unit0);
        f32x4 lb; { const f32x4 t0 = *(const GAS f32x4*)(F.lbt + h * 128 + 4 * kq), t1 = *(const GAS f32x4*)(F.lbt + 512 + h * 128 + 4 * kq);
#pragma unroll
            for (int j = 0; j < 4; ++j) lb[j] = pg8::sigm(t0[j] - t1[j]); }
        f32x16 acc0, acc1;
#pragma unroll
        for (int r = 0; r < 16; ++r) { acc0[r] = 0.f; acc1[r] = 0.f; }
        if (sj > 0) {
            float d0v[7], d1v[7]; u32x2 l0v[7][4], l1v[7][4];
#pragma unroll
            for (int i = 0; i < 7; ++i) { const int sg = bh * 8 + (i < sj ? i : sj - 1);
                d0v[i] = Dseg[(size_t)sg * 128 + 64 * kp + r32]; d1v[i] = Dseg[(size_t)sg * 128 + 64 * kp + 32 + r32];
                const bf16* lp = Lseg + (size_t)sg * 16384 + 32 * vb + 4 * hi;
#pragma unroll
                for (int gq = 0; gq < 4; ++gq) { l0v[i][gq] = *(const GAS u32x2*)(lp + (size_t)(64 * kp + r32) * 128 + 8 * gq); l1v[i][gq] = *(const GAS u32x2*)(lp + (size_t)(64 * kp + 32 + r32) * 128 + 8 * gq); } }
#pragma unroll
            for (int i = 0; i < 7; ++i) { const bool on = i < sj; const float d0 = on ? __builtin_amdgcn_exp2f(d0v[i]) : 1.0f, d1 = on ? __builtin_amdgcn_exp2f(d1v[i]) : 1.0f;
#pragma unroll
                for (int gq = 0; gq < 4; ++gq) { const f32x4 l0 = unpack4(l0v[i][gq]), l1 = unpack4(l1v[i][gq]);
#pragma unroll
                    for (int j = 0; j < 4; ++j) { acc0[4 * gq + j] = acc0[4 * gq + j] * d0 + (on ? l0[j] : 0.f); acc1[4 * gq + j] = acc1[4 * gq + j] * d1 + (on ? l1[j] : 0.f); } } }
        }
        for (int cc = 0; cc < 8; ++cc) {
            int lane_o = F.lane; asm volatile("" : "+v"(lane_o));
            const int lane = lane_o, r32 = lane & 31, hi = lane >> 5;
            const int c = sj * 8 + cc; const size_t row0 = (size_t)b * SEQ + c * 64;
            const size_t orow = row0 + 32 * tb + r32;
            u32x2 gtw[4]; f32x4 gnv[4];
#pragma unroll
            for (int gq = 0; gq < 4; ++gq) { gtw[gq] = *(const GAS u32x2*)(F.HGG + orow * HGW + h * 128 + 32 * vb + 8 * gq + 4 * hi); gnv[gq] = *(const GAS f32x4*)(F.hgn + 32 * vb + 8 * gq + 4 * hi); }
            f32x4 g[4], km[4]; f32x4 qv[4];
#pragma unroll
            for (int i = 0; i < 4; ++i) { g[i] = gl_of(unpack4(gx[i]), lb, km[i]); const f32x4 qr = unpack4(qw[i]); qv[i] = qr * vsigm(qr); }
#pragma unroll
            for (int j = 0; j < 2; ++j) { const int id = tid + 512 * j, row = id >> 4, ch = id & 15; *(LAS u32x4*)(imgV + imgoff(row, ch)) = vv[j]; }
#pragma unroll
            for (int gq = 0; gq < 4; ++gq) {
                *(LAS u32x2*)(imgS + imgoff(64 * kp + r32, 4 * vb + gq) + 8 * hi) = pack4(acc0[4 * gq], acc0[4 * gq + 1], acc0[4 * gq + 2], acc0[4 * gq + 3]);
                *(LAS u32x2*)(imgS + imgoff(64 * kp + 32 + r32, 4 * vb + gq) + 8 * hi) = pack4(acc1[4 * gq], acc1[4 * gq + 1], acc1[4 * gq + 2], acc1[4 * gq + 3]); }
            asm volatile("" : "+v"(g[0]), "+v"(g[1]), "+v"(g[2]), "+v"(g[3]), "+v"(qv[0]), "+v"(qv[1]), "+v"(qv[2]), "+v"(qv[3]), "+v"(km[0]), "+v"(km[1]), "+v"(km[2]), "+v"(km[3]) :: "memory");
            __builtin_amdgcn_sched_barrier(0); { const int nu = cc < 7 ? unit0 + cc + 1 : unit0 + cc; HG_P3_LOAD(nu); } __builtin_amdgcn_sched_barrier(0);
            *(LAS f32x4*)(SEG + tq * 128 + 4 * kq) = (g[0] + g[1]) + (g[2] + g[3]);
            asm volatile("s_waitcnt lgkmcnt(0)" ::: "memory"); __builtin_amdgcn_s_barrier(); asm volatile("" ::: "memory");
            f32x4 pre = (f32x4){0.f, 0.f, 0.f, 0.f}, ref = (f32x4){0.f, 0.f, 0.f, 0.f}, all = (f32x4){0.f, 0.f, 0.f, 0.f};
#pragma unroll
            for (int s8 = 0; s8 < 16; s8 += 4) { f32x4 sg[4];
#pragma unroll
              for (int s = 0; s < 4; ++s) sg[s] = *(const LAS f32x4*)(SEG + (s8 + s) * 128 + 4 * kq);
#pragma unroll
              for (int s = 0; s < 4; ++s) { all += sg[s]; if (s8 + s < tq) pre += sg[s]; if (s8 + s < 8) ref += sg[s]; } }
            f32x4 c1, c2;
            c1 = vexp2(ref); c2 = vexp2(all - ref);
#pragma unroll
            for (int i = 0; i < 4; ++i) { pre += g[i];
                const f32x4 dq = pre - ref, qt = qv[i] * vexp2(dq), kt = km[i] * vexp2(-dq), qh = qt * c1, kh = kt * c2;
                const int o = imgoff(4 * tq + i, kq >> 1) + 8 * (kq & 1);
                *(LAS u32x2*)(imgQT + o) = pack4(qt[0], qt[1], qt[2], qt[3]); *(LAS u32x2*)(imgKT + o) = pack4(kt[0], kt[1], kt[2], kt[3]); *(LAS u32x2*)(imgQH + o) = pack4(qh[0], qh[1], qh[2], qh[3]);
                *(LAS u32x2*)(imgKH + o) = pack4(kh[0], kh[1], kh[2], kh[3]); }
            if (tq == 0) *(LAS f32x4*)(DLS + 4 * kq) = all;
            asm volatile("s_waitcnt lgkmcnt(0)" ::: "memory"); __builtin_amdgcn_s_barrier(); asm volatile("" ::: "memory");
            f32x16 o;
#pragma unroll
            for (int r = 0; r < 16; ++r) o[r] = 0.f;
#pragma unroll
            for (int k4 = 0; k4 < 8; k4 += 4) { bf16x8 sa[4], qb[4];
#pragma unroll
              for (int ks = 0; ks < 4; ++ks) { sa[ks] = trfrag(imgS, 16 * (k4 + ks) + 8 * hi, 16 * (k4 + ks) + 8 * hi + 4, vb, lane); qb[ks] = rowfrag(imgQH, 32 * tb + r32, 2 * (k4 + ks) + hi); }
#pragma unroll
              for (int ks = 0; ks < 4; ++ks) o = HG_MFMA(sa[ks], qb[ks], o); }
#pragma unroll
            for (int sb = 0; sb < 2; ++sb) {
                if (sb <= tb) {
                    f32x16 at;
#pragma unroll
                    for (int r = 0; r < 16; ++r) at[r] = 0.f;
#pragma unroll
                    for (int k4 = 0; k4 < 8; k4 += 4) { bf16x8 ka[4], qa[4];
#pragma unroll
                      for (int ks = 0; ks < 4; ++ks) { ka[ks] = rowfrag(imgKT, 32 * sb + r32, 2 * (k4 + ks) + hi); qa[ks] = rowfrag(imgQT, 32 * tb + r32, 2 * (k4 + ks) + hi); }
#pragma unroll
                      for (int ks = 0; ks < 4; ++ks) at = HG_MFMA(ka[ks], qa[ks], at); }
                    if (sb == tb) {
#pragma unroll
                        for (int r = 0; r < 16; ++r) if (crow(r, hi) > r32) at[r] = 0.f; }
#pragma unroll
                    for (int st = 0; st < 2; ++st) { const int s0 = 32 * sb + 16 * st + 4 * hi;
                        o = HG_MFMA(trfrag(imgV, s0, s0 + 8, vb, lane), pack_step(at, st), o); }
                }
            }
            { const float d0 = __builtin_amdgcn_exp2f(DLS[64 * kp + r32]), d1 = __builtin_amdgcn_exp2f(DLS[64 * kp + 32 + r32]);
#pragma unroll
              for (int r = 0; r < 16; ++r) { acc0[r] *= d0; acc1[r] *= d1; } }
#pragma unroll
            for (int ks = 0; ks < 4; ++ks) {
                const bf16x8 af = trfrag(imgV, 16 * ks + 8 * hi, 16 * ks + 8 * hi + 4, vb, lane);
                acc0 = HG_MFMA(af, trfrag(imgKH, 16 * ks + 8 * hi, 16 * ks + 8 * hi + 4, 2 * kp, lane), acc0);
                acc1 = HG_MFMA(af, trfrag(imgKH, 16 * ks + 8 * hi, 16 * ks + 8 * hi + 4, 2 * kp + 1, lane), acc1);
            }
            float ss = 0.f;
#pragma unroll
            for (int r = 0; r < 16; ++r) ss += o[r] * o[r];
            ss += __shfl_xor(ss, 32);
            if (hi == 0) RSS[(32 * tb + r32) * 4 + vb] = ss;
            asm volatile("s_waitcnt lgkmcnt(0)" ::: "memory"); __builtin_amdgcn_s_barrier(); asm volatile("" ::: "memory");
            const f32x4 pr = *(const LAS f32x4*)(RSS + (32 * tb + r32) * 4);
            const float rn = 1.0f / sqrtf(((pr[0] + pr[1]) + (pr[2] + pr[3])) * (1.0f / 128.0f) + EPS);
#pragma unroll
            for (int gq = 0; gq < 4; ++gq) { const int v = 32 * vb + 8 * gq + 4 * hi;
                const f32x4 gr = unpack4(gtw[gq]), sc = (gnv[gq] * rn) * (gr * vsigm(gr));
                *(GAS u32x2*)(F.XN + orow * D + 512 + h * 128 + v) = pack4(o[4 * gq] * sc[0], o[4 * gq + 1] * sc[1], o[4 * gq + 2] * sc[2], o[4 * gq + 3] * sc[3]); }
            asm volatile("s_waitcnt lgkmcnt(0)" ::: "memory"); __builtin_amdgcn_s_barrier(); asm volatile("" ::: "memory");
        }
    }
#undef HG_P3_LOAD
}
#undef HG_MFMA
}

struct Args { const float* in[13]; float* out; unsigned char* ws; int ph_lo, ph_hi; };
__global__ void __launch_bounds__(NWAVES * 64, 2) skel_fwd(Args args) {
    extern __shared__ __attribute__((aligned(16))) unsigned char lds[];
    Frame F;
    F.lds = (LAS unsigned char*)lds; F.MISC = (volatile LAS unsigned*)(F.lds + MISC_OFF);
    F.tid = threadIdx.x; F.lane = F.tid & 63; F.wave = __builtin_amdgcn_readfirstlane(F.tid >> 6);
    F.G = gridDim.x; { const int bx = blockIdx.x; F.vcu = (F.G % 8 == 0) ? (bx % 8) * (F.G / 8) + bx / 8 : bx; }
    unsigned char* ws = args.ws;
    F.ctl = (gu32*)(ws + WS_CTL);
    F.x = args.in[0]; F.n1g = args.in[1]; F.w_in = args.in[2]; F.gq = args.in[3]; F.gk = args.in[4]; F.lbt = args.in[5]; F.hgn = args.in[6]; F.w_br = args.in[7]; F.w_out = args.in[8];
    F.n2g = args.in[9]; F.w_gate = args.in[10]; F.w_up = args.in[11]; F.w_dn = args.in[12]; F.out = args.out;
    F.WIN = (bf16*)(ws + WS_WIN); F.WBR = (bf16*)(ws + WS_WBR); F.WOUT = (bf16*)(ws + WS_WOUT); F.WGU = (bf16*)(ws + WS_WGU); F.WDN = (bf16*)(ws + WS_WDN);
    F.XN = (bf16*)(ws + WS_XN); F.Q = (bf16*)(ws + WS_Q); F.K = (bf16*)(ws + WS_K); F.V = (bf16*)(ws + WS_V); F.HQ = (bf16*)(ws + WS_HQ); F.LOGF = (float*)(ws + WS_LOGF);
    F.HI = (bf16*)(ws + WS_HI); F.HGG = (bf16*)(ws + WS_HGG); F.GS = (bf16*)(ws + WS_GS); F.GH = (bf16*)(ws + WS_GH); F.MIXED = (bf16*)(ws + WS_MIXED); F.STASH = (bf16*)(ws + WS_STASH); F.ACT = (bf16*)(ws + WS_ACT);
    for (int u = F.tid; u < (LDS_BYTES - LDSCTL_OFF) / 4; u += NWAVES * 64) ((LAS unsigned*)(F.lds + LDSCTL_OFF))[u] = 0u;
    __syncthreads();
    XcdBarrier bar; bar.bar = (unsigned*)(F.ctl + CW_BAR); bar.x = 0; bar.st = nullptr;
    if (MK_ONE_LAUNCH) bar = xcd_barrier_post((unsigned*)(F.ctl + CW_BAR), F.MISC + 8);
    const int lo = args.ph_lo, hi = args.ph_hi;
#define IN(k) (lo <= (k) && (k) < hi)
#define SEAM(k) do { if (IN(k) && IN((k) + 1)) xcd_barrier(bar); } while (0)

    if (IN(0)) { p0_prologue<0>(F); } SEAM(0);
    if (IN(1)) {
        if (((int)blockIdx.x >> 3) & 1) { p0_prologue<1>(F); asm volatile("s_waitcnt vmcnt(0) lgkmcnt(0)" ::: "memory"); } __syncthreads();
        pg8::Gemm g{F.XN, F.WIN, M, NIN, D, D, D}; pg8::StaticOrder S; S.init(M, NIN, F.G, (int)blockIdx.x);
        pg8::EpiProj E{F.Q, F.K, F.V, F.HQ, F.HI, F.HGG, F.GS, F.GH, F.LOGF, F.gq, F.gk, F.lbt, QSCALE, EPS};
        pg8::gemm_phase<pg8::EpiProj, pg8::StaticOrder, true, true>(F.lds + RING_OFF, g, S, E);
    } SEAM(1);
    bf16* HL = (bf16*)F.out; float* HDl = (float*)((unsigned char*)F.out + 64 * MiB);
    if (IN(2)) { hg::pass1(F, HL, HDl); __syncthreads(); sba::attn_phase(F); } SEAM(2);
    if (IN(3)) { hg::pass3(F, HL, HDl); } SEAM(3);
    if (IN(4)) {
        pg8::Gemm g{F.XN, F.WBR, M, D, D, D, D}; pg8::StaticOrder S; S.init(M, D, F.G, (int)blockIdx.x);
        pg8::EpiGateK E{(const unsigned char*)F.GS, (const unsigned char*)F.GH, F.MIXED};
        pg8::gemm_phase<pg8::EpiGateK, pg8::StaticOrder, true, true>(F.lds + RING_OFF, g, S, E);
    } SEAM(4);
    float* rowss = (float*)(ws + WS_CTL + 524288);
    if (IN(5)) {
        pg8::Gemm g{F.MIXED, F.WOUT, M, D, D, D, D}; pg8::StaticOrder S; S.init(M, D, F.G, (int)blockIdx.x);
        pg8::EpiResSq E{F.x, F.XN, rowss};
        pg8::gemm_phase<pg8::EpiResSq, pg8::StaticOrder, true, true>(F.lds + RING_OFF, g, S, E);
    } SEAM(5);
    if (IN(6)) {
        pg8::Gemm g{F.XN, F.WGU, M, NIN, D, D, D}; pg8::StaticOrder S; S.init(M, NIN, F.G, (int)blockIdx.x);
        pg8::EpiSwiglu E{F.ACT, FFN, rowss, EPS};
        pg8::gemm_phase<pg8::EpiSwiglu, pg8::StaticOrder, true, true>(F.lds + RING_OFF, g, S, E);
    } SEAM(6);
    if (IN(7)) {
        pg8::Gemm g{F.ACT, F.WDN, M, D, FFN, FFN, FFN}; pg8::StaticOrder S; S.init(M, D, F.G, (int)blockIdx.x);
        pg8::EpiResHn E{F.XN, F.out};
        pg8::gemm_phase<pg8::EpiResHn, pg8::StaticOrder, true, true>(F.lds + RING_OFF, g, S, E);
    }
#undef IN
#undef SEAM
}

extern "C" void kernel_launch(void* const* d_in, const int* in_sizes, int n_in, void* d_out, int out_size, void* d_ws, size_t ws_size, hipStream_t stream) {
    static int grid = 0;
    if (grid == 0) {
        if (n_in != 13 || in_sizes[0] != M * D || out_size != M * D || ws_size < WS_END) { fprintf(stderr, "kernel_launch: unexpected shapes / workspace (n_in %d, ws %zu); nothing launched\n", n_in, ws_size); grid = -1; return; }
        int dev = 0, cus = 0;
        if (hipGetDevice(&dev) != hipSuccess || hipDeviceGetAttribute(&cus, hipDeviceAttributeMultiprocessorCount, dev) != hipSuccess) { grid = -1; return; }
        if (hipFuncSetAttribute((const void*)skel_fwd, hipFuncAttributeMaxDynamicSharedMemorySize, LDS_BYTES) != hipSuccess) { grid = -1; return; }
        int per_cu = 0;
        if (hipOccupancyMaxActiveBlocksPerMultiprocessor(&per_cu, (const void*)skel_fwd, NWAVES * 64, LDS_BYTES) != hipSuccess || per_cu < 1) { fprintf(stderr, "kernel_launch: occupancy query says %d\n", per_cu); }
        (void)hipGetLastError();
        grid = cus;
    }
    if (grid < 0) return;
    (void)hipMemsetAsync((char*)d_ws + WS_CTL, 0, CTL_ZERO_BYTES, stream);
    Args a{};
    for (int i = 0; i < 13; ++i) a.in[i] = (const float*)d_in[i];
    a.out = (float*)d_out; a.ws = (unsigned char*)d_ws;
    if (MK_ONE_LAUNCH) { a.ph_lo = 0; a.ph_hi = N_PHASES; hipLaunchKernelGGL(skel_fwd, dim3(grid), dim3(NWAVES * 64), LDS_BYTES, stream, a); }
    else for (int p = 0; p < N_PHASES; ++p) { a.ph_lo = p; a.ph_hi = p + 1; hipLaunchKernelGGL(skel_fwd, dim3(grid), dim3(NWAVES * 64), LDS_BYTES, stream, a); }
}
```

```cpp
#include <hip/hip_runtime.h>
#include <cstdio>
#include <cstdint>
namespace pg8 {
#define PG8_LAS __attribute__((address_space(3)))
typedef unsigned short bf16_t;
typedef short bf16x8 __attribute__((ext_vector_type(8)));
typedef float f32x4 __attribute__((ext_vector_type(4)));
typedef unsigned u32x4 __attribute__((ext_vector_type(4)));
constexpr int BM = 256, BK = 64, HALF = 128, HTB = HALF * BK * 2  , STAGE_BYTES = 8 * HTB, NXCD = 8, WGM = 4;

__host__ __device__ __forceinline__ int lds_byte(int r, int c) { const int st = (r >> 4) * 2 + (c >> 5), rr = r & 15, cc = c & 31, ob = rr * 64 + cc * 2; return st * 1024 + (ob ^ (((ob >> 9) & 1) << 5)); }
__host__ __device__ __forceinline__ void stage_rc(int b, int& R, int& C) { const int st = b / 1024, sb = b % 1024, swz = sb ^ (((sb >> 9) & 1) << 5); R = (st >> 1) * 16 + swz / 64; C = (st & 1) * 32 + (swz % 64) / 2; }
__host__ __device__ __forceinline__ int perm32(int rho) { const int n = rho >> 4, i = rho & 15; return 8 * (i >> 2) + 4 * n + (i & 3); }

struct Unit { int pm, pn; };
struct Gemm { const bf16_t* A; const bf16_t* Bt; int M, N, K, lda, ldb; };

struct StaticOrder {
    int nM, nN, nwg, G, c;
    __host__ __device__ void init(int M, int N, int G_, int c_) { nM = M / BM; nN = N / BM; nwg = nM * nN; G = G_; c = c_; }
    __host__ __device__ bool next(int i, Unit& u) const {
        const long L = (long)i * G + c; if (L >= nwg) return false;
        int wgid = (int)L; { const int q = nwg / NXCD, r = nwg % NXCD, xcd = wgid % NXCD, off = wgid / NXCD; wgid = (xcd < r ? xcd * (q + 1) : r * (q + 1) + (xcd - r) * q) + off; }
        const int nig = WGM * nN, gid = wgid / nig, fm = gid * WGM, gsz = (nM - fm) < WGM ? (nM - fm) : WGM;
        u.pm = fm + ((wgid % nig) % gsz); u.pn = (wgid % nig) / gsz; return true;
    }
    __device__ __forceinline__ void a_ready(const Unit&) const {}
    __device__ __forceinline__ void done(const Unit&) const {}
};

typedef float f32x2_t __attribute__((ext_vector_type(2))); typedef __bf16 bf16x2_t __attribute__((ext_vector_type(2)));
__device__ __forceinline__ unsigned cvt_pk_bf16(float lo, float hi) { const f32x2_t v = {lo, hi}; const bf16x2_t b = __builtin_convertvector(v, bf16x2_t); return __builtin_bit_cast(unsigned, b); }
typedef unsigned u32x2 __attribute__((ext_vector_type(2)));
__device__ __forceinline__ float ex2(float x) { return __builtin_amdgcn_exp2f(x); }
__device__ __forceinline__ float sigm(float x) { return __builtin_amdgcn_rcpf(1.0f + ex2(x * -1.4426950408889634f)); }
__device__ __forceinline__ u32x4 pack8(const f32x4 a, const f32x4 b) { u32x4 w; w.x = cvt_pk_bf16(a[0], a[1]); w.y = cvt_pk_bf16(a[2], a[3]); w.z = cvt_pk_bf16(b[0], b[1]); w.w = cvt_pk_bf16(b[2], b[3]); return w; }
__device__ __forceinline__ f32x4 bf4_lo(const u32x4 w) { return (f32x4){__uint_as_float(w.x << 16), __uint_as_float(w.x & 0xffff0000u), __uint_as_float(w.y << 16), __uint_as_float(w.y & 0xffff0000u)}; }
__device__ __forceinline__ f32x4 bf4_hi(const u32x4 w) { return (f32x4){__uint_as_float(w.z << 16), __uint_as_float(w.z & 0xffff0000u), __uint_as_float(w.w << 16), __uint_as_float(w.w & 0xffff0000u)}; }

__device__ __forceinline__ u32x2 pack8_fp8(const f32x4 a, const f32x4 b) { u32x2 w; int t = __builtin_amdgcn_cvt_pk_fp8_f32(a[0], a[1], 0, false); t = __builtin_amdgcn_cvt_pk_fp8_f32(a[2], a[3], t, true); w.x = (unsigned)t;
    t = __builtin_amdgcn_cvt_pk_fp8_f32(b[0], b[1], 0, false); t = __builtin_amdgcn_cvt_pk_fp8_f32(b[2], b[3], t, true); w.y = (unsigned)t; return w; }
__device__ __forceinline__ f32x4 fp8x4(unsigned w) { typedef float f2_ __attribute__((ext_vector_type(2))); const f2_ lo = __builtin_amdgcn_cvt_pk_f32_fp8((int)w, false), hi = __builtin_amdgcn_cvt_pk_f32_fp8((int)w, true); return (f32x4){lo.x, lo.y, hi.x, hi.y}; }
struct EpiProj {
    static constexpr bool PERM = true, AFTER_DRAIN = false, MID = false;
    bf16_t *Q, *Kq, *V, *HQ, *HI, *HGG, *GS, *GH; float* LOGF; const float *gq, *gk, *lbt; float qscale, eps;
    __device__ __forceinline__ void operator()(const f32x4 (&acc)[2][2][4][2], const Unit& u, int wr, int wc, int fr, int fq) const {
        const int pn = u.pn, row0 = u.pm * BM + wr * 64 + fr;
        if (pn < 4) {
            const bool isq = pn < 2; const int head = 4 * (pn & 1) + wc;
            bf16_t* base = (isq ? Q : Kq) + head * 64 + 8 * fq; const float* g = (isq ? gq : gk) + 8 * fq; const float sc = isq ? qscale : 1.0f;
            f32x4 gv[2][2];
#pragma unroll
            for (int bj = 0; bj < 2; ++bj)
#pragma unroll
                for (int n = 0; n < 2; ++n) gv[bj][n] = *(const f32x4*)(g + 32 * bj + 4 * n) * sc;
#pragma unroll
            for (int ai = 0; ai < 2; ++ai)
#pragma unroll
                for (int m = 0; m < 4; ++m) {
                    float ss = 0.f;
#pragma unroll
                    for (int bj = 0; bj < 2; ++bj)
#pragma unroll
                        for (int n = 0; n < 2; ++n) { const f32x4 x = acc[ai][bj][m][n]; ss += (x[0] * x[0] + x[1] * x[1]) + (x[2] * x[2] + x[3] * x[3]); }
                    ss += __shfl_xor(ss, 16); ss += __shfl_xor(ss, 32);
                    const float rs = 1.0f / sqrtf(ss * (1.0f / 64.0f) + eps);
                    bf16_t* rowp = base + (size_t)(row0 + ai * HALF + m * 16) * 512;
#pragma unroll
                    for (int bj = 0; bj < 2; ++bj) *(u32x4*)(rowp + 32 * bj) = pack8(acc[ai][bj][m][0] * rs * gv[bj][0], acc[ai][bj][m][1] * rs * gv[bj][1]);
                }
        } else if (pn == 8 || pn == 9) {
            store_tile<0>(acc, (bf16_t*)LOGF, 512, row0, 256 * (pn - 8) + 32 * wc + 8 * fq);
        } else {
            const int cw = 32 * wc + 8 * fq;
            if (pn < 6) store_tile<0>(acc, V, 512, row0, 256 * (pn - 4) + cw);
            else if (pn < 8) store_tile<0>(acc, HQ, 512, row0, 256 * (pn - 6) + cw);
            else if (pn < 12) store_tile<0>(acc, HI, 512, row0, 256 * (pn - 10) + cw);
            else if (pn < 14) store_tile<0>(acc, HGG, 512, row0, 256 * (pn - 12) + cw);
            else if (pn < 18) store_tile8(acc, (unsigned char*)GS, row0, 256 * (pn - 14) + cw);
            else store_tile8(acc, (unsigned char*)GH, row0, 256 * (pn - 18) + cw);
        }
    }
    static __device__ __forceinline__ void store_tile8(const f32x4 (&acc)[2][2][4][2], unsigned char* ob, int row0, int cb) {
#pragma unroll
        for (int ai = 0; ai < 2; ++ai)
#pragma unroll
            for (int m = 0; m < 4; ++m) { unsigned char* rowp = ob + (size_t)(row0 + ai * HALF + m * 16) * 1024 + cb;
#pragma unroll
                for (int bj = 0; bj < 2; ++bj) *(u32x2*)(rowp + 128 * bj) = pack8_fp8(acc[ai][bj][m][0], acc[ai][bj][m][1]); }
    }
    template <int MODE  > static __device__ __forceinline__ void store_tile(const f32x4 (&acc)[2][2][4][2], bf16_t* ob, int ld, int row0, int cb) {
#pragma unroll
        for (int ai = 0; ai < 2; ++ai)
#pragma unroll
            for (int m = 0; m < 4; ++m) { bf16_t* rowp = ob + (size_t)(row0 + ai * HALF + m * 16) * ld + cb;
#pragma unroll
                for (int bj = 0; bj < 2; ++bj) { f32x4 v[2];
#pragma unroll
                    for (int n = 0; n < 2; ++n) { const f32x4 x = acc[ai][bj][m][n];
                        if (MODE == 0) v[n] = x;
                        else {
#pragma unroll
                            for (int j = 0; j < 4; ++j) { const float s = sigm(x[j]); v[n][j] = MODE == 1 ? x[j] * s : s; } } }
                    *(u32x4*)(rowp + 128 * bj) = pack8(v[0], v[1]); } }
    }
};
struct EpiGateK {
    static constexpr bool PERM = true, AFTER_DRAIN = false, MID = true;
    const unsigned char* gs; const unsigned char* gh; bf16_t* out;
    __device__ __forceinline__ void mid(f32x4 (&acc)[2][2][4][2], const Unit& u, int wr, int wc, int fr_, int fq_) const {
        int fr = fr_, fq = fq_; asm volatile("" : "+v"(fr), "+v"(fq));
        const int row0 = u.pm * BM + wr * 64 + fr, col0 = u.pn * BM + wc * 32 + 8 * fq;
#pragma unroll
        for (int ai = 0; ai < 2; ++ai) {
            u32x2 a[4][2], b[4][2];
#pragma unroll
            for (int m = 0; m < 4; ++m)
#pragma unroll
                for (int bj = 0; bj < 2; ++bj) { const size_t off = (size_t)(row0 + ai * HALF + m * 16) * 1024 + col0 + bj * HALF; a[m][bj] = *(const u32x2*)(gs + off); b[m][bj] = *(const u32x2*)(gh + off); }
            asm volatile("" ::: "memory");
#pragma unroll
            for (int m = 0; m < 4; ++m)
#pragma unroll
                for (int bj = 0; bj < 2; ++bj) {
                    const f32x4 es0 = fp8x4(a[m][bj].x) * -1.4426950408889634f, es1 = fp8x4(a[m][bj].y) * -1.4426950408889634f, eh0 = fp8x4(b[m][bj].x) * -1.4426950408889634f, eh1 = fp8x4(b[m][bj].y) * -1.4426950408889634f;
                    f32x4 n0, n1, d0, d1;
#pragma unroll
                    for (int j = 0; j < 4; ++j) { n0[j] = ex2(eh0[j]); n1[j] = ex2(eh1[j]); d0[j] = ex2(es0[j]); d1[j] = ex2(es1[j]); }
                    n0 = n0 + 1.0f; n1 = n1 + 1.0f; d0 = d0 + 1.0f; d1 = d1 + 1.0f;
#pragma unroll
                    for (int j = 0; j < 4; ++j) { d0[j] = __builtin_amdgcn_rcpf(d0[j]); d1[j] = __builtin_amdgcn_rcpf(d1[j]); }
                    acc[ai][bj][m][0] = acc[ai][bj][m][0] * (n0 * d0); acc[ai][bj][m][1] = acc[ai][bj][m][1] * (n1 * d1); }
            asm volatile("" ::: "memory");
        }
    }
    __device__ __forceinline__ void operator()(const f32x4 (&acc)[2][2][4][2], const Unit& u, int wr, int wc, int fr, int fq) const {
        const int row0 = u.pm * BM + wr * 64 + fr, col0 = u.pn * BM + wc * 32 + 8 * fq;
#pragma unroll
        for (int ai = 0; ai < 2; ++ai) {
            u32x2 b[4][2];
#pragma unroll
            for (int m = 0; m < 4; ++m)
#pragma unroll
                for (int bj = 0; bj < 2; ++bj) b[m][bj] = *(const u32x2*)(gh + (size_t)(row0 + ai * HALF + m * 16) * 1024 + col0 + bj * HALF);
            asm volatile("" ::: "memory");
#pragma unroll
            for (int m = 0; m < 4; ++m)
#pragma unroll
                for (int bj = 0; bj < 2; ++bj) { f32x4 g0 = fp8x4(b[m][bj].x), g1 = fp8x4(b[m][bj].y);
#pragma unroll
                    for (int j = 0; j < 4; ++j) { g0[j] = sigm(g0[j]); g1[j] = sigm(g1[j]); }
                    *(u32x4*)(out + (size_t)(row0 + ai * HALF + m * 16) * 1024 + col0 + bj * HALF) = pack8(acc[ai][bj][m][0] * g0, acc[ai][bj][m][1] * g1); }
            asm volatile("" ::: "memory");
        }
    }
};
struct EpiResHn {
    static constexpr bool PERM = false, AFTER_DRAIN = false, MID = false;
    const bf16_t* hn; float* out;
    __device__ __forceinline__ void operator()(const f32x4 (&acc)[2][2][4][2], const Unit& u, int wr, int wc, int fr, int fq) const {
        const int row0 = u.pm * BM + wr * 64 + fr, col0 = u.pn * BM + wc * 32 + 4 * fq;
#pragma unroll
        for (int ai = 0; ai < 2; ++ai) {
            u32x2 pre[4][2][2];
#pragma unroll
            for (int m = 0; m < 4; ++m) {
#pragma unroll
                for (int bj = 0; bj < 2; ++bj)
#pragma unroll
                    for (int n = 0; n < 2; ++n) pre[m][bj][n] = *(const u32x2*)(hn + (size_t)(row0 + ai * HALF + m * 16) * 1024 + col0 + bj * HALF + n * 16); }
            asm volatile("" ::: "memory");
#pragma unroll
            for (int m = 0; m < 4; ++m)
#pragma unroll
                for (int bj = 0; bj < 2; ++bj)
#pragma unroll
                    for (int n = 0; n < 2; ++n) { const u32x2 w = pre[m][bj][n];
                        const f32x4 h = (f32x4){__uint_as_float(w.x << 16), __uint_as_float(w.x & 0xffff0000u), __uint_as_float(w.y << 16), __uint_as_float(w.y & 0xffff0000u)};
                        *(f32x4*)(out + (size_t)(row0 + ai * HALF + m * 16) * 1024 + col0 + bj * HALF + n * 16) = h + acc[ai][bj][m][n]; }
            asm volatile("" ::: "memory");
        }
    }
};
struct EpiResSq {
    static constexpr bool PERM = false, AFTER_DRAIN = false, MID = false;
    const float* base; bf16_t* hb; float* rowss;
    __device__ __forceinline__ void operator()(const f32x4 (&acc)[2][2][4][2], const Unit& u, int wr, int wc, int fr, int fq) const {
        const int row0 = u.pm * BM + wr * 64 + fr, col0 = u.pn * BM + wc * 32 + 4 * fq;
#pragma unroll
        for (int ai = 0; ai < 2; ++ai) {
            f32x4 pre[4][2][2];
#pragma unroll
            for (int m = 0; m < 4; ++m)
#pragma unroll
                for (int bj = 0; bj < 2; ++bj)
#pragma unroll
                    for (int n = 0; n < 2; ++n) pre[m][bj][n] = *(const f32x4*)(base + (size_t)(row0 + ai * HALF + m * 16) * 1024 + col0 + bj * HALF + n * 16);
            asm volatile("" ::: "memory");
#pragma unroll
            for (int m = 0; m < 4; ++m) { float s = 0.f;
#pragma unroll
                for (int bj = 0; bj < 2; ++bj)
#pragma unroll
                    for (int n = 0; n < 2; ++n) { const f32x4 h = pre[m][bj][n] + acc[ai][bj][m][n]; s += (h[0] * h[0] + h[1] * h[1]) + (h[2] * h[2] + h[3] * h[3]);
                        u32x2 w; w.x = cvt_pk_bf16(h[0], h[1]); w.y = cvt_pk_bf16(h[2], h[3]); *(u32x2*)(hb + (size_t)(row0 + ai * HALF + m * 16) * 1024 + col0 + bj * HALF + n * 16) = w; }
                s += __shfl_xor(s, 16); s += __shfl_xor(s, 32);
                if (fq == 0) __hip_atomic_fetch_add(rowss + row0 + ai * HALF + m * 16, s, __ATOMIC_RELAXED, __HIP_MEMORY_SCOPE_AGENT); }
            asm volatile("" ::: "memory");
        }
    }
};
struct EpiSwiglu {
    static constexpr bool PERM = true, AFTER_DRAIN = false, MID = false;
    bf16_t* out; int ldc; const float* rowss; float eps;
    __device__ __forceinline__ void operator()(const f32x4 (&acc)[2][2][4][2], const Unit& u, int wr, int wc, int fr, int fq) const {
        const int row0 = u.pm * BM + wr * 64 + fr, col0 = u.pn * HALF + wc * 32 + 8 * fq;
        float rs[2][4];
#pragma unroll
        for (int ai = 0; ai < 2; ++ai)
#pragma unroll
            for (int m = 0; m < 4; ++m) rs[ai][m] = rowss[row0 + ai * HALF + m * 16];
#pragma unroll
        for (int ai = 0; ai < 2; ++ai)
#pragma unroll
            for (int m = 0; m < 4; ++m) { f32x4 v[2]; const float r = 1.0f / sqrtf(rs[ai][m] * (1.0f / 1024.0f) + eps), cr = -1.4426950408889634f * r, r2 = r * r;
#pragma unroll
                for (int n = 0; n < 2; ++n) {
                    const f32x4 g4 = acc[ai][0][m][n], u4 = acc[ai][1][m][n], t = g4 * cr;
                    f32x4 d; d[0] = ex2(t[0]); d[1] = ex2(t[1]); d[2] = ex2(t[2]); d[3] = ex2(t[3]); d = d + 1.0f;
                    f32x4 s; s[0] = __builtin_amdgcn_rcpf(d[0]); s[1] = __builtin_amdgcn_rcpf(d[1]); s[2] = __builtin_amdgcn_rcpf(d[2]); s[3] = __builtin_amdgcn_rcpf(d[3]);
                    v[n] = (g4 * u4) * (s * r2); }
                *(u32x4*)(out + (size_t)(row0 + ai * HALF + m * 16) * ldc + col0) = pack8(v[0], v[1]); }
    }
};
template <class Epi, class Sched, bool ALIGN_EPI = false, bool SP2 = false>
__device__ __forceinline__ void gemm_phase(PG8_LAS unsigned char* lds, const Gemm g, const Sched& S, const Epi& E) {
    const int tid = threadIdx.x, wid = __builtin_amdgcn_readfirstlane(tid >> 6), lane = tid & 63, wr = wid >> 2, wc = wid & 3, fr = lane & 15, fq = lane >> 4;
    const int K = g.K, nt = K / BK;
    unsigned voffA[2], voffB[2];
#pragma unroll
    for (int i = 0; i < 2; ++i) { int R, C; stage_rc(tid * 16 + i * 8192, R, C); const int Rb = Epi::PERM ? ((R & ~31) + perm32(R & 31)) : R;
        voffA[i] = (unsigned)(R * g.lda + C) * 2u; voffB[i] = (unsigned)(Rb * g.ldb + C) * 2u; }
    const size_t kstep = (size_t)(BK * 2);
    const size_t hstepA = (size_t)HALF * g.lda * 2, hstepB = (size_t)HALF * g.ldb * 2;
    const size_t tstepA = 2 * hstepA, tstepB = 2 * hstepB;
    const unsigned ldsw = (unsigned)wid * 1024u;
    const int aoff = lds_byte(wr * 64 + fr, fq * 8), boff = lds_byte(wc * 32 + fr, fq * 8);
#define PG8_SA(b, h) (((b) * 2 + (h)) * HTB)
#define PG8_SB(b, h) ((4 + (b) * 2 + (h)) * HTB)
#define PG8_STAGE(bufoff, gbase, voff) do { _Pragma("unroll") for (int _i = 0; _i < 2; ++_i) \
        __builtin_amdgcn_global_load_lds((const unsigned*)((const char*)(gbase) + (voff)[_i]), (PG8_LAS unsigned*)(lds + (bufoff) + ldsw + _i * 8192), 16, 0, 0); } while (0)
#define PG8_LDA(dst, b, h) do { _Pragma("unroll") for (int m = 0; m < 4; ++m) _Pragma("unroll") for (int k = 0; k < 2; ++k) dst[m][k] = *(const PG8_LAS bf16x8*)(lds + PG8_SA(b, h) + aoff + m * 2048 + k * 1024); } while (0)
#define PG8_LDB(dst, b, h) do { _Pragma("unroll") for (int n = 0; n < 2; ++n) _Pragma("unroll") for (int k = 0; k < 2; ++k) dst[n][k] = *(const PG8_LAS bf16x8*)(lds + PG8_SB(b, h) + boff + n * 2048 + k * 1024); } while (0)
#define PG8_MMA(ai, bj, At, Bt) do { __builtin_amdgcn_s_setprio(1); _Pragma("unroll") for (int m = 0; m < 4; ++m) _Pragma("unroll") for (int n = 0; n < 2; ++n) _Pragma("unroll") for (int k = 0; k < 2; ++k) \
        acc[ai][bj][m][n] = __builtin_amdgcn_mfma_f32_16x16x32_bf16(Bt[n][k], At[m][k], acc[ai][bj][m][n], 0, 0, 0); __builtin_amdgcn_s_setprio(0); } while (0)
#define PG8_WAIT_V(n) asm volatile("s_waitcnt vmcnt(" #n ")" ::: "memory")
#define PG8_WAIT_L(n) asm volatile("s_waitcnt lgkmcnt(" #n ")" ::: "memory")
#define PG8_BAR __builtin_amdgcn_s_barrier()
#define PG8_SCHED __builtin_amdgcn_sched_barrier(0)
    Unit cur, nxt; int ui = 0;
    if (!S.next(0, cur)) return;
    f32x4 acc[2][2][4][2];
#pragma unroll
    for (int a = 0; a < 2; ++a)
#pragma unroll
        for (int b = 0; b < 2; ++b)
#pragma unroll
            for (int m = 0; m < 4; ++m)
#pragma unroll
                for (int n = 0; n < 2; ++n) acc[a][b][m][n] = (f32x4){0.f, 0.f, 0.f, 0.f};
    bf16x8 At[4][2], B0[2][2], B1[2][2];
    const char* cA = (const char*)g.A + (size_t)cur.pm * tstepA; const char* cB = (const char*)g.Bt + (size_t)cur.pn * tstepB;
    S.a_ready(cur);
    if constexpr (SP2) {
        PG8_STAGE(PG8_SB(0, 0), cB, voffB); PG8_STAGE(PG8_SB(0, 1), cB + hstepB, voffB); PG8_STAGE(PG8_SA(0, 0), cA, voffA); PG8_STAGE(PG8_SA(0, 1), cA + hstepA, voffA);
        if (wr == 1) PG8_BAR;
        PG8_WAIT_V(2); PG8_BAR;
        PG8_STAGE(PG8_SB(1, 0), cB + kstep, voffB); PG8_STAGE(PG8_SA(1, 0), cA + kstep, voffA); PG8_STAGE(PG8_SB(1, 1), cB + hstepB + kstep, voffB);
        PG8_WAIT_V(6); PG8_BAR;
    } else {
        PG8_STAGE(PG8_SB(0, 0), cB, voffB); PG8_STAGE(PG8_SA(0, 0), cA, voffA); PG8_STAGE(PG8_SB(0, 1), cB + hstepB, voffB); PG8_STAGE(PG8_SA(0, 1), cA + hstepA, voffA);
        if (wr == 1) PG8_BAR;
        PG8_WAIT_V(4); PG8_BAR;
        PG8_STAGE(PG8_SB(1, 0), cB + kstep, voffB); PG8_STAGE(PG8_SA(1, 0), cA + kstep, voffA); PG8_STAGE(PG8_SB(1, 1), cB + hstepB + kstep, voffB);
        PG8_WAIT_V(6); PG8_BAR;
    }
    for (;;) {
        const bool has_next = S.next(ui + 1, nxt);
        const char* nA = has_next ? (const char*)g.A + (size_t)nxt.pm * tstepA : cA; const char* nB = has_next ? (const char*)g.Bt + (size_t)nxt.pn * tstepB : cB;
        for (int t = 0; t < nt; t += 2) {
            if constexpr (Epi::MID) { if (t == nt / 2) E.mid(acc, cur, wr, wc, fr, fq); }
            const bool last = (t == nt - 2);
            const char* a1 = cA + (size_t)(t + 1) * kstep;
            const char* a2 = last ? nA : cA + (size_t)(t + 2) * kstep; const char* b2 = last ? nB : cB + (size_t)(t + 2) * kstep;
            const char* a3 = a2 + kstep; const char* b3 = b2 + kstep;
            if (last && has_next) S.a_ready(nxt);
            if constexpr (SP2) {
            PG8_LDB(B0, 0, 0); PG8_LDB(B1, 0, 1); PG8_SCHED; PG8_LDA(At, 0, 0); PG8_STAGE(PG8_SA(1, 1), a1 + hstepA, voffA);
            PG8_WAIT_V(8); PG8_WAIT_L(0); PG8_BAR; PG8_MMA(0, 0, At, B0); PG8_MMA(0, 1, At, B1); PG8_BAR; PG8_SCHED;
            PG8_LDA(At, 0, 1); PG8_STAGE(PG8_SB(0, 0), b2, voffB); PG8_STAGE(PG8_SB(0, 1), b2 + hstepB, voffB); PG8_STAGE(PG8_SA(0, 0), a2, voffA);
            PG8_WAIT_V(8); PG8_WAIT_L(0); PG8_BAR; PG8_MMA(1, 0, At, B0); PG8_MMA(1, 1, At, B1); PG8_BAR; PG8_SCHED;
            PG8_LDB(B0, 1, 0); PG8_LDB(B1, 1, 1); PG8_SCHED; PG8_LDA(At, 1, 0); PG8_STAGE(PG8_SA(0, 1), a2 + hstepA, voffA);
            PG8_WAIT_V(8); PG8_WAIT_L(0); PG8_BAR; PG8_MMA(0, 0, At, B0); PG8_MMA(0, 1, At, B1); PG8_BAR; PG8_SCHED;
            PG8_LDA(At, 1, 1); PG8_STAGE(PG8_SB(1, 0), b3, voffB); PG8_STAGE(PG8_SB(1, 1), b3 + hstepB, voffB); PG8_STAGE(PG8_SA(1, 0), a3, voffA);
            PG8_WAIT_V(8); PG8_WAIT_L(0); PG8_BAR; PG8_MMA(1, 0, At, B0); PG8_MMA(1, 1, At, B1); PG8_BAR; PG8_SCHED;
            } else {
            PG8_LDB(B0, 0, 0); PG8_SCHED; PG8_LDA(At, 0, 0); PG8_STAGE(PG8_SA(1, 1), a1 + hstepA, voffA);
            PG8_WAIT_L(8); PG8_BAR; PG8_WAIT_L(0); PG8_MMA(0, 0, At, B0); PG8_BAR; PG8_SCHED;
            PG8_LDB(B1, 0, 1); PG8_STAGE(PG8_SB(0, 0), b2, voffB);
            PG8_BAR; PG8_WAIT_L(0); PG8_MMA(0, 1, At, B1); PG8_BAR;
            PG8_LDA(At, 0, 1); PG8_STAGE(PG8_SA(0, 0), a2, voffA);
            PG8_BAR; PG8_WAIT_L(0); PG8_MMA(1, 0, At, B0); PG8_BAR; PG8_SCHED;
            PG8_STAGE(PG8_SB(0, 1), b2 + hstepB, voffB);
            PG8_WAIT_V(6); PG8_BAR; PG8_MMA(1, 1, At, B1); PG8_BAR;
            PG8_LDB(B0, 1, 0); PG8_SCHED; PG8_LDA(At, 1, 0); PG8_STAGE(PG8_SA(0, 1), a2 + hstepA, voffA);
            PG8_WAIT_L(8); PG8_BAR; PG8_WAIT_L(0); PG8_MMA(0, 0, At, B0); PG8_BAR; PG8_SCHED;
            PG8_LDB(B1, 1, 1); PG8_STAGE(PG8_SB(1, 0), b3, voffB);
            PG8_BAR; PG8_WAIT_L(0); PG8_MMA(0, 1, At, B1); PG8_BAR;
            PG8_LDA(At, 1, 1); PG8_STAGE(PG8_SA(1, 0), a3, voffA);
            PG8_BAR; PG8_WAIT_L(0); PG8_MMA(1, 0, At, B0); PG8_BAR; PG8_SCHED;
            PG8_STAGE(PG8_SB(1, 1), b3 + hstepB, voffB);
            PG8_WAIT_V(6); PG8_BAR; PG8_MMA(1, 1, At, B1); PG8_BAR;
            }
        }
        if constexpr (ALIGN_EPI) { if (wr == 0) PG8_BAR; }
        if constexpr (!Epi::AFTER_DRAIN) { E(acc, cur, wr, wc, fr, fq); S.done(cur); }
        if (!has_next) break;
#pragma unroll
        for (int a = 0; a < 2; ++a)
#pragma unroll
            for (int b = 0; b < 2; ++b)
#pragma unroll
                for (int m = 0; m < 4; ++m)
#pragma unroll
                    for (int n = 0; n < 2; ++n) acc[a][b][m][n] = (f32x4){0.f, 0.f, 0.f, 0.f};
        cur = nxt; cA = nA; cB = nB; ++ui;
        if constexpr (ALIGN_EPI) { if (wr == 1) PG8_BAR; }
    }
    PG8_WAIT_V(0);
    if constexpr (!ALIGN_EPI) { if (wr == 0) PG8_BAR; }
    PG8_BAR;
    if constexpr (Epi::AFTER_DRAIN) { E.fused(acc, cur, wr, wc, fr, fq, lds, wid, lane); S.done(cur); }
#undef PG8_SA
#undef PG8_SB
#undef PG8_STAGE
#undef PG8_LDA
#undef PG8_LDB
#undef PG8_MMA
#undef PG8_WAIT_V
#undef PG8_WAIT_L
#undef PG8_BAR
#undef PG8_SCHED
}
}
constexpr int NWAVES = 8;
#ifndef MK_ONE_LAUNCH
#define MK_ONE_LAUNCH 1
#endif
constexpr int N_PHASES = 8;

constexpr int BATCH = 8, SEQ = 4096, D = 1024, M = BATCH * SEQ;
constexpr int SBH = 8, SBD = 64, SBW = 512, HGH = 4, HGD = 128, HGW = 512, NIN = 5632, FFN = 2816;
constexpr float EPS = 1e-6f;
constexpr float QSCALE = 0.125f * 1.4426950408889634f;

constexpr size_t MiB = 1u << 20;
constexpr size_t WS_CTL = 0, CTL_ZERO_BYTES = 1 * MiB;
constexpr size_t WS_WIN = 1 * MiB, WS_WBR = 12 * MiB, WS_WOUT = 14 * MiB, WS_WGU = 16 * MiB, WS_WDN = 27 * MiB;
constexpr size_t WS_XN = 33 * MiB;
constexpr size_t WS_Q = 97 * MiB, WS_K = 129 * MiB, WS_V = 161 * MiB, WS_HQ = 193 * MiB, WS_LOGF = 225 * MiB, WS_HI = 289 * MiB, WS_HGG = 321 * MiB, WS_GS = 353 * MiB, WS_GH = 417 * MiB;
constexpr size_t WS_MIXED = 97 * MiB, WS_STASH = 161 * MiB;
constexpr size_t WS_ACT = 225 * MiB;
constexpr size_t WS_END = 481 * MiB;
static_assert(WS_ACT + (size_t)M * FFN * 2 <= WS_GH + 64 * MiB && WS_WDN + (size_t)D * FFN * 2 <= WS_XN, "d_ws map");
constexpr int CW_TMO = 0, CW_CODE = 1, CW_BAR = 4096, CW_SEAM = 16384;

constexpr int RING_OFF = 0, RING_BYTES = 131072;
constexpr int LDSCTL_OFF = RING_BYTES, MISC_OFF = LDSCTL_OFF + 320;
constexpr int LDS_BYTES = 147456;
#define GAS __attribute__((address_space(1)))
#define LAS __attribute__((address_space(3)))
typedef unsigned short bf16;
typedef unsigned v4u __attribute__((ext_vector_type(4)));
typedef float f32x4 __attribute__((ext_vector_type(4)));
typedef short bf16x8 __attribute__((ext_vector_type(8)));
typedef GAS unsigned gu32;
typedef GAS unsigned long long gu64;
#define RLX_AGENT __ATOMIC_RELAXED, __HIP_MEMORY_SCOPE_AGENT
#define LDS_WAIT() asm volatile("s_waitcnt lgkmcnt(0)" ::: "memory")
#define VM_WAIT() asm volatile("s_waitcnt vmcnt(0)" ::: "memory")
__device__ __forceinline__ unsigned long long rt() { return __builtin_amdgcn_s_memrealtime(); }
__device__ __forceinline__ unsigned f2bf(float f) { unsigned u = __builtin_bit_cast(unsigned, f); return (u + 0x7fffu + ((u >> 16) & 1u)) >> 16; }
__device__ __forceinline__ unsigned pk2(float lo, float hi) { return f2bf(lo) | (f2bf(hi) << 16); }

#define XB_TMO      128
#define XB_XCNT(j)  (256  + 64 * (j))
#define XB_XSUB(j)  (1280 + 64 * (j))
#define XB_XGEN(j)  (2304 + 64 * (j))
#define XB_TOP      3328
#define XB_TOPGEN   3392
#define XCD_BAR_WORDS 3456
#define XB_SPIN_CAP (1u << 18)

__device__ __forceinline__ unsigned xb_ld(unsigned* p)              { return __hip_atomic_load(p, __ATOMIC_RELAXED, __HIP_MEMORY_SCOPE_AGENT); }
__device__ __forceinline__ unsigned xb_add(unsigned* p, unsigned v) { return __hip_atomic_fetch_add(p, v, __ATOMIC_RELAXED, __HIP_MEMORY_SCOPE_AGENT); }
__device__ __forceinline__ unsigned xb_xcc_id() { return (unsigned)__builtin_amdgcn_s_getreg((3 << 11) | 20) & 0xFu; }
#define XB_SPIN(cond, bar) do { unsigned _sp = 0; while (cond) { __builtin_amdgcn_s_sleep(1); \
    if ((++_sp & 255u) == 0u) { if (xb_ld(&(bar)[XB_TMO])) break; if (_sp > XB_SPIN_CAP) { atomicAdd(&(bar)[XB_TMO], 1u); break; } } } } while (0)

struct XcdBarrier {
    unsigned* bar; unsigned x;
    volatile LAS unsigned* st;
};

__device__ __forceinline__ XcdBarrier xcd_barrier_post(unsigned* bar, volatile LAS unsigned* st) {
    XcdBarrier b; b.bar = bar; b.x = xb_xcc_id(); b.st = st;
    if (threadIdx.x == 0) (void)xb_add(&bar[XB_XCNT(b.x)], 1u);
    return b;
}
__device__ __forceinline__ void xcd_barrier_complete(unsigned* bar, unsigned x, unsigned& nloc, unsigned& nx) {
    const unsigned G = gridDim.x * gridDim.y * gridDim.z;
    unsigned sum, cnt, mine, sp = 0u;
    for (;;) {
        sum = 0u; cnt = 0u; mine = 0u;
#pragma unroll
        for (unsigned j = 0; j < 16; ++j) { const unsigned c = xb_ld(&bar[XB_XCNT(j)]); sum += c; cnt += (c > 0u) ? 1u : 0u; mine = (j == x) ? c : mine; }
        if (sum == G) break;
        __builtin_amdgcn_s_sleep(1);
        if ((++sp & 255u) == 0u) { if (xb_ld(&bar[XB_TMO])) break; if (sp > XB_SPIN_CAP) { atomicAdd(&bar[XB_TMO], 1u); break; } }
    }
    nloc = mine > 0u ? mine : 1u; nx = cnt > 0u ? cnt : 1u;
}

__device__ __forceinline__ void xcd_barrier(const XcdBarrier& b) {
    asm volatile("s_waitcnt vmcnt(0)" ::: "memory");
    __syncthreads();
    if (threadIdx.x == 0) {
        unsigned* bar = b.bar;
        __builtin_amdgcn_s_waitcnt(0);
        unsigned nloc = b.st[0], nx = b.st[1];
        if (nloc == 0u) { xcd_barrier_complete(bar, b.x, nloc, nx); b.st[0] = nloc; b.st[1] = nx; }
        const unsigned old = xb_add(&bar[XB_XSUB(b.x)], 1u);
        const unsigned gen = old / nloc;
        if (old + 1u == (gen + 1u) * nloc) {
            __builtin_amdgcn_fence(__ATOMIC_RELEASE, "agent");
            asm volatile("s_waitcnt vmcnt(0)" ::: "memory");
            const unsigned og = xb_add(&bar[XB_TOP], 1u);
            const unsigned tg = og / nx;
            if (og + 1u == (tg + 1u) * nx) xb_add(&bar[XB_TOPGEN], 1u);
            else XB_SPIN(xb_ld(&bar[XB_TOPGEN]) == tg, bar);
            __builtin_amdgcn_fence(__ATOMIC_ACQUIRE, "agent");
            xb_add(&bar[XB_XGEN(b.x)], 1u);
            asm volatile("s_waitcnt vmcnt(0)" ::: "memory");
        } else {
            XB_SPIN(xb_ld(&bar[XB_XGEN(b.x)]) == gen, bar);
            __builtin_amdgcn_fence(__ATOMIC_ACQUIRE, "agent");
            asm volatile("s_waitcnt vmcnt(0)" ::: "memory");
        }
    }
    __syncthreads();
}
struct Frame {
    LAS unsigned char* lds; volatile LAS unsigned* MISC; gu32* ctl;
    int tid, lane, wave, vcu, G;
    const float *x, *n1g, *w_in, *gq, *gk, *lbt, *hgn, *w_br, *w_out, *n2g, *w_gate, *w_up, *w_dn; float* out;
    bf16 *WIN, *WBR, *WOUT, *WGU, *WDN, *XN, *Q, *K, *V, *HQ, *HI, *HGG, *GS, *GH, *MIXED, *STASH, *ACT; float* LOGF;
};
__device__ __forceinline__ float wave_sum(float v) {
#pragma unroll
    for (int o = 1; o < 64; o <<= 1) v += __shfl_xor(v, o);
    return v;
}
__device__ __forceinline__ float bf2f(unsigned short h) { return __uint_as_float((unsigned)h << 16); }
__device__ __forceinline__ void p0_transpose_item(const float* W, int Nsrc, int ns, bf16* WT, int ldd, int nd, int k0, LAS float* scr, int lane, const float* kscale = nullptr) {
    { float wv[32];
#pragma unroll
      for (int i = 0; i < 32; ++i) { const int kk = 2 * i + (lane >> 5); wv[i] = W[(size_t)(k0 + kk) * Nsrc + ns + (lane & 31)]; }
      if (kscale) {
#pragma unroll
          for (int i = 0; i < 32; ++i) wv[i] *= kscale[k0 + 2 * i + (lane >> 5)]; }
#pragma unroll
      for (int i = 0; i < 32; ++i) { const int kk = 2 * i + (lane >> 5); scr[kk * 33 + (lane & 31)] = wv[i]; } }
    LDS_WAIT(); asm volatile("" ::: "memory");
    const int c = lane & 7;
#pragma unroll
    for (int j = 0; j < 4; ++j) { const int n = (lane >> 3) + 8 * j; const LAS float* s = scr + (8 * c) * 33 + n;
        v4u o; o.x = pk2(s[0 * 33], s[1 * 33]); o.y = pk2(s[2 * 33], s[3 * 33]); o.z = pk2(s[4 * 33], s[5 * 33]); o.w = pk2(s[6 * 33], s[7 * 33]);
        *(GAS v4u*)(WT + (size_t)(nd + n) * ldd + k0 + 8 * c) = o; }
    LDS_WAIT(); asm volatile("" ::: "memory");
}
template <int PART> __device__ __forceinline__ void p0_prologue(Frame& F) {
    LAS float* scr = (LAS float*)(F.lds + RING_OFF + F.wave * 16384);
    const int gw = PART == 0 ? F.vcu * NWAVES + F.wave : (((int)blockIdx.x >> 4) * 8 + ((int)blockIdx.x & 7)) * NWAVES + F.wave, NGW = PART == 0 ? F.G * NWAVES : (F.G / 2) * NWAVES;
    constexpr int I_IN = 16 * 176, I_BR = 16 * 32, I_OUT = 16 * 32, I_G = 16 * 88, I_U = 16 * 88, I_DN = 44 * 32;
    constexpr int NITEMS = I_IN + I_BR + I_OUT + I_G + I_U + I_DN;
    for (int it = (PART == 0 ? gw : I_IN + gw); it < (PART == 0 ? I_IN : NITEMS); it += NGW) {
        int r = it;
        if (r < I_IN) { const int kb = r / 176, nb = r % 176; int sb = nb;
            if (nb < 32) { const int pn = nb >> 3, rem = nb & 7, bj = rem >> 2, wc = rem & 3; sb = 8 * pn + 2 * wc + bj; }
            p0_transpose_item(F.w_in, NIN, 32 * sb, F.WIN, D, 32 * nb, 64 * kb, scr, F.lane); continue; } r -= I_IN;
        if (r < I_BR) { p0_transpose_item(F.w_br, D, 32 * (r % 32), F.WBR, D, 32 * (r % 32), 64 * (r / 32), scr, F.lane); continue; } r -= I_BR;
        if (r < I_OUT) { p0_transpose_item(F.w_out, D, 32 * (r % 32), F.WOUT, D, 32 * (r % 32), 64 * (r / 32), scr, F.lane); continue; } r -= I_OUT;
        if (r < I_G + I_U) { const bool up = r >= I_G; if (up) r -= I_G; const int kb = r / 88, sb = r % 88;
            p0_transpose_item(up ? F.w_up : F.w_gate, FFN, 32 * sb, F.WGU, D, 256 * (sb >> 2) + (up ? 128 : 0) + 32 * (sb & 3), 64 * kb, scr, F.lane, F.n2g); continue; } r -= I_G + I_U;
        p0_transpose_item(F.w_dn, D, 32 * (r % 32), F.WDN, FFN, 32 * (r % 32), 64 * (r / 32), scr, F.lane);
    }
    if (PART == 0) {
        const GAS f32x4* gr = (const GAS f32x4*)F.n1g + F.lane; f32x4 gv[4];
#pragma unroll
        for (int j = 0; j < 4; ++j) gv[j] = gr[64 * j];
        for (int m0 = gw * 8; m0 < M; m0 += NGW * 8) {
            f32x4 v[8][4];
#pragma unroll
            for (int r = 0; r < 8; ++r)
#pragma unroll
                for (int j = 0; j < 4; ++j) v[r][j] = ((const GAS f32x4*)(F.x + (size_t)(m0 + r) * D) + F.lane)[64 * j];
#pragma unroll
            for (int r = 0; r < 8; ++r) { float s = 0.f;
#pragma unroll
                for (int j = 0; j < 4; ++j) s += (v[r][j].x * v[r][j].x + v[r][j].y * v[r][j].y) + (v[r][j].z * v[r][j].z + v[r][j].w * v[r][j].w);
                const float rs = 1.0f / sqrtf(wave_sum(s) * (1.0f / 1024.0f) + EPS);
                GAS unsigned long long* o8 = (GAS unsigned long long*)(F.XN + (size_t)(m0 + r) * D) + F.lane;
#pragma unroll
                for (int j = 0; j < 4; ++j) o8[64 * j] = (unsigned long long)pk2(v[r][j].x * rs * gv[j].x, v[r][j].y * rs * gv[j].y) | ((unsigned long long)pk2(v[r][j].z * rs * gv[j].z, v[r][j].w * rs * gv[j].w) << 32); }
        }
    }
}

namespace sba {
typedef short bf16x8 __attribute__((ext_vector_type(8)));
typedef short s16x4 __attribute__((ext_vector_type(4)));
typedef float f32x16 __attribute__((ext_vector_type(16)));
typedef unsigned u32x4 __attribute__((ext_vector_type(4)));
typedef unsigned u32x2 __attribute__((ext_vector_type(2)));
#define SBA_MFMA(a, b, c) __builtin_amdgcn_mfma_f32_32x32x16_bf16((a), (b), (c), 0, 0, 0)
__device__ __forceinline__ int crow(int r, int hi) { return (r & 3) + 8 * (r >> 2) + 4 * hi; }
__device__ __forceinline__ bf16x8 pack_step(const f32x16& x, int s) {
    u32x4 p; p.x = pg8::cvt_pk_bf16(x[8 * s], x[8 * s + 1]); p.y = pg8::cvt_pk_bf16(x[8 * s + 2], x[8 * s + 3]); p.z = pg8::cvt_pk_bf16(x[8 * s + 4], x[8 * s + 5]); p.w = pg8::cvt_pk_bf16(x[8 * s + 6], x[8 * s + 7]);
    return __builtin_bit_cast(bf16x8, p); }
typedef short v4i16_t __attribute__((ext_vector_type(4)));
__device__ __forceinline__ s16x4 vtr(LAS const unsigned char* p) { return __builtin_bit_cast(s16x4, __builtin_amdgcn_ds_read_tr16_b64_v4i16((LAS v4i16_t*)p)); }

__device__ __forceinline__ void attn_phase(Frame& F) {
    const int lane = F.lane, r32 = lane & 31, hi = lane >> 5;
    LAS unsigned char* vst = F.lds + F.wave * 4096;
    LAS const unsigned char* vp0 = vst + ((lane >> 4) & 1) * 32 + (lane & 3) * 8 + (4 * hi + ((lane & 15) >> 2)) * 64;
    float gm = fabsf(F.gq[lane]), km = fabsf(F.gk[lane]);
#pragma unroll
    for (int o = 1; o < 64; o <<= 1) { gm = fmaxf(gm, __shfl_xor(gm, o)); km = fmaxf(km, __shfl_xor(km, o)); }
    const float THR = 152.0f + 1.02f * (QSCALE * 64.0f) * gm * km;
    bf16x8 tf0, tf1;
#pragma unroll
    for (int j = 0; j < 8; ++j) { const int k0 = 8 * (j >> 2) + 4 * hi + (j & 3); tf0[j] = (k0 >= r32) ? (short)0x3F80 : (short)0; tf1[j] = (16 + k0 >= r32) ? (short)0x3F80 : (short)0; }
    const int gw = F.vcu * NWAVES + F.wave, NGW = F.G * NWAVES;
    for (int u = gw; u < BATCH * SBH * (SEQ / 32); u += NGW) {
        const int bh = u >> 7, qblk = u & 127, b = bh >> 3, h = bh & 7, t0 = qblk * 32;
        const size_t rowb = (size_t)b * SEQ;
        bf16x8 qf[4];
        { const bf16* qp = F.Q + (rowb + t0 + r32) * SBW + h * 64 + 8 * hi;
#pragma unroll
          for (int d0 = 0; d0 < 4; ++d0) qf[d0] = *(const GAS bf16x8*)(qp + 16 * d0); }
        const bf16* kbase = F.K + rowb * SBW + h * 64 + 8 * hi; const bf16* vbase = F.V + rowb * SBW + h * 64 + (lane & 7) * 8;
        f32x16 o0, o1;
#pragma unroll
        for (int r = 0; r < 16; ++r) { o0[r] = 0.f; o1[r] = 0.f; }
        float Rc = 0.f;
        int ht = qblk; bool diag = true;
        bf16x8 kn[4]; u32x4 vn[4];
#define SBA_LOAD(HT) do { _Pragma("unroll") for (int d0 = 0; d0 < 4; ++d0) kn[d0] = *(const GAS bf16x8*)(kbase + (size_t)(32 * (HT) + r32) * SBW + 16 * d0); \
        _Pragma("unroll") for (int i = 0; i < 4; ++i) vn[i] = *(const GAS u32x4*)(vbase + (size_t)(32 * (HT) + 8 * i + (lane >> 3)) * SBW); } while (0)
        SBA_LOAD(ht);
        for (;;) {
#pragma unroll
            for (int i = 0; i < 4; ++i) { const int key = 8 * i + (lane >> 3), ch = lane & 7; *(LAS u32x4*)(vst + (ch >> 2) * 2048 + (key >> 4) * 1024 + (key & 15) * 64 + (ch & 3) * 16) = vn[i]; }
            bf16x8 kc[4];
#pragma unroll
            for (int d0 = 0; d0 < 4; ++d0) kc[d0] = kn[d0];
            if (ht > 0) SBA_LOAD(ht - 1);
            f32x16 z;
#pragma unroll
            for (int r = 0; r < 16; ++r) z[r] = 0.f;
#pragma unroll
            for (int d0 = 0; d0 < 4; ++d0) z = SBA_MFMA(kc[d0], qf[d0], z);
            f32x16 s;
#pragma unroll
            for (int r = 0; r < 16; ++r) { s[r] = __builtin_amdgcn_logf(1.0f + __builtin_amdgcn_exp2f(z[r])); if (diag) { if (crow(r, hi) >= r32) s[r] = 0.f; } }
            const bf16x8 x0 = pack_step(s, 0), x1 = pack_step(s, 1);
            f32x16 c;
#pragma unroll
            for (int r = 0; r < 16; ++r) c[r] = Rc;
            c = SBA_MFMA(tf0, x0, c); c = SBA_MFMA(tf1, x1, c);
#pragma unroll
            for (int r = 0; r < 16; ++r) { z[r] = __builtin_amdgcn_exp2f(z[r] - c[r]); if (diag) { if (crow(r, hi) >= r32) z[r] = 0.f; } }
            const bf16x8 w0 = pack_step(z, 0), w1 = pack_step(z, 1);
            { const s16x4 l00 = vtr(vp0), h00 = vtr(vp0 + 512), l01 = vtr(vp0 + 1024), h01 = vtr(vp0 + 1536), l10 = vtr(vp0 + 2048), h10 = vtr(vp0 + 2560), l11 = vtr(vp0 + 3072), h11 = vtr(vp0 + 3584);
#define SBA_VF(l, h) (bf16x8){l[0], l[1], l[2], l[3], h[0], h[1], h[2], h[3]}
              o0 = SBA_MFMA(SBA_VF(l00, h00), w0, o0); o0 = SBA_MFMA(SBA_VF(l01, h01), w1, o0);
              o1 = SBA_MFMA(SBA_VF(l10, h10), w0, o1); o1 = SBA_MFMA(SBA_VF(l11, h11), w1, o1);
#undef SBA_VF
            }
            Rc = __shfl(c[0], r32);
            if (ht == 0) break;
            if (__all(Rc >= THR)) break;
            --ht; diag = false;
        }
#undef SBA_LOAD
        bf16* op = F.XN + (rowb + t0 + r32) * D + h * 64 + 4 * hi;
#pragma unroll
        for (int g = 0; g < 4; ++g) {
            u32x2 a, c; a.x = pg8::cvt_pk_bf16(o0[4 * g], o0[4 * g + 1]); a.y = pg8::cvt_pk_bf16(o0[4 * g + 2], o0[4 * g + 3]); c.x = pg8::cvt_pk_bf16(o1[4 * g], o1[4 * g + 1]); c.y = pg8::cvt_pk_bf16(o1[4 * g + 2], o1[4 * g + 3]);
            *(GAS u32x2*)(op + 8 * g) = a; *(GAS u32x2*)(op + 32 + 8 * g) = c; }
    }
}
#undef SBA_MFMA
}

namespace hg {
typedef short bf16x8 __attribute__((ext_vector_type(8)));
typedef short s16x4 __attribute__((ext_vector_type(4)));
typedef float f32x16 __attribute__((ext_vector_type(16)));
typedef unsigned u32x4 __attribute__((ext_vector_type(4)));
typedef unsigned u32x2 __attribute__((ext_vector_type(2)));
#define HG_MFMA(a, b, c) __builtin_amdgcn_mfma_f32_32x32x16_bf16((a), (b), (c), 0, 0, 0)
constexpr float LOG2E = 1.4426950408889634f;
__device__ __forceinline__ int imgoff(int row, int ch) { return 256 * row + 16 * (ch ^ (((row & 3) << 2) | ((row >> 2) & 3))); }
__device__ __forceinline__ int crow(int r, int hi) { return (r & 3) + 8 * (r >> 2) + 4 * hi; }
__device__ __forceinline__ s16x4 vtr(LAS const unsigned char* p) { return __builtin_bit_cast(s16x4, __builtin_amdgcn_ds_read_tr16_b64_v4i16((LAS sba::v4i16_t*)p)); }
__device__ __forceinline__ bf16x8 cat8(s16x4 lo, s16x4 hh) { return (bf16x8){lo[0], lo[1], lo[2], lo[3], hh[0], hh[1], hh[2], hh[3]}; }
__device__ __forceinline__ bf16x8 trfrag(LAS const unsigned char* img, int r0, int r1, int c, int lane) {
    const int blk = (lane >> 4) & 1, q = (lane & 15) >> 2, p = lane & 3, ch = 4 * c + 2 * blk + (p >> 1), by = 8 * (p & 1);
    return cat8(vtr(img + imgoff(r0 + q, ch) + by), vtr(img + imgoff(r1 + q, ch) + by));
}
__device__ __forceinline__ bf16x8 rowfrag(LAS const unsigned char* img, int row, int ch) { return *(const LAS bf16x8*)(img + imgoff(row, ch)); }
__device__ __forceinline__ u32x2 pack4(float a, float b, float c, float d) { u32x2 w; w.x = pg8::cvt_pk_bf16(a, b); w.y = pg8::cvt_pk_bf16(c, d); return w; }
__device__ __forceinline__ f32x4 unpack4(u32x2 w) { return (f32x4){__uint_as_float(w.x << 16), __uint_as_float(w.x & 0xffff0000u), __uint_as_float(w.y << 16), __uint_as_float(w.y & 0xffff0000u)}; }
__device__ __forceinline__ bf16x8 pack_step(const f32x16& x, int s) { return sba::pack_step(x, s); }
__device__ __forceinline__ f32x4 vexp2(const f32x4 x) { return (f32x4){__builtin_amdgcn_exp2f(x[0]), __builtin_amdgcn_exp2f(x[1]), __builtin_amdgcn_exp2f(x[2]), __builtin_amdgcn_exp2f(x[3])}; }
__device__ __forceinline__ f32x4 vrcp(const f32x4 x) { return (f32x4){__builtin_amdgcn_rcpf(x[0]), __builtin_amdgcn_rcpf(x[1]), __builtin_amdgcn_rcpf(x[2]), __builtin_amdgcn_rcpf(x[3])}; }
__device__ __forceinline__ f32x4 vlog2(const f32x4 x) { return (f32x4){__builtin_amdgcn_logf(x[0]), __builtin_amdgcn_logf(x[1]), __builtin_amdgcn_logf(x[2]), __builtin_amdgcn_logf(x[3])}; }
__device__ __forceinline__ f32x4 vsigm(const f32x4 x) { return vrcp(vexp2(x * -1.4426950408889634f) + 1.0f); }


constexpr int NUNIT = BATCH * HGH * (SEQ / 64);
__device__ __forceinline__ f32x4 gl_of(const f32x4 x, const f32x4 lb, f32x4& km) {
    const f32x4 f = lb + (1.0f - lb) * vsigm(x); km = 1.0f - f; return vlog2(f); }
constexpr int NSEG = BATCH * HGH * 8;
__device__ __forceinline__ void pass1(Frame& F, bf16* L, float* Dl) {
    const int tid = F.tid, lane = F.lane, kq = tid & 31, tq = tid >> 5, r32 = lane & 31, hi = lane >> 5;
    LAS unsigned char* imgK = F.lds; LAS unsigned char* imgV = F.lds + 16384; LAS float* SEG = (LAS float*)(F.lds + 32768); LAS float* DLS = (LAS float*)(F.lds + 40960);
    const int vb = F.wave & 3, kp = F.wave >> 2;
    u32x2 gx[4]; u32x4 vv[2];
#define HG_P1_LOAD(UNIT) do { const int bh_ = (UNIT) >> 6, c_ = (UNIT) & 63, b_ = bh_ >> 2, h_ = bh_ & 3; const size_t r0_ = (size_t)b_ * SEQ + c_ * 64; \
        _Pragma("unroll") for (int i = 0; i < 4; ++i) gx[i] = *(const GAS u32x2*)((const bf16*)F.LOGF + (r0_ + 4 * tq + i) * HGW + h_ * 128 + 4 * kq); \
        _Pragma("unroll") for (int j = 0; j < 2; ++j) { const int id = tid + 512 * j; vv[j] = *(const GAS u32x4*)(F.HI + (r0_ + (id >> 4)) * HGW + h_ * 128 + 8 * (id & 15)); } } while (0)
    for (int seg = F.vcu; seg < NSEG; seg += F.G) {
        const int h = (seg >> 3) & 3, unit0 = seg * 8;
        f32x4 lb; { const f32x4 t0 = *(const GAS f32x4*)(F.lbt + h * 128 + 4 * kq), t1 = *(const GAS f32x4*)(F.lbt + 512 + h * 128 + 4 * kq);
#pragma unroll
            for (int j = 0; j < 4; ++j) lb[j] = pg8::sigm(t0[j] - t1[j]); }
        f32x16 acc0, acc1; f32x4 dsum = (f32x4){0.f, 0.f, 0.f, 0.f};
#pragma unroll
        for (int r = 0; r < 16; ++r) { acc0[r] = 0.f; acc1[r] = 0.f; }
        HG_P1_LOAD(unit0);
        for (int cc = 0; cc < 8; ++cc) {
            f32x4 g[4], km[4];
#pragma unroll
            for (int i = 0; i < 4; ++i) g[i] = gl_of(unpack4(gx[i]), lb, km[i]);
#pragma unroll
            for (int j = 0; j < 2; ++j) { const int id = tid + 512 * j, row = id >> 4, ch = id & 15; *(LAS u32x4*)(imgV + imgoff(row, ch)) = vv[j]; }
            asm volatile("" : "+v"(g[0]), "+v"(g[1]), "+v"(g[2]), "+v"(g[3]), "+v"(km[0]), "+v"(km[1]), "+v"(km[2]), "+v"(km[3]) :: "memory");
            __builtin_amdgcn_sched_barrier(0); { const int nu = cc < 7 ? unit0 + cc + 1 : unit0 + cc; HG_P1_LOAD(nu); } __builtin_amdgcn_sched_barrier(0);
            f32x4 rs[4]; rs[3] = (f32x4){0.f, 0.f, 0.f, 0.f}; rs[2] = g[3]; rs[1] = g[3] + g[2]; rs[0] = rs[1] + g[1];
            const f32x4 tot = rs[0] + g[0];
            *(LAS f32x4*)(SEG + tq * 128 + 4 * kq) = tot;
            asm volatile("s_waitcnt lgkmcnt(0)" ::: "memory"); __builtin_amdgcn_s_barrier(); asm volatile("" ::: "memory");
            f32x4 suf = (f32x4){0.f, 0.f, 0.f, 0.f}, all = (f32x4){0.f, 0.f, 0.f, 0.f};
#pragma unroll
            for (int s = 0; s < 16; ++s) { const f32x4 t = *(const LAS f32x4*)(SEG + s * 128 + 4 * kq); all += t; if (s > tq) suf += t; }
#pragma unroll
            for (int i = 0; i < 4; ++i) { const f32x4 kh = km[i] * vexp2(suf + rs[i]);
                *(LAS u32x2*)(imgK + imgoff(4 * tq + i, kq >> 1) + 8 * (kq & 1)) = pack4(kh[0], kh[1], kh[2], kh[3]); }
            if (tq == 0) { *(LAS f32x4*)(DLS + 4 * kq) = all; dsum += all; }
            asm volatile("s_waitcnt lgkmcnt(0)" ::: "memory"); __builtin_amdgcn_s_barrier(); asm volatile("" ::: "memory");
            { const float d0 = __builtin_amdgcn_exp2f(DLS[64 * kp + r32]), d1 = __builtin_amdgcn_exp2f(DLS[64 * kp + 32 + r32]);
#pragma unroll
              for (int r = 0; r < 16; ++r) { acc0[r] *= d0; acc1[r] *= d1; } }
#pragma unroll
            for (int ks = 0; ks < 4; ++ks) {
                const bf16x8 af = trfrag(imgV, 16 * ks + 8 * hi, 16 * ks + 8 * hi + 4, vb, lane);
                acc0 = HG_MFMA(af, trfrag(imgK, 16 * ks + 8 * hi, 16 * ks + 8 * hi + 4, 2 * kp, lane), acc0);
                acc1 = HG_MFMA(af, trfrag(imgK, 16 * ks + 8 * hi, 16 * ks + 8 * hi + 4, 2 * kp + 1, lane), acc1);
            }
            asm volatile("s_waitcnt lgkmcnt(0)" ::: "memory"); __builtin_amdgcn_s_barrier(); asm volatile("" ::: "memory");
        }
        bf16* lp = L + (size_t)seg * 16384 + 32 * vb + 4 * hi;
#pragma unroll
        for (int gq = 0; gq < 4; ++gq) {
            *(GAS u32x2*)(lp + (size_t)(64 * kp + r32) * 128 + 8 * gq) = pack4(acc0[4 * gq], acc0[4 * gq + 1], acc0[4 * gq + 2], acc0[4 * gq + 3]);
            *(GAS u32x2*)(lp + (size_t)(64 * kp + 32 + r32) * 128 + 8 * gq) = pack4(acc1[4 * gq], acc1[4 * gq + 1], acc1[4 * gq + 2], acc1[4 * gq + 3]); }
        if (tq == 0) *(GAS f32x4*)(Dl + (size_t)seg * 128 + 4 * kq) = dsum;
    }
#undef HG_P1_LOAD
}
__device__ __forceinline__ void pass3(Frame& F, const bf16* Lseg, const float* Dseg) {
    const int tid = F.tid, lane = F.lane, kq = tid & 31, tq = tid >> 5, r32 = lane & 31, hi = lane >> 5;
    LAS unsigned char* imgQT = F.lds; LAS unsigned char* imgKT = F.lds + 16384; LAS unsigned char* imgQH = F.lds + 32768; LAS unsigned char* imgV = F.lds + 49152; LAS unsigned char* imgS = F.lds + 65536;
    LAS unsigned char* imgKH = F.lds + 98304; LAS float* SEG = (LAS float*)(F.lds + 114688); LAS float* RSS = (LAS float*)(F.lds + 122880); LAS float* DLS = (LAS float*)(F.lds + 123904);
    const int tb = F.wave >> 2, vb = F.wave & 3, kp = F.wave >> 2;
    u32x2 gx[4]; u32x2 qw[4]; u32x4 vv[2];
#define HG_P3_LOAD(UNIT) do { const int bh_ = (UNIT) >> 6, c_ = (UNIT) & 63, b_ = bh_ >> 2, h_ = bh_ & 3; const size_t r0_ = (size_t)b_ * SEQ + c_ * 64; \
        _Pragma("unroll") for (int i = 0; i < 4; ++i) { gx[i] = *(const GAS u32x2*)((const bf16*)F.LOGF + (r0_ + 4 * tq + i) * HGW + h_ * 128 + 4 * kq); qw[i] = *(const GAS u32x2*)(F.HQ + (r0_ + 4 * tq + i) * HGW + h_ * 128 + 4 * kq); } \
        _Pragma("unroll") for (int j = 0; j < 2; ++j) { const int id = tid + 512 * j; vv[j] = *(const GAS u32x4*)(F.HI + (r0_ + (id >> 4)) * HGW + h_ * 128 + 8 * (id & 15)); } } while (0)
    for (int seg = F.vcu; seg < NSEG; seg += F.G) {
        const int bh = seg >> 3, sj = seg & 7, b = bh >> 2, h = bh & 3, unit0 = seg * 8;
        HG_P3_LOAD(unit0);
        f32x4 lb; { const f32x4 t0 = *(const GAS f32x4*)(F.lbt + h * 128 + 4 * kq), t1 = *(const GAS f32x4*)(F.lbt + 512 + h * 128 + 4 * kq);
#pragma unroll
            for (int j = 0; j < 4; ++j) lb[j] = pg8::sigm(t0[j] - t1[j]); }
        f32x16 acc0, acc1;
#pragma unroll
        for (int r = 0; r < 16; ++r) { acc0[r] = 0.f; acc1[r] = 0.f; }
        if (sj > 0) {
            float d0v[7], d1v[7]; u32x2 l0v[7][4], l1v[7][4];
#pragma unroll
            for (int i = 0; i < 7; ++i) { const int sg = bh * 8 + (i < sj ? i : sj - 1);
                d0v[i] = Dseg[(size_t)sg * 128 + 64 * kp + r32]; d1v[i] = Dseg[(size_t)sg * 128 + 64 * kp + 32 + r32];
                const bf16* lp = Lseg + (size_t)sg * 16384 + 32 * vb + 4 * hi;
#pragma unroll
                for (int gq = 0; gq < 4; ++gq) { l0v[i][gq] = *(const GAS u32x2*)(lp + (size_t)(64 * kp + r32) * 128 + 8 * gq); l1v[i][gq] = *(const GAS u32x2*)(lp + (size_t)(64 * kp + 32 + r32) * 128 + 8 * gq); } }
#pragma unroll
            for (int i = 0; i < 7; ++i) { const bool on = i < sj; const float d0 = on ? __builtin_amdgcn_exp2f(d0v[i]) : 1.0f, d1 = on ? __builtin_amdgcn_exp2f(d1v[i]) : 1.0f;
#pragma unroll
                for (int gq = 0; gq < 4; ++gq) { const f32x4 l0 = unpack4(l0v[i][gq]), l1 = unpack4(l1v[i][gq]);
#pragma unroll
                    for (int j = 0; j < 4; ++j) { acc0[4 * gq + j] = acc0[4 * gq + j] * d0 + (on ? l0[j] : 0.f); acc1[4 * gq + j] = acc1[4 * gq + j] * d1 + (on ? l1[j] : 0.f); } } }
        }
        for (int cc = 0; cc < 8; ++cc) {
            int lane_o = F.lane; asm volatile("" : "+v"(lane_o));
            const int lane = lane_o, r32 = lane & 31, hi = lane >> 5;
            const int c = sj * 8 + cc; const size_t row0 = (size_t)b * SEQ + c * 64;
            const size_t orow = row0 + 32 * tb + r32;
            u32x2 gtw[4]; f32x4 gnv[4];
#pragma unroll
            for (int gq = 0; gq < 4; ++gq) { gtw[gq] = *(const GAS u32x2*)(F.HGG + orow * HGW + h * 128 + 32 * vb + 8 * gq + 4 * hi); gnv[gq] = *(const GAS f32x4*)(F.hgn + 32 * vb + 8 * gq + 4 * hi); }
            f32x4 g[4], km[4]; f32x4 qv[4];
#pragma unroll
            for (int i = 0; i < 4; ++i) { g[i] = gl_of(unpack4(gx[i]), lb, km[i]); const f32x4 qr = unpack4(qw[i]); qv[i] = qr * vsigm(qr); }
#pragma unroll
            for (int j = 0; j < 2; ++j) { const int id = tid + 512 * j, row = id >> 4, ch = id & 15; *(LAS u32x4*)(imgV + imgoff(row, ch)) = vv[j]; }
#pragma unroll
            for (int gq = 0; gq < 4; ++gq) {
                *(LAS u32x2*)(imgS + imgoff(64 * kp + r32, 4 * vb + gq) + 8 * hi) = pack4(acc0[4 * gq], acc0[4 * gq + 1], acc0[4 * gq + 2], acc0[4 * gq + 3]);
                *(LAS u32x2*)(imgS + imgoff(64 * kp + 32 + r32, 4 * vb + gq) + 8 * hi) = pack4(acc1[4 * gq], acc1[4 * gq + 1], acc1[4 * gq + 2], acc1[4 * gq + 3]); }
            asm volatile("" : "+v"(g[0]), "+v"(g[1]), "+v"(g[2]), "+v"(g[3]), "+v"(qv[0]), "+v"(qv[1]), "+v"(qv[2]), "+v"(qv[3]), "+v"(km[0]), "+v"(km[1]), "+v"(km[2]), "+v"(km[3]) :: "memory");
            __builtin_amdgcn_sched_barrier(0); { const int nu = cc < 7 ? unit0 + cc + 1 : unit0 + cc; HG_P3_LOAD(nu); } __builtin_amdgcn_sched_barrier(0);
            *(LAS f32x4*)(SEG + tq * 128 + 4 * kq) = (g[0] + g[1]) + (g[2] + g[3]);
            asm volatile("s_waitcnt lgkmcnt(0)" ::: "memory"); __builtin_amdgcn_s_barrier(); asm volatile("" ::: "memory");
            f32x4 pre = (f32x4){0.f, 0.f, 0.f, 0.f}, ref = (f32x4){0.f, 0.f, 0.f, 0.f}, all = (f32x4){0.f, 0.f, 0.f, 0.f};
#pragma unroll
            for (int s8 = 0; s8 < 16; s8 += 4) { f32x4 sg[4];
#pragma unroll
              for (int s = 0; s < 4; ++s) sg[s] = *(const LAS f32x4*)(SEG + (s8 + s) * 128 + 4 * kq);
#pragma unroll
              for (int s = 0; s < 4; ++s) { all += sg[s]; if (s8 + s < tq) pre += sg[s]; if (s8 + s < 8) ref += sg[s]; } }
            f32x4 c1, c2;
            c1 = vexp2(ref); c2 = vexp2(all - ref);
#pragma unroll
            for (int i = 0; i < 4; ++i) { pre += g[i];
                const f32x4 dq = pre - ref, qt = qv[i] * vexp2(dq), kt = km[i] * vexp2(-dq), qh = qt * c1, kh = kt * c2;
                const int o = imgoff(4 * tq + i, kq >> 1) + 8 * (kq & 1);
                *(LAS u32x2*)(imgQT + o) = pack4(qt[0], qt[1], qt[2], qt[3]); *(LAS u32x2*)(imgKT + o) = pack4(kt[0], kt[1], kt[2], kt[3]); *(LAS u32x2*)(imgQH + o) = pack4(qh[0], qh[1], qh[2], qh[3]);
                *(LAS u32x2*)(imgKH + o) = pack4(kh[0], kh[1], kh[2], kh[3]); }
            if (tq == 0) *(LAS f32x4*)(DLS + 4 * kq) = all;
            asm volatile("s_waitcnt lgkmcnt(0)" ::: "memory"); __builtin_amdgcn_s_barrier(); asm volatile("" ::: "memory");
            f32x16 o;
#pragma unroll
            for (int r = 0; r < 16; ++r) o[r] = 0.f;
#pragma unroll
            for (int k4 = 0; k4 < 8; k4 += 4) { bf16x8 sa[4], qb[4];
#pragma unroll
              for (int ks = 0; ks < 4; ++ks) { sa[ks] = trfrag(imgS, 16 * (k4 + ks) + 8 * hi, 16 * (k4 + ks) + 8 * hi + 4, vb, lane); qb[ks] = rowfrag(imgQH, 32 * tb + r32, 2 * (k4 + ks) + hi); }
#pragma unroll
              for (int ks = 0; ks < 4; ++ks) o = HG_MFMA(sa[ks], qb[ks], o); }
#pragma unroll
            for (int sb = 0; sb < 2; ++sb) {
                if (sb <= tb) {
                    f32x16 at;
#pragma unroll
                    for (int r = 0; r < 16; ++r) at[r] = 0.f;
#pragma unroll
                    for (int k4 = 0; k4 < 8; k4 += 4) { bf16x8 ka[4], qa[4];
#pragma unroll
                      for (int ks = 0; ks < 4; ++ks) { ka[ks] = rowfrag(imgKT, 32 * sb + r32, 2 * (k4 + ks) + hi); qa[ks] = rowfrag(imgQT, 32 * tb + r32, 2 * (k4 + ks) + hi); }
#pragma unroll
                      for (int ks = 0; ks < 4; ++ks) at = HG_MFMA(ka[ks], qa[ks], at); }
                    if (sb == tb) {
#pragma unroll
                        for (int r = 0; r < 16; ++r) if (crow(r, hi) > r32) at[r] = 0.f; }
#pragma unroll
                    for (int st = 0; st < 2; ++st) { const int s0 = 32 * sb + 16 * st + 4 * hi;
                        o = HG_MFMA(trfrag(imgV, s0, s0 + 8, vb, lane), pack_step(at, st), o); }
                }
            }
            { const float d0 = __builtin_amdgcn_exp2f(DLS[64 * kp + r32]), d1 = __builtin_amdgcn_exp2f(DLS[64 * kp + 32 + r32]);
#pragma unroll
              for (int r = 0; r < 16; ++r) { acc0[r] *= d0; acc1[r] *= d1; } }
#pragma unroll
            for (int ks = 0; ks < 4; ++ks) {
                const bf16x8 af = trfrag(imgV, 16 * ks + 8 * hi, 16 * ks + 8 * hi + 4, vb, lane);
                acc0 = HG_MFMA(af, trfrag(imgKH, 16 * ks + 8 * hi, 16 * ks + 8 * hi + 4, 2 * kp, lane), acc0);
                acc1 = HG_MFMA(af, trfrag(imgKH, 16 * ks + 8 * hi, 16 * ks + 8 * hi + 4, 2 * kp + 1, lane), acc1);
            }
            float ss = 0.f;
#pragma unroll
            for (int r = 0; r < 16; ++r) ss += o[r] * o[r];
            ss += __shfl_xor(ss, 32);
            if (hi == 0) RSS[(32 * tb + r32) * 4 + vb] = ss;
            asm volatile("s_waitcnt lgkmcnt(0)" ::: "memory"); __builtin_amdgcn_s_barrier(); asm volatile("" ::: "memory");
            const f32x4 pr = *(const LAS f32x4*)(RSS + (32 * tb + r32) * 4);
            const float rn = 1.0f / sqrtf(((pr[0] + pr[1]) + (pr[2] + pr[3])) * (1.0f / 128.0f) + EPS);
#pragma unroll
            for (int gq = 0; gq < 4; ++gq) { const int v = 32 * vb + 8 * gq + 4 * hi;
                const f32x4 gr = unpack4(gtw[gq]), sc = (gnv[gq] * rn) * (gr * vsigm(gr));
                *(GAS u32x2*)(F.XN + orow * D + 512 + h * 128 + v) = pack4(o[4 * gq] * sc[0], o[4 * gq + 1] * sc[1], o[4 * gq + 2] * sc[2], o[4 * gq + 3] * sc[3]); }
            asm volatile("s_waitcnt lgkmcnt(0)" ::: "memory"); __builtin_amdgcn_s_barrier(); asm volatile("" ::: "memory");
        }
    }
#undef HG_P3_LOAD
}
#undef HG_MFMA
}

struct Args { const float* in[13]; float* out; unsigned char* ws; int ph_lo, ph_hi; };
__global__ void __launch_bounds__(NWAVES * 64, 2) skel_fwd(Args args) {
    extern __shared__ __attribute__((aligned(16))) unsigned char lds[];
    Frame F;
    F.lds = (LAS unsigned char*)lds; F.MISC = (volatile LAS unsigned*)(F.lds + MISC_OFF);
    F.tid = threadIdx.x; F.lane = F.tid & 63; F.wave = __builtin_amdgcn_readfirstlane(F.tid >> 6);
    F.G = gridDim.x; { const int bx = blockIdx.x; F.vcu = (F.G % 8 == 0) ? (bx % 8) * (F.G / 8) + bx / 8 : bx; }
    unsigned char* ws = args.ws;
    F.ctl = (gu32*)(ws + WS_CTL);
    F.x = args.in[0]; F.n1g = args.in[1]; F.w_in = args.in[2]; F.gq = args.in[3]; F.gk = args.in[4]; F.lbt = args.in[5]; F.hgn = args.in[6]; F.w_br = args.in[7]; F.w_out = args.in[8];
    F.n2g = args.in[9]; F.w_gate = args.in[10]; F.w_up = args.in[11]; F.w_dn = args.in[12]; F.out = args.out;
    F.WIN = (bf16*)(ws + WS_WIN); F.WBR = (bf16*)(ws + WS_WBR); F.WOUT = (bf16*)(ws + WS_WOUT); F.WGU = (bf16*)(ws + WS_WGU); F.WDN = (bf16*)(ws + WS_WDN);
    F.XN = (bf16*)(ws + WS_XN); F.Q = (bf16*)(ws + WS_Q); F.K = (bf16*)(ws + WS_K); F.V = (bf16*)(ws + WS_V); F.HQ = (bf16*)(ws + WS_HQ); F.LOGF = (float*)(ws + WS_LOGF);
    F.HI = (bf16*)(ws + WS_HI); F.HGG = (bf16*)(ws + WS_HGG); F.GS = (bf16*)(ws + WS_GS); F.GH = (bf16*)(ws + WS_GH); F.MIXED = (bf16*)(ws + WS_MIXED); F.STASH = (bf16*)(ws + WS_STASH); F.ACT = (bf16*)(ws + WS_ACT);
    for (int u = F.tid; u < (LDS_BYTES - LDSCTL_OFF) / 4; u += NWAVES * 64) ((LAS unsigned*)(F.lds + LDSCTL_OFF))[u] = 0u;
    __syncthreads();
    XcdBarrier bar; bar.bar = (unsigned*)(F.ctl + CW_BAR); bar.x = 0; bar.st = nullptr;
    if (MK_ONE_LAUNCH) bar = xcd_barrier_post((unsigned*)(F.ctl + CW_BAR), F.MISC + 8);
    const int lo = args.ph_lo, hi = args.ph_hi;
#define IN(k) (lo <= (k) && (k) < hi)
#define SEAM(k) do { if (IN(k) && IN((k) + 1)) xcd_barrier(bar); } while (0)

    if (IN(0)) { p0_prologue<0>(F); } SEAM(0);
    if (IN(1)) {
        if (((int)blockIdx.x >> 3) & 1) { p0_prologue<1>(F); asm volatile("s_waitcnt vmcnt(0) lgkmcnt(0)" ::: "memory"); } __syncthreads();
        pg8::Gemm g{F.XN, F.WIN, M, NIN, D, D, D}; pg8::StaticOrder S; S.init(M, NIN, F.G, (int)blockIdx.x);
        pg8::EpiProj E{F.Q, F.K, F.V, F.HQ, F.HI, F.HGG, F.GS, F.GH, F.LOGF, F.gq, F.gk, F.lbt, QSCALE, EPS};
        pg8::gemm_phase<pg8::EpiProj, pg8::StaticOrder, true, true>(F.lds + RING_OFF, g, S, E);
    } SEAM(1);
    bf16* HL = (bf16*)F.out; float* HDl = (float*)((unsigned char*)F.out + 64 * MiB);
    if (IN(2)) { hg::pass1(F, HL, HDl); __syncthreads(); sba::attn_phase(F); } SEAM(2);
    if (IN(3)) { hg::pass3(F, HL, HDl); } SEAM(3);
    if (IN(4)) {
        pg8::Gemm g{F.XN, F.WBR, M, D, D, D, D}; pg8::StaticOrder S; S.init(M, D, F.G, (int)blockIdx.x);
        pg8::EpiGateK E{(const unsigned char*)F.GS, (const unsigned char*)F.GH, F.MIXED};
        pg8::gemm_phase<pg8::EpiGateK, pg8::StaticOrder, true, true>(F.lds + RING_OFF, g, S, E);
    } SEAM(4);
    float* rowss = (float*)(ws + WS_CTL + 524288);
    if (IN(5)) {
        pg8::Gemm g{F.MIXED, F.WOUT, M, D, D, D, D}; pg8::StaticOrder S; S.init(M, D, F.G, (int)blockIdx.x);
        pg8::EpiResSq E{F.x, F.XN, rowss};
        pg8::gemm_phase<pg8::EpiResSq, pg8::StaticOrder, true, true>(F.lds + RING_OFF, g, S, E);
    } SEAM(5);
    if (IN(6)) {
        pg8::Gemm g{F.XN, F.WGU, M, NIN, D, D, D}; pg8::StaticOrder S; S.init(M, NIN, F.G, (int)blockIdx.x);
        pg8::EpiSwiglu E{F.ACT, FFN, rowss, EPS};
        pg8::gemm_phase<pg8::EpiSwiglu, pg8::StaticOrder, true, true>(F.lds + RING_OFF, g, S, E);
    } SEAM(6);
    if (IN(7)) {
        pg8::Gemm g{F.ACT, F.WDN, M, D, FFN, FFN, FFN}; pg8::StaticOrder S; S.init(M, D, F.G, (int)blockIdx.x);
        pg8::EpiResHn E{F.XN, F.out};
        pg8::gemm_phase<pg8::EpiResHn, pg8::StaticOrder, true, true>(F.lds + RING_OFF, g, S, E);
    }
#undef IN
#undef SEAM
}

extern "C" void kernel_launch(void* const* d_in, const int* in_sizes, int n_in, void* d_out, int out_size, void* d_ws, size_t ws_size, hipStream_t stream) {
    static int grid = 0;
    if (grid == 0) {
        if (n_in != 13 || in_sizes[0] != M * D || out_size != M * D || ws_size < WS_END) { fprintf(stderr, "kernel_launch: unexpected shapes / workspace (n_in %d, ws %zu); nothing launched\n", n_in, ws_size); grid = -1; return; }
        int dev = 0, cus = 0;
        if (hipGetDevice(&dev) != hipSuccess || hipDeviceGetAttribute(&cus, hipDeviceAttributeMultiprocessorCount, dev) != hipSuccess) { grid = -1; return; }
        if (hipFuncSetAttribute((const void*)skel_fwd, hipFuncAttributeMaxDynamicSharedMemorySize, LDS_BYTES) != hipSuccess) { grid = -1; return; }
        int per_cu = 0;
        if (hipOccupancyMaxActiveBlocksPerMultiprocessor(&per_cu, (const void*)skel_fwd, NWAVES * 64, LDS_BYTES) != hipSuccess || per_cu < 1) { fprintf(stderr, "kernel_launch: occupancy query says %d\n", per_cu); }
        (void)hipGetLastError();
        grid = cus;
    }
    if (grid < 0) return;
    (void)hipMemsetAsync((char*)d_ws + WS_CTL, 0, CTL_ZERO_BYTES, stream);
    Args a{};
    for (int i = 0; i < 13; ++i) a.in[i] = (const float*)d_in[i];
    a.out = (float*)d_out; a.ws = (unsigned char*)d_ws;
    if (MK_ONE_LAUNCH) { a.ph_lo = 0; a.ph_hi = N_PHASES; hipLaunchKernelGGL(skel_fwd, dim3(grid), dim3(NWAVES * 64), LDS_BYTES, stream, a); }
    else for (int p = 0; p < N_PHASES; ++p) { a.ph_lo = p; a.ph_hi = p + 1; hipLaunchKernelGGL(skel_fwd, dim3(grid), dim3(NWAVES * 64), LDS_BYTES, stream, a); }
}
```

```cpp
#include <hip/hip_runtime.h>
#include <cstdio>
#include <cstdint>
namespace pg8 {
#define PG8_LAS __attribute__((address_space(3)))
typedef unsigned short bf16_t;
typedef short bf16x8 __attribute__((ext_vector_type(8)));
typedef float f32x4 __attribute__((ext_vector_type(4)));
typedef unsigned u32x4 __attribute__((ext_vector_type(4)));
constexpr int BM = 256, BK = 64, HALF = 128, HTB = HALF * BK * 2  , STAGE_BYTES = 8 * HTB, NXCD = 8, WGM = 4;

__host__ __device__ __forceinline__ int lds_byte(int r, int c) { const int st = (r >> 4) * 2 + (c >> 5), rr = r & 15, cc = c & 31, ob = rr * 64 + cc * 2; return st * 1024 + (ob ^ (((ob >> 9) & 1) << 5)); }
__host__ __device__ __forceinline__ void stage_rc(int b, int& R, int& C) { const int st = b / 1024, sb = b % 1024, swz = sb ^ (((sb >> 9) & 1) << 5); R = (st >> 1) * 16 + swz / 64; C = (st & 1) * 32 + (swz % 64) / 2; }
__host__ __device__ __forceinline__ int perm32(int rho) { const int n = rho >> 4, i = rho & 15; return 8 * (i >> 2) + 4 * n + (i & 3); }

struct Unit { int pm, pn; };
struct Gemm { const bf16_t* A; const bf16_t* Bt; int M, N, K, lda, ldb; };

struct StaticOrder {
    int nM, nN, nwg, G, c;
    __host__ __device__ void init(int M, int N, int G_, int c_) { nM = M / BM; nN = N / BM; nwg = nM * nN; G = G_; c = c_; }
    __host__ __device__ bool next(int i, Unit& u) const {
        const long L = (long)i * G + c; if (L >= nwg) return false;
        int wgid = (int)L; { const int q = nwg / NXCD, r = nwg % NXCD, xcd = wgid % NXCD, off = wgid / NXCD; wgid = (xcd < r ? xcd * (q + 1) : r * (q + 1) + (xcd - r) * q) + off; }
        const int nig = WGM * nN, gid = wgid / nig, fm = gid * WGM, gsz = (nM - fm) < WGM ? (nM - fm) : WGM;
        u.pm = fm + ((wgid % nig) % gsz); u.pn = (wgid % nig) / gsz; return true;
    }
    __device__ __forceinline__ void a_ready(const Unit&) const {}
    __device__ __forceinline__ void done(const Unit&) const {}
};

typedef float f32x2_t __attribute__((ext_vector_type(2))); typedef __bf16 bf16x2_t __attribute__((ext_vector_type(2)));
__device__ __forceinline__ unsigned cvt_pk_bf16(float lo, float hi) { const f32x2_t v = {lo, hi}; const bf16x2_t b = __builtin_convertvector(v, bf16x2_t); return __builtin_bit_cast(unsigned, b); }
typedef unsigned u32x2 __attribute__((ext_vector_type(2)));
__device__ __forceinline__ float ex2(float x) { return __builtin_amdgcn_exp2f(x); }
__device__ __forceinline__ float sigm(float x) { return __builtin_amdgcn_rcpf(1.0f + ex2(x * -1.4426950408889634f)); }
__device__ __forceinline__ u32x4 pack8(const f32x4 a, const f32x4 b) { u32x4 w; w.x = cvt_pk_bf16(a[0], a[1]); w.y = cvt_pk_bf16(a[2], a[3]); w.z = cvt_pk_bf16(b[0], b[1]); w.w = cvt_pk_bf16(b[2], b[3]); return w; }
__device__ __forceinline__ f32x4 bf4_lo(const u32x4 w) { return (f32x4){__uint_as_float(w.x << 16), __uint_as_float(w.x & 0xffff0000u), __uint_as_float(w.y << 16), __uint_as_float(w.y & 0xffff0000u)}; }
__device__ __forceinline__ f32x4 bf4_hi(const u32x4 w) { return (f32x4){__uint_as_float(w.z << 16), __uint_as_float(w.z & 0xffff0000u), __uint_as_float(w.w << 16), __uint_as_float(w.w & 0xffff0000u)}; }

__device__ __forceinline__ u32x2 pack8_fp8(const f32x4 a, const f32x4 b) { u32x2 w; int t = __builtin_amdgcn_cvt_pk_fp8_f32(a[0], a[1], 0, false); t = __builtin_amdgcn_cvt_pk_fp8_f32(a[2], a[3], t, true); w.x = (unsigned)t;
    t = __builtin_amdgcn_cvt_pk_fp8_f32(b[0], b[1], 0, false); t = __builtin_amdgcn_cvt_pk_fp8_f32(b[2], b[3], t, true); w.y = (unsigned)t; return w; }
__device__ __forceinline__ f32x4 fp8x4(unsigned w) { typedef float f2_ __attribute__((ext_vector_type(2))); const f2_ lo = __builtin_amdgcn_cvt_pk_f32_fp8((int)w, false), hi = __builtin_amdgcn_cvt_pk_f32_fp8((int)w, true); return (f32x4){lo.x, lo.y, hi.x, hi.y}; }
struct EpiProj {
    static constexpr bool PERM = true, AFTER_DRAIN = false, MID = false;
    bf16_t *Q, *Kq, *V, *HQ, *HI, *HGG, *GS, *GH; float* LOGF; const float *gq, *gk, *lbt; float qscale, eps;
    __device__ __forceinline__ void operator()(const f32x4 (&acc)[2][2][4][2], const Unit& u, int wr, int wc, int fr, int fq) const {
        const int pn = u.pn, row0 = u.pm * BM + wr * 64 + fr;
        if (pn < 4) {
            const bool isq = pn < 2; const int head = 4 * (pn & 1) + wc;
            bf16_t* base = (isq ? Q : Kq) + head * 64 + 8 * fq; const float* g = (isq ? gq : gk) + 8 * fq; const float sc = isq ? qscale : 1.0f;
            f32x4 gv[2][2];
#pragma unroll
            for (int bj = 0; bj < 2; ++bj)
#pragma unroll
                for (int n = 0; n < 2; ++n) gv[bj][n] = *(const f32x4*)(g + 32 * bj + 4 * n) * sc;
#pragma unroll
            for (int ai = 0; ai < 2; ++ai)
#pragma unroll
                for (int m = 0; m < 4; ++m) {
                    float ss = 0.f;
#pragma unroll
                    for (int bj = 0; bj < 2; ++bj)
#pragma unroll
                        for (int n = 0; n < 2; ++n) { const f32x4 x = acc[ai][bj][m][n]; ss += (x[0] * x[0] + x[1] * x[1]) + (x[2] * x[2] + x[3] * x[3]); }
                    ss += __shfl_xor(ss, 16); ss += __shfl_xor(ss, 32);
                    const float rs = 1.0f / sqrtf(ss * (1.0f / 64.0f) + eps);
                    bf16_t* rowp = base + (size_t)(row0 + ai * HALF + m * 16) * 512;
#pragma unroll
                    for (int bj = 0; bj < 2; ++bj) *(u32x4*)(rowp + 32 * bj) = pack8(acc[ai][bj][m][0] * rs * gv[bj][0], acc[ai][bj][m][1] * rs * gv[bj][1]);
                }
        } else if (pn == 8 || pn == 9) {
            store_tile<0>(acc, (bf16_t*)LOGF, 512, row0, 256 * (pn - 8) + 32 * wc + 8 * fq);
        } else {
            const int cw = 32 * wc + 8 * fq;
            if (pn < 6) store_tile<0>(acc, V, 512, row0, 256 * (pn - 4) + cw);
            else if (pn < 8) store_tile<0>(acc, HQ, 512, row0, 256 * (pn - 6) + cw);
            else if (pn < 12) store_tile<0>(acc, HI, 512, row0, 256 * (pn - 10) + cw);
            else if (pn < 14) store_tile<0>(acc, HGG, 512, row0, 256 * (pn - 12) + cw);
            else if (pn < 18) store_tile8(acc, (unsigned char*)GS, row0, 256 * (pn - 14) + cw);
            else store_tile8(acc, (unsigned char*)GH, row0, 256 * (pn - 18) + cw);
        }
    }
    static __device__ __forceinline__ void store_tile8(const f32x4 (&acc)[2][2][4][2], unsigned char* ob, int row0, int cb) {
#pragma unroll
        for (int ai = 0; ai < 2; ++ai)
#pragma unroll
            for (int m = 0; m < 4; ++m) { unsigned char* rowp = ob + (size_t)(row0 + ai * HALF + m * 16) * 1024 + cb;
#pragma unroll
                for (int bj = 0; bj < 2; ++bj) *(u32x2*)(rowp + 128 * bj) = pack8_fp8(acc[ai][bj][m][0], acc[ai][bj][m][1]); }
    }
    template <int MODE  > static __device__ __forceinline__ void store_tile(const f32x4 (&acc)[2][2][4][2], bf16_t* ob, int ld, int row0, int cb) {
#pragma unroll
        for (int ai = 0; ai < 2; ++ai)
#pragma unroll
            for (int m = 0; m < 4; ++m) { bf16_t* rowp = ob + (size_t)(row0 + ai * HALF + m * 16) * ld + cb;
#pragma unroll
                for (int bj = 0; bj < 2; ++bj) { f32x4 v[2];
#pragma unroll
                    for (int n = 0; n < 2; ++n) { const f32x4 x = acc[ai][bj][m][n];
                        if (MODE == 0) v[n] = x;
                        else {
#pragma unroll
                            for (int j = 0; j < 4; ++j) { const float s = sigm(x[j]); v[n][j] = MODE == 1 ? x[j] * s : s; } } }
                    *(u32x4*)(rowp + 128 * bj) = pack8(v[0], v[1]); } }
    }
};
struct EpiGateK {
    static constexpr bool PERM = true, AFTER_DRAIN = false, MID = true;
    const unsigned char* gs; const unsigned char* gh; bf16_t* out;
    __device__ __forceinline__ void mid(f32x4 (&acc)[2][2][4][2], const Unit& u, int wr, int wc, int fr_, int fq_) const {
        int fr = fr_, fq = fq_; asm volatile("" : "+v"(fr), "+v"(fq));
        const int row0 = u.pm * BM + wr * 64 + fr, col0 = u.pn * BM + wc * 32 + 8 * fq;
#pragma unroll
        for (int ai = 0; ai < 2; ++ai) {
            u32x2 a[4][2], b[4][2];
#pragma unroll
            for (int m = 0; m < 4; ++m)
#pragma unroll
                for (int bj = 0; bj < 2; ++bj) { const size_t off = (size_t)(row0 + ai * HALF + m * 16) * 1024 + col0 + bj * HALF; a[m][bj] = *(const u32x2*)(gs + off); b[m][bj] = *(const u32x2*)(gh + off); }
            asm volatile("" ::: "memory");
#pragma unroll
            for (int m = 0; m < 4; ++m)
#pragma unroll
                for (int bj = 0; bj < 2; ++bj) {
                    const f32x4 es0 = fp8x4(a[m][bj].x) * -1.4426950408889634f, es1 = fp8x4(a[m][bj].y) * -1.4426950408889634f, eh0 = fp8x4(b[m][bj].x) * -1.4426950408889634f, eh1 = fp8x4(b[m][bj].y) * -1.4426950408889634f;
                    f32x4 n0, n1, d0, d1;
#pragma unroll
                    for (int j = 0; j < 4; ++j) { n0[j] = ex2(eh0[j]); n1[j] = ex2(eh1[j]); d0[j] = ex2(es0[j]); d1[j] = ex2(es1[j]); }
                    n0 = n0 + 1.0f; n1 = n1 + 1.0f; d0 = d0 + 1.0f; d1 = d1 + 1.0f;
#pragma unroll
                    for (int j = 0; j < 4; ++j) { d0[j] = __builtin_amdgcn_rcpf(d0[j]); d1[j] = __builtin_amdgcn_rcpf(d1[j]); }
                    acc[ai][bj][m][0] = acc[ai][bj][m][0] * (n0 * d0); acc[ai][bj][m][1] = acc[ai][bj][m][1] * (n1 * d1); }
            asm volatile("" ::: "memory");
        }
    }
    __device__ __forceinline__ void operator()(const f32x4 (&acc)[2][2][4][2], const Unit& u, int wr, int wc, int fr, int fq) const {
        const int row0 = u.pm * BM + wr * 64 + fr, col0 = u.pn * BM + wc * 32 + 8 * fq;
#pragma unroll
        for (int ai = 0; ai < 2; ++ai) {
            u32x2 b[4][2];
#pragma unroll
            for (int m = 0; m < 4; ++m)
#pragma unroll
                for (int bj = 0; bj < 2; ++bj) b[m][bj] = *(const u32x2*)(gh + (size_t)(row0 + ai * HALF + m * 16) * 1024 + col0 + bj * HALF);
            asm volatile("" ::: "memory");
#pragma unroll
            for (int m = 0; m < 4; ++m)
#pragma unroll
                for (int bj = 0; bj < 2; ++bj) { f32x4 g0 = fp8x4(b[m][bj].x), g1 = fp8x4(b[m][bj].y);
#pragma unroll
                    for (int j = 0; j < 4; ++j) { g0[j] = sigm(g0[j]); g1[j] = sigm(g1[j]); }
                    *(u32x4*)(out + (size_t)(row0 + ai * HALF + m * 16) * 1024 + col0 + bj * HALF) = pack8(acc[ai][bj][m][0] * g0, acc[ai][bj][m][1] * g1); }
            asm volatile("" ::: "memory");
        }
    }
};
struct EpiResHn {
    static constexpr bool PERM = false, AFTER_DRAIN = false, MID = false;
    const bf16_t* hn; float* out;
    __device__ __forceinline__ void operator()(const f32x4 (&acc)[2][2][4][2], const Unit& u, int wr, int wc, int fr, int fq) const {
        const int row0 = u.pm * BM + wr * 64 + fr, col0 = u.pn * BM + wc * 32 + 4 * fq;
#pragma unroll
        for (int ai = 0; ai < 2; ++ai) {
            u32x2 pre[4][2][2];
#pragma unroll
            for (int m = 0; m < 4; ++m) {
#pragma unroll
                for (int bj = 0; bj < 2; ++bj)
#pragma unroll
                    for (int n = 0; n < 2; ++n) pre[m][bj][n] = *(const u32x2*)(hn + (size_t)(row0 + ai * HALF + m * 16) * 1024 + col0 + bj * HALF + n * 16); }
            asm volatile("" ::: "memory");
#pragma unroll
            for (int m = 0; m < 4; ++m)
#pragma unroll
                for (int bj = 0; bj < 2; ++bj)
#pragma unroll
                    for (int n = 0; n < 2; ++n) { const u32x2 w = pre[m][bj][n];
                        const f32x4 h = (f32x4){__uint_as_float(w.x << 16), __uint_as_float(w.x & 0xffff0000u), __uint_as_float(w.y << 16), __uint_as_float(w.y & 0xffff0000u)};
                        *(f32x4*)(out + (size_t)(row0 + ai * HALF + m * 16) * 1024 + col0 + bj * HALF + n * 16) = h + acc[ai][bj][m][n]; }
            asm volatile("" ::: "memory");
        }
    }
};
struct EpiResSq {
    static constexpr bool PERM = false, AFTER_DRAIN = false, MID = false;
    const float* base; bf16_t* hb; float* rowss;
    __device__ __forceinline__ void operator()(const f32x4 (&acc)[2][2][4][2], const Unit& u, int wr, int wc, int fr, int fq) const {
        const int row0 = u.pm * BM + wr * 64 + fr, col0 = u.pn * BM + wc * 32 + 4 * fq;
#pragma unroll
        for (int ai = 0; ai < 2; ++ai) {
            f32x4 pre[4][2][2];
#pragma unroll
            for (int m = 0; m < 4; ++m)
#pragma unroll
                for (int bj = 0; bj < 2; ++bj)
#pragma unroll
                    for (int n = 0; n < 2; ++n) pre[m][bj][n] = *(const f32x4*)(base + (size_t)(row0 + ai * HALF + m * 16) * 1024 + col0 + bj * HALF + n * 16);
            asm volatile("" ::: "memory");
#pragma unroll
            for (int m = 0; m < 4; ++m) { float s = 0.f;
#pragma unroll
                for (int bj = 0; bj < 2; ++bj)
#pragma unroll
                    for (int n = 0; n < 2; ++n) { const f32x4 h = pre[m][bj][n] + acc[ai][bj][m][n]; s += (h[0] * h[0] + h[1] * h[1]) + (h[2] * h[2] + h[3] * h[3]);
                        u32x2 w; w.x = cvt_pk_bf16(h[0], h[1]); w.y = cvt_pk_bf16(h[2], h[3]); *(u32x2*)(hb + (size_t)(row0 + ai * HALF + m * 16) * 1024 + col0 + bj * HALF + n * 16) = w; }
                s += __shfl_xor(s, 16); s += __shfl_xor(s, 32);
                if (fq == 0) __hip_atomic_fetch_add(rowss + row0 + ai * HALF + m * 16, s, __ATOMIC_RELAXED, __HIP_MEMORY_SCOPE_AGENT); }
            asm volatile("" ::: "memory");
        }
    }
};
struct EpiSwiglu {
    static constexpr bool PERM = true, AFTER_DRAIN = false, MID = false;
    bf16_t* out; int ldc; const float* rowss; float eps;
    __device__ __forceinline__ void operator()(const f32x4 (&acc)[2][2][4][2], const Unit& u, int wr, int wc, int fr, int fq) const {
        const int row0 = u.pm * BM + wr * 64 + fr, col0 = u.pn * HALF + wc * 32 + 8 * fq;
        float rs[2][4];
#pragma unroll
        for (int ai = 0; ai < 2; ++ai)
#pragma unroll
            for (int m = 0; m < 4; ++m) rs[ai][m] = rowss[row0 + ai * HALF + m * 16];
#pragma unroll
        for (int ai = 0; ai < 2; ++ai)
#pragma unroll
            for (int m = 0; m < 4; ++m) { f32x4 v[2]; const float r = 1.0f / sqrtf(rs[ai][m] * (1.0f / 1024.0f) + eps), cr = -1.4426950408889634f * r, r2 = r * r;
#pragma unroll
                for (int n = 0; n < 2; ++n) {
                    const f32x4 g4 = acc[ai][0][m][n], u4 = acc[ai][1][m][n], t = g4 * cr;
                    f32x4 d; d[0] = ex2(t[0]); d[1] = ex2(t[1]); d[2] = ex2(t[2]); d[3] = ex2(t[3]); d = d + 1.0f;
                    f32x4 s; s[0] = __builtin_amdgcn_rcpf(d[0]); s[1] = __builtin_amdgcn_rcpf(d[1]); s[2] = __builtin_amdgcn_rcpf(d[2]); s[3] = __builtin_amdgcn_rcpf(d[3]);
                    v[n] = (g4 * u4) * (s * r2); }
                *(u32x4*)(out + (size_t)(row0 + ai * HALF + m * 16) * ldc + col0) = pack8(v[0], v[1]); }
    }
};
template <class Epi, class Sched, bool ALIGN_EPI = false, bool SP2 = false>
__device__ __forceinline__ void gemm_phase(PG8_LAS unsigned char* lds, const Gemm g, const Sched& S, const Epi& E) {
    const int tid = threadIdx.x, wid = __builtin_amdgcn_readfirstlane(tid >> 6), lane = tid & 63, wr = wid >> 2, wc = wid & 3, fr = lane & 15, fq = lane >> 4;
    const int K = g.K, nt = K / BK;
    unsigned voffA[2], voffB[2];
#pragma unroll
    for (int i = 0; i < 2; ++i) { int R, C; stage_rc(tid * 16 + i * 8192, R, C); const int Rb = Epi::PERM ? ((R & ~31) + perm32(R & 31)) : R;
        voffA[i] = (unsigned)(R * g.lda + C) * 2u; voffB[i] = (unsigned)(Rb * g.ldb + C) * 2u; }
    const size_t kstep = (size_t)(BK * 2);
    const size_t hstepA = (size_t)HALF * g.lda * 2, hstepB = (size_t)HALF * g.ldb * 2;
    const size_t tstepA = 2 * hstepA, tstepB = 2 * hstepB;
    const unsigned ldsw = (unsigned)wid * 1024u;
    const int aoff = lds_byte(wr * 64 + fr, fq * 8), boff = lds_byte(wc * 32 + fr, fq * 8);
#define PG8_SA(b, h) (((b) * 2 + (h)) * HTB)
#define PG8_SB(b, h) ((4 + (b) * 2 + (h)) * HTB)
#define PG8_STAGE(bufoff, gbase, voff) do { _Pragma("unroll") for (int _i = 0; _i < 2; ++_i) \
        __builtin_amdgcn_global_load_lds((const unsigned*)((const char*)(gbase) + (voff)[_i]), (PG8_LAS unsigned*)(lds + (bufoff) + ldsw + _i * 8192), 16, 0, 0); } while (0)
#define PG8_LDA(dst, b, h) do { _Pragma("unroll") for (int m = 0; m < 4; ++m) _Pragma("unroll") for (int k = 0; k < 2; ++k) dst[m][k] = *(const PG8_LAS bf16x8*)(lds + PG8_SA(b, h) + aoff + m * 2048 + k * 1024); } while (0)
#define PG8_LDB(dst, b, h) do { _Pragma("unroll") for (int n = 0; n < 2; ++n) _Pragma("unroll") for (int k = 0; k < 2; ++k) dst[n][k] = *(const PG8_LAS bf16x8*)(lds + PG8_SB(b, h) + boff + n * 2048 + k * 1024); } while (0)
#define PG8_MMA(ai, bj, At, Bt) do { __builtin_amdgcn_s_setprio(1); _Pragma("unroll") for (int m = 0; m < 4; ++m) _Pragma("unroll") for (int n = 0; n < 2; ++n) _Pragma("unroll") for (int k = 0; k < 2; ++k) \
        acc[ai][bj][m][n] = __builtin_amdgcn_mfma_f32_16x16x32_bf16(Bt[n][k], At[m][k], acc[ai][bj][m][n], 0, 0, 0); __builtin_amdgcn_s_setprio(0); } while (0)
#define PG8_WAIT_V(n) asm volatile("s_waitcnt vmcnt(" #n ")" ::: "memory")
#define PG8_WAIT_L(n) asm volatile("s_waitcnt lgkmcnt(" #n ")" ::: "memory")
#define PG8_BAR __builtin_amdgcn_s_barrier()
#define PG8_SCHED __builtin_amdgcn_sched_barrier(0)
    Unit cur, nxt; int ui = 0;
    if (!S.next(0, cur)) return;
    f32x4 acc[2][2][4][2];
#pragma unroll
    for (int a = 0; a < 2; ++a)
#pragma unroll
        for (int b = 0; b < 2; ++b)
#pragma unroll
            for (int m = 0; m < 4; ++m)
#pragma unroll
                for (int n = 0; n < 2; ++n) acc[a][b][m][n] = (f32x4){0.f, 0.f, 0.f, 0.f};
    bf16x8 At[4][2], B0[2][2], B1[2][2];
    const char* cA = (const char*)g.A + (size_t)cur.pm * tstepA; const char* cB = (const char*)g.Bt + (size_t)cur.pn * tstepB;
    S.a_ready(cur);
    if constexpr (SP2) {
        PG8_STAGE(PG8_SB(0, 0), cB, voffB); PG8_STAGE(PG8_SB(0, 1), cB + hstepB, voffB); PG8_STAGE(PG8_SA(0, 0), cA, voffA); PG8_STAGE(PG8_SA(0, 1), cA + hstepA, voffA);
        if (wr == 1) PG8_BAR;
        PG8_WAIT_V(2); PG8_BAR;
        PG8_STAGE(PG8_SB(1, 0), cB + kstep, voffB); PG8_STAGE(PG8_SA(1, 0), cA + kstep, voffA); PG8_STAGE(PG8_SB(1, 1), cB + hstepB + kstep, voffB);
        PG8_WAIT_V(6); PG8_BAR;
    } else {
        PG8_STAGE(PG8_SB(0, 0), cB, voffB); PG8_STAGE(PG8_SA(0, 0), cA, voffA); PG8_STAGE(PG8_SB(0, 1), cB + hstepB, voffB); PG8_STAGE(PG8_SA(0, 1), cA + hstepA, voffA);
        if (wr == 1) PG8_BAR;
        PG8_WAIT_V(4); PG8_BAR;
        PG8_STAGE(PG8_SB(1, 0), cB + kstep, voffB); PG8_STAGE(PG8_SA(1, 0), cA + kstep, voffA); PG8_STAGE(PG8_SB(1, 1), cB + hstepB + kstep, voffB);
        PG8_WAIT_V(6); PG8_BAR;
    }
    for (;;) {
        const bool has_next = S.next(ui + 1, nxt);
        const char* nA = has_next ? (const char*)g.A + (size_t)nxt.pm * tstepA : cA; const char* nB = has_next ? (const char*)g.Bt + (size_t)nxt.pn * tstepB : cB;
        for (int t = 0; t < nt; t += 2) {
            if constexpr (Epi::MID) { if (t == nt / 2) E.mid(acc, cur, wr, wc, fr, fq); }
            const bool last = (t == nt - 2);
            const char* a1 = cA + (size_t)(t + 1) * kstep;
            const char* a2 = last ? nA : cA + (size_t)(t + 2) * kstep; const char* b2 = last ? nB : cB + (size_t)(t + 2) * kstep;
            const char* a3 = a2 + kstep; const char* b3 = b2 + kstep;
            if (last && has_next) S.a_ready(nxt);
            if constexpr (SP2) {
            PG8_LDB(B0, 0, 0); PG8_LDB(B1, 0, 1); PG8_SCHED; PG8_LDA(At, 0, 0); PG8_STAGE(PG8_SA(1, 1), a1 + hstepA, voffA);
            PG8_WAIT_V(8); PG8_WAIT_L(0); PG8_BAR; PG8_MMA(0, 0, At, B0); PG8_MMA(0, 1, At, B1); PG8_BAR; PG8_SCHED;
            PG8_LDA(At, 0, 1); PG8_STAGE(PG8_SB(0, 0), b2, voffB); PG8_STAGE(PG8_SB(0, 1), b2 + hstepB, voffB); PG8_STAGE(PG8_SA(0, 0), a2, voffA);
            PG8_WAIT_V(8); PG8_WAIT_L(0); PG8_BAR; PG8_MMA(1, 0, At, B0); PG8_MMA(1, 1, At, B1); PG8_BAR; PG8_SCHED;
            PG8_LDB(B0, 1, 0); PG8_LDB(B1, 1, 1); PG8_SCHED; PG8_LDA(At, 1, 0); PG8_STAGE(PG8_SA(0, 1), a2 + hstepA, voffA);
            PG8_WAIT_V(8); PG8_WAIT_L(0); PG8_BAR; PG8_MMA(0, 0, At, B0); PG8_MMA(0, 1, At, B1); PG8_BAR; PG8_SCHED;
            PG8_LDA(At, 1, 1); PG8_STAGE(PG8_SB(1, 0), b3, voffB); PG8_STAGE(PG8_SB(1, 1), b3 + hstepB, voffB); PG8_STAGE(PG8_SA(1, 0), a3, voffA);
            PG8_WAIT_V(8); PG8_WAIT_L(0); PG8_BAR; PG8_MMA(1, 0, At, B0); PG8_MMA(1, 1, At, B1); PG8_BAR; PG8_SCHED;
            } else {
            PG8_LDB(B0, 0, 0); PG8_SCHED; PG8_LDA(At, 0, 0); PG8_STAGE(PG8_SA(1, 1), a1 + hstepA, voffA);
            PG8_WAIT_L(8); PG8_BAR; PG8_WAIT_L(0); PG8_MMA(0, 0, At, B0); PG8_BAR; PG8_SCHED;
            PG8_LDB(B1, 0, 1); PG8_STAGE(PG8_SB(0, 0), b2, voffB);
            PG8_BAR; PG8_WAIT_L(0); PG8_MMA(0, 1, At, B1); PG8_BAR;
            PG8_LDA(At, 0, 1); PG8_STAGE(PG8_SA(0, 0), a2, voffA);
            PG8_BAR; PG8_WAIT_L(0); PG8_MMA(1, 0, At, B0); PG8_BAR; PG8_SCHED;
            PG8_STAGE(PG8_SB(0, 1), b2 + hstepB, voffB);
            PG8_WAIT_V(6); PG8_BAR; PG8_MMA(1, 1, At, B1); PG8_BAR;
            PG8_LDB(B0, 1, 0); PG8_SCHED; PG8_LDA(At, 1, 0); PG8_STAGE(PG8_SA(0, 1), a2 + hstepA, voffA);
            PG8_WAIT_L(8); PG8_BAR; PG8_WAIT_L(0); PG8_MMA(0, 0, At, B0); PG8_BAR; PG8_SCHED;
            PG8_LDB(B1, 1, 1); PG8_STAGE(PG8_SB(1, 0), b3, voffB);
            PG8_BAR; PG8_WAIT_L(0); PG8_MMA(0, 1, At, B1); PG8_BAR;
            PG8_LDA(At, 1, 1); PG8_STAGE(PG8_SA(1, 0), a3, voffA);
            PG8_BAR; PG8_WAIT_L(0); PG8_MMA(1, 0, At, B0); PG8_BAR; PG8_SCHED;
            PG8_STAGE(PG8_SB(1, 1), b3 + hstepB, voffB);
            PG8_WAIT_V(6); PG8_BAR; PG8_MMA(1, 1, At, B1); PG8_BAR;
            }
        }
        if constexpr (ALIGN_EPI) { if (wr == 0) PG8_BAR; }
        if constexpr (!Epi::AFTER_DRAIN) { E(acc, cur, wr, wc, fr, fq); S.done(cur); }
        if (!has_next) break;
#pragma unroll
        for (int a = 0; a < 2; ++a)
#pragma unroll
            for (int b = 0; b < 2; ++b)
#pragma unroll
                for (int m = 0; m < 4; ++m)
#pragma unroll
                    for (int n = 0; n < 2; ++n) acc[a][b][m][n] = (f32x4){0.f, 0.f, 0.f, 0.f};
        cur = nxt; cA = nA; cB = nB; ++ui;
        if constexpr (ALIGN_EPI) { if (wr == 1) PG8_BAR; }
    }
    PG8_WAIT_V(0);
    if constexpr (!ALIGN_EPI) { if (wr == 0) PG8_BAR; }
    PG8_BAR;
    if constexpr (Epi::AFTER_DRAIN) { E.fused(acc, cur, wr, wc, fr, fq, lds, wid, lane); S.done(cur); }
#undef PG8_SA
#undef PG8_SB
#undef PG8_STAGE
#undef PG8_LDA
#undef PG8_LDB
#undef PG8_MMA
#undef PG8_WAIT_V
#undef PG8_WAIT_L
#undef PG8_BAR
#undef PG8_SCHED
}
}
constexpr int NWAVES = 8;
#ifndef MK_ONE_LAUNCH
#define MK_ONE_LAUNCH 1
#endif
constexpr int N_PHASES = 8;

constexpr int BATCH = 8, SEQ = 4096, D = 1024, M = BATCH * SEQ;
constexpr int SBH = 8, SBD = 64, SBW = 512, HGH = 4, HGD = 128, HGW = 512, NIN = 5632, FFN = 2816;
constexpr float EPS = 1e-6f;
constexpr float QSCALE = 0.125f * 1.4426950408889634f;

constexpr size_t MiB = 1u << 20;
constexpr size_t WS_CTL = 0, CTL_ZERO_BYTES = 1 * MiB;
constexpr size_t WS_WIN = 1 * MiB, WS_WBR = 12 * MiB, WS_WOUT = 14 * MiB, WS_WGU = 16 * MiB, WS_WDN = 27 * MiB;
constexpr size_t WS_XN = 33 * MiB;
constexpr size_t WS_Q = 97 * MiB, WS_K = 129 * MiB, WS_V = 161 * MiB, WS_HQ = 193 * MiB, WS_LOGF = 225 * MiB, WS_HI = 289 * MiB, WS_HGG = 321 * MiB, WS_GS = 353 * MiB, WS_GH = 417 * MiB;
constexpr size_t WS_MIXED = 97 * MiB, WS_STASH = 161 * MiB;
constexpr size_t WS_ACT = 225 * MiB;
constexpr size_t WS_END = 481 * MiB;
static_assert(WS_ACT + (size_t)M * FFN * 2 <= WS_GH + 64 * MiB && WS_WDN + (size_t)D * FFN * 2 <= WS_XN, "d_ws map");
constexpr int CW_TMO = 0, CW_CODE = 1, CW_BAR = 4096, CW_SEAM = 16384;

constexpr int RING_OFF = 0, RING_BYTES = 131072;
constexpr int LDSCTL_OFF = RING_BYTES, MISC_OFF = LDSCTL_OFF + 320;
constexpr int LDS_BYTES = 147456;
#define GAS __attribute__((address_space(1)))
#define LAS __attribute__((address_space(3)))
typedef unsigned short bf16;
typedef unsigned v4u __attribute__((ext_vector_type(4)));
typedef float f32x4 __attribute__((ext_vector_type(4)));
typedef short bf16x8 __attribute__((ext_vector_type(8)));
typedef GAS unsigned gu32;
typedef GAS unsigned long long gu64;
#define RLX_AGENT __ATOMIC_RELAXED, __HIP_MEMORY_SCOPE_AGENT
#define LDS_WAIT() asm volatile("s_waitcnt lgkmcnt(0)" ::: "memory")
#define VM_WAIT() asm volatile("s_waitcnt vmcnt(0)" ::: "memory")
__device__ __forceinline__ unsigned long long rt() { return __builtin_amdgcn_s_memrealtime(); }
__device__ __forceinline__ unsigned f2bf(float f) { unsigned u = __builtin_bit_cast(unsigned, f); return (u + 0x7fffu + ((u >> 16) & 1u)) >> 16; }
__device__ __forceinline__ unsigned pk2(float lo, float hi) { return f2bf(lo) | (f2bf(hi) << 16); }

#define XB_TMO      128
#define XB_XCNT(j)  (256  + 64 * (j))
#define XB_XSUB(j)  (1280 + 64 * (j))
#define XB_XGEN(j)  (2304 + 64 * (j))
#define XB_TOP      3328
#define XB_TOPGEN   3392
#define XCD_BAR_WORDS 3456
#define XB_SPIN_CAP (1u << 18)

__device__ __forceinline__ unsigned xb_ld(unsigned* p)              { return __hip_atomic_load(p, __ATOMIC_RELAXED, __HIP_MEMORY_SCOPE_AGENT); }
__device__ __forceinline__ unsigned xb_add(unsigned* p, unsigned v) { return __hip_atomic_fetch_add(p, v, __ATOMIC_RELAXED, __HIP_MEMORY_SCOPE_AGENT); }
__device__ __forceinline__ unsigned xb_xcc_id() { return (unsigned)__builtin_amdgcn_s_getreg((3 << 11) | 20) & 0xFu; }
#define XB_SPIN(cond, bar) do { unsigned _sp = 0; while (cond) { __builtin_amdgcn_s_sleep(1); \
    if ((++_sp & 255u) == 0u) { if (xb_ld(&(bar)[XB_TMO])) break; if (_sp > XB_SPIN_CAP) { atomicAdd(&(bar)[XB_TMO], 1u); break; } } } } while (0)

struct XcdBarrier {
    unsigned* bar; unsigned x;
    volatile LAS unsigned* st;
};

__device__ __forceinline__ XcdBarrier xcd_barrier_post(unsigned* bar, volatile LAS unsigned* st) {
    XcdBarrier b; b.bar = bar; b.x = xb_xcc_id(); b.st = st;
    if (threadIdx.x == 0) (void)xb_add(&bar[XB_XCNT(b.x)], 1u);
    return b;
}
__device__ __forceinline__ void xcd_barrier_complete(unsigned* bar, unsigned x, unsigned& nloc, unsigned& nx) {
    const unsigned G = gridDim.x * gridDim.y * gridDim.z;
    unsigned sum, cnt, mine, sp = 0u;
    for (;;) {
        sum = 0u; cnt = 0u; mine = 0u;
#pragma unroll
        for (unsigned j = 0; j < 16; ++j) { const unsigned c = xb_ld(&bar[XB_XCNT(j)]); sum += c; cnt += (c > 0u) ? 1u : 0u; mine = (j == x) ? c : mine; }
        if (sum == G) break;
        __builtin_amdgcn_s_sleep(1);
        if ((++sp & 255u) == 0u) { if (xb_ld(&bar[XB_TMO])) break; if (sp > XB_SPIN_CAP) { atomicAdd(&bar[XB_TMO], 1u); break; } }
    }
    nloc = mine > 0u ? mine : 1u; nx = cnt > 0u ? cnt : 1u;
}

__device__ __forceinline__ void xcd_barrier(const XcdBarrier& b) {
    asm volatile("s_waitcnt vmcnt(0)" ::: "memory");
    __syncthreads();
    if (threadIdx.x == 0) {
        unsigned* bar = b.bar;
        __builtin_amdgcn_s_waitcnt(0);
        unsigned nloc = b.st[0], nx = b.st[1];
        if (nloc == 0u) { xcd_barrier_complete(bar, b.x, nloc, nx); b.st[0] = nloc; b.st[1] = nx; }
        const unsigned old = xb_add(&bar[XB_XSUB(b.x)], 1u);
        const unsigned gen = old / nloc;
        if (old + 1u == (gen + 1u) * nloc) {
            __builtin_amdgcn_fence(__ATOMIC_RELEASE, "agent");
            asm volatile("s_waitcnt vmcnt(0)" ::: "memory");
            const unsigned og = xb_add(&bar[XB_TOP], 1u);
            const unsigned tg = og / nx;
            if (og + 1u == (tg + 1u) * nx) xb_add(&bar[XB_TOPGEN], 1u);
            else XB_SPIN(xb_ld(&bar[XB_TOPGEN]) == tg, bar);
            __builtin_amdgcn_fence(__ATOMIC_ACQUIRE, "agent");
            xb_add(&bar[XB_XGEN(b.x)], 1u);
            asm volatile("s_waitcnt vmcnt(0)" ::: "memory");
        } else {
            XB_SPIN(xb_ld(&bar[XB_XGEN(b.x)]) == gen, bar);
            __builtin_amdgcn_fence(__ATOMIC_ACQUIRE, "agent");
            asm volatile("s_waitcnt vmcnt(0)" ::: "memory");
        }
    }
    __syncthreads();
}
struct Frame {
    LAS unsigned char* lds; volatile LAS unsigned* MISC; gu32* ctl;
    int tid, lane, wave, vcu, G;
    const float *x, *n1g, *w_in, *gq, *gk, *lbt, *hgn, *w_br, *w_out, *n2g, *w_gate, *w_up, *w_dn; float* out;
    bf16 *WIN, *WBR, *WOUT, *WGU, *WDN, *XN, *Q, *K, *V, *HQ, *HI, *HGG, *GS, *GH, *MIXED, *STASH, *ACT; float* LOGF;
};
__device__ __forceinline__ float wave_sum(float v) {
#pragma unroll
    for (int o = 1; o < 64; o <<= 1) v += __shfl_xor(v, o);
    return v;
}
__device__ __forceinline__ float bf2f(unsigned short h) { return __uint_as_float((unsigned)h << 16); }
__device__ __forceinline__ void p0_transpose_item(const float* W, int Nsrc, int ns, bf16* WT, int ldd, int nd, int k0, LAS float* scr, int lane, const float* kscale = nullptr) {
    { float wv[32];
#pragma unroll
      for (int i = 0; i < 32; ++i) { const int kk = 2 * i + (lane >> 5); wv[i] = W[(size_t)(k0 + kk) * Nsrc + ns + (lane & 31)]; }
      if (kscale) {
#pragma unroll
          for (int i = 0; i < 32; ++i) wv[i] *= kscale[k0 + 2 * i + (lane >> 5)]; }
#pragma unroll
      for (int i = 0; i < 32; ++i) { const int kk = 2 * i + (lane >> 5); scr[kk * 33 + (lane & 31)] = wv[i]; } }
    LDS_WAIT(); asm volatile("" ::: "memory");
    const int c = lane & 7;
#pragma unroll
    for (int j = 0; j < 4; ++j) { const int n = (lane >> 3) + 8 * j; const LAS float* s = scr + (8 * c) * 33 + n;
        v4u o; o.x = pk2(s[0 * 33], s[1 * 33]); o.y = pk2(s[2 * 33], s[3 * 33]); o.z = pk2(s[4 * 33], s[5 * 33]); o.w = pk2(s[6 * 33], s[7 * 33]);
        *(GAS v4u*)(WT + (size_t)(nd + n) * ldd + k0 + 8 * c) = o; }
    LDS_WAIT(); asm volatile("" ::: "memory");
}
template <int PART> __device__ __forceinline__ void p0_prologue(Frame& F) {
    LAS float* scr = (LAS float*)(F.lds + RING_OFF + F.wave * 16384);
    const int gw = PART == 0 ? F.vcu * NWAVES + F.wave : (((int)blockIdx.x >> 4) * 8 + ((int)blockIdx.x & 7)) * NWAVES + F.wave, NGW = PART == 0 ? F.G * NWAVES : (F.G / 2) * NWAVES;
    constexpr int I_IN = 16 * 176, I_BR = 16 * 32, I_OUT = 16 * 32, I_G = 16 * 88, I_U = 16 * 88, I_DN = 44 * 32;
    constexpr int NITEMS = I_IN + I_BR + I_OUT + I_G + I_U + I_DN;
    for (int it = (PART == 0 ? gw : I_IN + gw); it < (PART == 0 ? I_IN : NITEMS); it += NGW) {
        int r = it;
        if (r < I_IN) { const int kb = r / 176, nb = r % 176; int sb = nb;
            if (nb < 32) { const int pn = nb >> 3, rem = nb & 7, bj = rem >> 2, wc = rem & 3; sb = 8 * pn + 2 * wc + bj; }
            p0_transpose_item(F.w_in, NIN, 32 * sb, F.WIN, D, 32 * nb, 64 * kb, scr, F.lane); continue; } r -= I_IN;
        if (r < I_BR) { p0_transpose_item(F.w_br, D, 32 * (r % 32), F.WBR, D, 32 * (r % 32), 64 * (r / 32), scr, F.lane); continue; } r -= I_BR;
        if (r < I_OUT) { p0_transpose_item(F.w_out, D, 32 * (r % 32), F.WOUT, D, 32 * (r % 32), 64 * (r / 32), scr, F.lane); continue; } r -= I_OUT;
        if (r < I_G + I_U) { const bool up = r >= I_G; if (up) r -= I_G; const int kb = r / 88, sb = r % 88;
            p0_transpose_item(up ? F.w_up : F.w_gate, FFN, 32 * sb, F.WGU, D, 256 * (sb >> 2) + (up ? 128 : 0) + 32 * (sb & 3), 64 * kb, scr, F.lane, F.n2g); continue; } r -= I_G + I_U;
        p0_transpose_item(F.w_dn, D, 32 * (r % 32), F.WDN, FFN, 32 * (r % 32), 64 * (r / 32), scr, F.lane);
    }
    if (PART == 0) {
        const GAS f32x4* gr = (const GAS f32x4*)F.n1g + F.lane; f32x4 gv[4];
#pragma unroll
        for (int j = 0; j < 4; ++j) gv[j] = gr[64 * j];
        for (int m0 = gw * 8; m0 < M; m0 += NGW * 8) {
            f32x4 v[8][4];
#pragma unroll
            for (int r = 0; r < 8; ++r)
#pragma unroll
                for (int j = 0; j < 4; ++j) v[r][j] = ((const GAS f32x4*)(F.x + (size_t)(m0 + r) * D) + F.lane)[64 * j];
#pragma unroll
            for (int r = 0; r < 8; ++r) { float s = 0.f;
#pragma unroll
                for (int j = 0; j < 4; ++j) s += (v[r][j].x * v[r][j].x + v[r][j].y * v[r][j].y) + (v[r][j].z * v[r][j].z + v[r][j].w * v[r][j].w);
                const float rs = 1.0f / sqrtf(wave_sum(s) * (1.0f / 1024.0f) + EPS);
                GAS unsigned long long* o8 = (GAS unsigned long long*)(F.XN + (size_t)(m0 + r) * D) + F.lane;
#pragma unroll
                for (int j = 0; j < 4; ++j) o8[64 * j] = (unsigned long long)pk2(v[r][j].x * rs * gv[j].x, v[r][j].y * rs * gv[j].y) | ((unsigned long long)pk2(v[r][j].z * rs * gv[j].z, v[r][j].w * rs * gv[j].w) << 32); }
        }
    }
}

namespace sba {
typedef short bf16x8 __attribute__((ext_vector_type(8)));
typedef short s16x4 __attribute__((ext_vector_type(4)));
typedef float f32x16 __attribute__((ext_vector_type(16)));
typedef unsigned u32x4 __attribute__((ext_vector_type(4)));
typedef unsigned u32x2 __attribute__((ext_vector_type(2)));
#define SBA_MFMA(a, b, c) __builtin_amdgcn_mfma_f32_32x32x16_bf16((a), (b), (c), 0, 0, 0)
__device__ __forceinline__ int crow(int r, int hi) { return (r & 3) + 8 * (r >> 2) + 4 * hi; }
__device__ __forceinline__ bf16x8 pack_step(const f32x16& x, int s) {
    u32x4 p; p.x = pg8::cvt_pk_bf16(x[8 * s], x[8 * s + 1]); p.y = pg8::cvt_pk_bf16(x[8 * s + 2], x[8 * s + 3]); p.z = pg8::cvt_pk_bf16(x[8 * s + 4], x[8 * s + 5]); p.w = pg8::cvt_pk_bf16(x[8 * s + 6], x[8 * s + 7]);
    return __builtin_bit_cast(bf16x8, p); }
typedef short v4i16_t __attribute__((ext_vector_type(4)));
__device__ __forceinline__ s16x4 vtr(LAS const unsigned char* p) { return __builtin_bit_cast(s16x4, __builtin_amdgcn_ds_read_tr16_b64_v4i16((LAS v4i16_t*)p)); }

__device__ __forceinline__ void attn_phase(Frame& F) {
    const int lane = F.lane, r32 = lane & 31, hi = lane >> 5;
    LAS unsigned char* vst = F.lds + F.wave * 4096;
    LAS const unsigned char* vp0 = vst + ((lane >> 4) & 1) * 32 + (lane & 3) * 8 + (4 * hi + ((lane & 15) >> 2)) * 64;
    float gm = fabsf(F.gq[lane]), km = fabsf(F.gk[lane]);
#pragma unroll
    for (int o = 1; o < 64; o <<= 1) { gm = fmaxf(gm, __shfl_xor(gm, o)); km = fmaxf(km, __shfl_xor(km, o)); }
    const float THR = 152.0f + 1.02f * (QSCALE * 64.0f) * gm * km;
    bf16x8 tf0, tf1;
#pragma unroll
    for (int j = 0; j < 8; ++j) { const int k0 = 8 * (j >> 2) + 4 * hi + (j & 3); tf0[j] = (k0 >= r32) ? (short)0x3F80 : (short)0; tf1[j] = (16 + k0 >= r32) ? (short)0x3F80 : (short)0; }
    const int gw = F.vcu * NWAVES + F.wave, NGW = F.G * NWAVES;
    for (int u = gw; u < BATCH * SBH * (SEQ / 32); u += NGW) {
        const int bh = u >> 7, qblk = u & 127, b = bh >> 3, h = bh & 7, t0 = qblk * 32;
        const size_t rowb = (size_t)b * SEQ;
        bf16x8 qf[4];
        { const bf16* qp = F.Q + (rowb + t0 + r32) * SBW + h * 64 + 8 * hi;
#pragma unroll
          for (int d0 = 0; d0 < 4; ++d0) qf[d0] = *(const GAS bf16x8*)(qp + 16 * d0); }
        const bf16* kbase = F.K + rowb * SBW + h * 64 + 8 * hi; const bf16* vbase = F.V + rowb * SBW + h * 64 + (lane & 7) * 8;
        f32x16 o0, o1;
#pragma unroll
        for (int r = 0; r < 16; ++r) { o0[r] = 0.f; o1[r] = 0.f; }
        float Rc = 0.f;
        int ht = qblk; bool diag = true;
        bf16x8 kn[4]; u32x4 vn[4];
#define SBA_LOAD(HT) do { _Pragma("unroll") for (int d0 = 0; d0 < 4; ++d0) kn[d0] = *(const GAS bf16x8*)(kbase + (size_t)(32 * (HT) + r32) * SBW + 16 * d0); \
        _Pragma("unroll") for (int i = 0; i < 4; ++i) vn[i] = *(const GAS u32x4*)(vbase + (size_t)(32 * (HT) + 8 * i + (lane >> 3)) * SBW); } while (0)
        SBA_LOAD(ht);
        for (;;) {
#pragma unroll
            for (int i = 0; i < 4; ++i) { const int key = 8 * i + (lane >> 3), ch = lane & 7; *(LAS u32x4*)(vst + (ch >> 2) * 2048 + (key >> 4) * 1024 + (key & 15) * 64 + (ch & 3) * 16) = vn[i]; }
            bf16x8 kc[4];
#pragma unroll
            for (int d0 = 0; d0 < 4; ++d0) kc[d0] = kn[d0];
            if (ht > 0) SBA_LOAD(ht - 1);
            f32x16 z;
#pragma unroll
            for (int r = 0; r < 16; ++r) z[r] = 0.f;
#pragma unroll
            for (int d0 = 0; d0 < 4; ++d0) z = SBA_MFMA(kc[d0], qf[d0], z);
            f32x16 s;
#pragma unroll
            for (int r = 0; r < 16; ++r) { s[r] = __builtin_amdgcn_logf(1.0f + __builtin_amdgcn_exp2f(z[r])); if (diag) { if (crow(r, hi) >= r32) s[r] = 0.f; } }
            const bf16x8 x0 = pack_step(s, 0), x1 = pack_step(s, 1);
            f32x16 c;
#pragma unroll
            for (int r = 0; r < 16; ++r) c[r] = Rc;
            c = SBA_MFMA(tf0, x0, c); c = SBA_MFMA(tf1, x1, c);
#pragma unroll
            for (int r = 0; r < 16; ++r) { z[r] = __builtin_amdgcn_exp2f(z[r] - c[r]); if (diag) { if (crow(r, hi) >= r32) z[r] = 0.f; } }
            const bf16x8 w0 = pack_step(z, 0), w1 = pack_step(z, 1);
            { const s16x4 l00 = vtr(vp0), h00 = vtr(vp0 + 512), l01 = vtr(vp0 + 1024), h01 = vtr(vp0 + 1536), l10 = vtr(vp0 + 2048), h10 = vtr(vp0 + 2560), l11 = vtr(vp0 + 3072), h11 = vtr(vp0 + 3584);
#define SBA_VF(l, h) (bf16x8){l[0], l[1], l[2], l[3], h[0], h[1], h[2], h[3]}
              o0 = SBA_MFMA(SBA_VF(l00, h00), w0, o0); o0 = SBA_MFMA(SBA_VF(l01, h01), w1, o0);
              o1 = SBA_MFMA(SBA_VF(l10, h10), w0, o1); o1 = SBA_MFMA(SBA_VF(l11, h11), w1, o1);
#undef SBA_VF
            }
            Rc = __shfl(c[0], r32);
            if (ht == 0) break;
            if (__all(Rc >= THR)) break;
            --ht; diag = false;
        }
#undef SBA_LOAD
        bf16* op = F.XN + (rowb + t0 + r32) * D + h * 64 + 4 * hi;
#pragma unroll
        for (int g = 0; g < 4; ++g) {
            u32x2 a, c; a.x = pg8::cvt_pk_bf16(o0[4 * g], o0[4 * g + 1]); a.y = pg8::cvt_pk_bf16(o0[4 * g + 2], o0[4 * g + 3]); c.x = pg8::cvt_pk_bf16(o1[4 * g], o1[4 * g + 1]); c.y = pg8::cvt_pk_bf16(o1[4 * g + 2], o1[4 * g + 3]);
            *(GAS u32x2*)(op + 8 * g) = a; *(GAS u32x2*)(op + 32 + 8 * g) = c; }
    }
}
#undef SBA_MFMA
}

namespace hg {
typedef short bf16x8 __attribute__((ext_vector_type(8)));
typedef short s16x4 __attribute__((ext_vector_type(4)));
typedef float f32x16 __attribute__((ext_vector_type(16)));
typedef unsigned u32x4 __attribute__((ext_vector_type(4)));
typedef unsigned u32x2 __attribute__((ext_vector_type(2)));
#define HG_MFMA(a, b, c) __builtin_amdgcn_mfma_f32_32x32x16_bf16((a), (b), (c), 0, 0, 0)
constexpr float LOG2E = 1.4426950408889634f;
__device__ __forceinline__ int imgoff(int row, int ch) { return 256 * row + 16 * (ch ^ (((row & 3) << 2) | ((row >> 2) & 3))); }
__device__ __forceinline__ int crow(int r, int hi) { return (r & 3) + 8 * (r >> 2) + 4 * hi; }
__device__ __forceinline__ s16x4 vtr(LAS const unsigned char* p) { return __builtin_bit_cast(s16x4, __builtin_amdgcn_ds_read_tr16_b64_v4i16((LAS sba::v4i16_t*)p)); }
__device__ __forceinline__ bf16x8 cat8(s16x4 lo, s16x4 hh) { return (bf16x8){lo[0], lo[1], lo[2], lo[3], hh[0], hh[1], hh[2], hh[3]}; }
__device__ __forceinline__ bf16x8 trfrag(LAS const unsigned char* img, int r0, int r1, int c, int lane) {
    const int blk = (lane >> 4) & 1, q = (lane & 15) >> 2, p = lane & 3, ch = 4 * c + 2 * blk + (p >> 1), by = 8 * (p & 1);
    return cat8(vtr(img + imgoff(r0 + q, ch) + by), vtr(img + imgoff(r1 + q, ch) + by));
}
__device__ __forceinline__ bf16x8 rowfrag(LAS const unsigned char* img, int row, int ch) { return *(const LAS bf16x8*)(img + imgoff(row, ch)); }
__device__ __forceinline__ u32x2 pack4(float a, float b, float c, float d) { u32x2 w; w.x = pg8::cvt_pk_bf16(a, b); w.y = pg8::cvt_pk_bf16(c, d); return w; }
__device__ __forceinline__ f32x4 unpack4(u32x2 w) { return (f32x4){__uint_as_float(w.x << 16), __uint_as_float(w.x & 0xffff0000u), __uint_as_float(w.y << 16), __uint_as_float(w.y & 0xffff0000u)}; }
__device__ __forceinline__ bf16x8 pack_step(const f32x16& x, int s) { return sba::pack_step(x, s); }
__device__ __forceinline__ f32x4 vexp2(const f32x4 x) { return (f32x4){__builtin_amdgcn_exp2f(x[0]), __builtin_amdgcn_exp2f(x[1]), __builtin_amdgcn_exp2f(x[2]), __builtin_amdgcn_exp2f(x[3])}; }
__device__ __forceinline__ f32x4 vrcp(const f32x4 x) { return (f32x4){__builtin_amdgcn_rcpf(x[0]), __builtin_amdgcn_rcpf(x[1]), __builtin_amdgcn_rcpf(x[2]), __builtin_amdgcn_rcpf(x[3])}; }
__device__ __forceinline__ f32x4 vlog2(const f32x4 x) { return (f32x4){__builtin_amdgcn_logf(x[0]), __builtin_amdgcn_logf(x[1]), __builtin_amdgcn_logf(x[2]), __builtin_amdgcn_logf(x[3])}; }
__device__ __forceinline__ f32x4 vsigm(const f32x4 x) { return vrcp(vexp2(x * -1.4426950408889634f) + 1.0f); }


constexpr int NUNIT = BATCH * HGH * (SEQ / 64);
__device__ __forceinline__ f32x4 scan16(f32x4 v, int lane) {
#pragma unroll
    for (int d = 4; d < 64; d <<= 1) { f32x4 t;
#pragma unroll
        for (int j = 0; j < 4; ++j) t[j] = __shfl_up(v[j], d);
        if (lane >= d) v += t; }
    return v; }
__device__ __forceinline__ f32x4 bcast4(const f32x4 v, int src) { return (f32x4){__shfl(v[0], src), __shfl(v[1], src), __shfl(v[2], src), __shfl(v[3], src)}; }

__device__ __forceinline__ f32x4 gl_of(const f32x4 x, const f32x4 lb, f32x4& km) {
    const f32x4 f = lb + (1.0f - lb) * vsigm(x); km = 1.0f - f; return vlog2(f); }
constexpr int NSEG = BATCH * HGH * 8;
__device__ __forceinline__ void pass1(Frame& F, bf16* L, float* Dl) {
    const int tid = F.tid, lane = F.lane, kq = 4 * F.wave + (lane & 3), tq = lane >> 2, r32 = lane & 31, hi = lane >> 5;
    LAS unsigned char* imgK = F.lds; LAS unsigned char* imgV = F.lds + 16384; LAS float* SEG = (LAS float*)(F.lds + 32768); LAS float* DLS = (LAS float*)(F.lds + 40960);
    const int vb = F.wave & 3, kp = F.wave >> 2;
    u32x2 gx[4]; u32x4 vv[2];
#define HG_P1_LOAD(UNIT) do { const int bh_ = (UNIT) >> 6, c_ = (UNIT) & 63, b_ = bh_ >> 2, h_ = bh_ & 3; const size_t r0_ = (size_t)b_ * SEQ + c_ * 64; \
        _Pragma("unroll") for (int i = 0; i < 4; ++i) gx[i] = *(const GAS u32x2*)((const bf16*)F.LOGF + (r0_ + 4 * tq + i) * HGW + h_ * 128 + 4 * kq); \
        _Pragma("unroll") for (int j = 0; j < 2; ++j) { const int id = tid + 512 * j; vv[j] = *(const GAS u32x4*)(F.HI + (r0_ + (id >> 4)) * HGW + h_ * 128 + 8 * (id & 15)); } } while (0)
    for (int seg = F.vcu; seg < NSEG; seg += F.G) {
        const int h = (seg >> 3) & 3, unit0 = seg * 8;
        f32x4 lb; { const f32x4 t0 = *(const GAS f32x4*)(F.lbt + h * 128 + 4 * kq), t1 = *(const GAS f32x4*)(F.lbt + 512 + h * 128 + 4 * kq);
#pragma unroll
            for (int j = 0; j < 4; ++j) lb[j] = pg8::sigm(t0[j] - t1[j]); }
        f32x16 acc0, acc1; f32x4 dsum = (f32x4){0.f, 0.f, 0.f, 0.f};
#pragma unroll
        for (int r = 0; r < 16; ++r) { acc0[r] = 0.f; acc1[r] = 0.f; }
        HG_P1_LOAD(unit0);
        for (int cc = 0; cc < 8; ++cc) {
            f32x4 g[4], km[4];
#pragma unroll
            for (int i = 0; i < 4; ++i) g[i] = gl_of(unpack4(gx[i]), lb, km[i]);
#pragma unroll
            for (int j = 0; j < 2; ++j) { const int id = tid + 512 * j, row = id >> 4, ch = id & 15; *(LAS u32x4*)(imgV + imgoff(row, ch)) = vv[j]; }
            asm volatile("" : "+v"(g[0]), "+v"(g[1]), "+v"(g[2]), "+v"(g[3]), "+v"(km[0]), "+v"(km[1]), "+v"(km[2]), "+v"(km[3]) :: "memory");
            __builtin_amdgcn_sched_barrier(0); { const int nu = cc < 7 ? unit0 + cc + 1 : unit0 + cc; HG_P1_LOAD(nu); } __builtin_amdgcn_sched_barrier(0);
            f32x4 rs[4]; rs[3] = (f32x4){0.f, 0.f, 0.f, 0.f}; rs[2] = g[3]; rs[1] = g[3] + g[2]; rs[0] = rs[1] + g[1];
            const f32x4 tot = rs[0] + g[0];
            const f32x4 incl = scan16(tot, lane), all = bcast4(incl, 60 + (lane & 3)), suf = all - incl;
#pragma unroll
            for (int i = 0; i < 4; ++i) { const f32x4 kh = km[i] * vexp2(suf + rs[i]);
                *(LAS u32x2*)(imgK + imgoff(4 * tq + i, kq >> 1) + 8 * (kq & 1)) = pack4(kh[0], kh[1], kh[2], kh[3]); }
            if (tq == 0) { *(LAS f32x4*)(DLS + 4 * kq) = all; dsum += all; }
            asm volatile("s_waitcnt lgkmcnt(0)" ::: "memory"); __builtin_amdgcn_s_barrier(); asm volatile("" ::: "memory");
            { const float d0 = __builtin_amdgcn_exp2f(DLS[64 * kp + r32]), d1 = __builtin_amdgcn_exp2f(DLS[64 * kp + 32 + r32]);
#pragma unroll
              for (int r = 0; r < 16; ++r) { acc0[r] *= d0; acc1[r] *= d1; } }
#pragma unroll
            for (int ks = 0; ks < 4; ++ks) {
                const bf16x8 af = trfrag(imgV, 16 * ks + 8 * hi, 16 * ks + 8 * hi + 4, vb, lane);
                acc0 = HG_MFMA(af, trfrag(imgK, 16 * ks + 8 * hi, 16 * ks + 8 * hi + 4, 2 * kp, lane), acc0);
                acc1 = HG_MFMA(af, trfrag(imgK, 16 * ks + 8 * hi, 16 * ks + 8 * hi + 4, 2 * kp + 1, lane), acc1);
            }
            asm volatile("s_waitcnt lgkmcnt(0)" ::: "memory"); __builtin_amdgcn_s_barrier(); asm volatile("" ::: "memory");
        }
        bf16* lp = L + (size_t)seg * 16384 + 32 * vb + 4 * hi;
#pragma unroll
        for (int gq = 0; gq < 4; ++gq) {
            *(GAS u32x2*)(lp + (size_t)(64 * kp + r32) * 128 + 8 * gq) = pack4(acc0[4 * gq], acc0[4 * gq + 1], acc0[4 * gq + 2], acc0[4 * gq + 3]);
            *(GAS u32x2*)(lp + (size_t)(64 * kp + 32 + r32) * 128 + 8 * gq) = pack4(acc1[4 * gq], acc1[4 * gq + 1], acc1[4 * gq + 2], acc1[4 * gq + 3]); }
        if (tq == 0) *(GAS f32x4*)(Dl + (size_t)seg * 128 + 4 * kq) = dsum;
    }
#undef HG_P1_LOAD
}
__device__ __forceinline__ void pass3(Frame& F, const bf16* Lseg, const float* Dseg) {
    const int tid = F.tid, lane = F.lane, kq = 4 * F.wave + (lane & 3), tq = lane >> 2, r32 = lane & 31, hi = lane >> 5;
    LAS unsigned char* imgQT = F.lds; LAS unsigned char* imgKT = F.lds + 16384; LAS unsigned char* imgQH = F.lds + 32768; LAS unsigned char* imgV = F.lds + 49152; LAS unsigned char* imgS = F.lds + 65536;
    LAS unsigned char* imgKH = F.lds + 98304; LAS float* SEG = (LAS float*)(F.lds + 114688); LAS float* RSS = (LAS float*)(F.lds + 122880); LAS float* DLS = (LAS float*)(F.lds + 123904);
    const int tb = F.wave >> 2, vb = F.wave & 3, kp = F.wave >> 2;
    u32x2 gx[4]; u32x2 qw[4]; u32x4 vv[2];
#define HG_P3_LOAD(UNIT) do { const int bh_ = (UNIT) >> 6, c_ = (UNIT) & 63, b_ = bh_ >> 2, h_ = bh_ & 3; const size_t r0_ = (size_t)b_ * SEQ + c_ * 64; \
        _Pragma("unroll") for (int i = 0; i < 4; ++i) { gx[i] = *(const GAS u32x2*)((const bf16*)F.LOGF + (r0_ + 4 * tq + i) * HGW + h_ * 128 + 4 * kq); qw[i] = *(const GAS u32x2*)(F.HQ + (r0_ + 4 * tq + i) * HGW + h_ * 128 + 4 * kq); } \
        _Pragma("unroll") for (int j = 0; j < 2; ++j) { const int id = tid + 512 * j; vv[j] = *(const GAS u32x4*)(F.HI + (r0_ + (id >> 4)) * HGW + h_ * 128 + 8 * (id & 15)); } } while (0)
    for (int seg = F.vcu; seg < NSEG; seg += F.G) {
        const int bh = seg >> 3, sj = seg & 7, b = bh >> 2, h = bh & 3, unit0 = seg * 8;
        HG_P3_LOAD(unit0);
        f32x4 lb; { const f32x4 t0 = *(const GAS f32x4*)(F.lbt + h * 128 + 4 * kq), t1 = *(const GAS f32x4*)(F.lbt + 512 + h * 128 + 4 * kq);
#pragma unroll
            for (int j = 0; j < 4; ++j) lb[j] = pg8::sigm(t0[j] - t1[j]); }
        f32x16 acc0, acc1;
#pragma unroll
        for (int r = 0; r < 16; ++r) { acc0[r] = 0.f; acc1[r] = 0.f; }
        if (sj > 0) {
            float d0v[7], d1v[7]; u32x2 l0v[7][4], l1v[7][4];
#pragma unroll
            for (int i = 0; i < 7; ++i) { const int sg = bh * 8 + (i < sj ? i : sj - 1);
                d0v[i] = Dseg[(size_t)sg * 128 + 64 * kp + r32]; d1v[i] = Dseg[(size_t)sg * 128 + 64 * kp + 32 + r32];
                const bf16* lp = Lseg + (size_t)sg * 16384 + 32 * vb + 4 * hi;
#pragma unroll
                for (int gq = 0; gq < 4; ++gq) { l0v[i][gq] = *(const GAS u32x2*)(lp + (size_t)(64 * kp + r32) * 128 + 8 * gq); l1v[i][gq] = *(const GAS u32x2*)(lp + (size_t)(64 * kp + 32 + r32) * 128 + 8 * gq); } }
#pragma unroll
            for (int i = 0; i < 7; ++i) { const bool on = i < sj; const float d0 = on ? __builtin_amdgcn_exp2f(d0v[i]) : 1.0f, d1 = on ? __builtin_amdgcn_exp2f(d1v[i]) : 1.0f;
#pragma unroll
                for (int gq = 0; gq < 4; ++gq) { const f32x4 l0 = unpack4(l0v[i][gq]), l1 = unpack4(l1v[i][gq]);
#pragma unroll
                    for (int j = 0; j < 4; ++j) { acc0[4 * gq + j] = acc0[4 * gq + j] * d0 + (on ? l0[j] : 0.f); acc1[4 * gq + j] = acc1[4 * gq + j] * d1 + (on ? l1[j] : 0.f); } } }
        }
        for (int cc = 0; cc < 8; ++cc) {
            int lane_o = F.lane; asm volatile("" : "+v"(lane_o));
            const int lane = lane_o, r32 = lane & 31, hi = lane >> 5;
            const int c = sj * 8 + cc; const size_t row0 = (size_t)b * SEQ + c * 64;
            const size_t orow = row0 + 32 * tb + r32;
            u32x2 gtw[4]; f32x4 gnv[4];
#pragma unroll
            for (int gq = 0; gq < 4; ++gq) { gtw[gq] = *(const GAS u32x2*)(F.HGG + orow * HGW + h * 128 + 32 * vb + 8 * gq + 4 * hi); gnv[gq] = *(const GAS f32x4*)(F.hgn + 32 * vb + 8 * gq + 4 * hi); }
            f32x4 g[4], km[4]; f32x4 qv[4];
#pragma unroll
            for (int i = 0; i < 4; ++i) { g[i] = gl_of(unpack4(gx[i]), lb, km[i]); const f32x4 qr = unpack4(qw[i]); qv[i] = qr * vsigm(qr); }
#pragma unroll
            for (int j = 0; j < 2; ++j) { const int id = tid + 512 * j, row = id >> 4, ch = id & 15; *(LAS u32x4*)(imgV + imgoff(row, ch)) = vv[j]; }
#pragma unroll
            for (int gq = 0; gq < 4; ++gq) {
                *(LAS u32x2*)(imgS + imgoff(64 * kp + r32, 4 * vb + gq) + 8 * hi) = pack4(acc0[4 * gq], acc0[4 * gq + 1], acc0[4 * gq + 2], acc0[4 * gq + 3]);
                *(LAS u32x2*)(imgS + imgoff(64 * kp + 32 + r32, 4 * vb + gq) + 8 * hi) = pack4(acc1[4 * gq], acc1[4 * gq + 1], acc1[4 * gq + 2], acc1[4 * gq + 3]); }
            asm volatile("" : "+v"(g[0]), "+v"(g[1]), "+v"(g[2]), "+v"(g[3]), "+v"(qv[0]), "+v"(qv[1]), "+v"(qv[2]), "+v"(qv[3]), "+v"(km[0]), "+v"(km[1]), "+v"(km[2]), "+v"(km[3]) :: "memory");
            __builtin_amdgcn_sched_barrier(0); { const int nu = cc < 7 ? unit0 + cc + 1 : unit0 + cc; HG_P3_LOAD(nu); } __builtin_amdgcn_sched_barrier(0);
            const f32x4 tot = (g[0] + g[1]) + (g[2] + g[3]), incl = scan16(tot, lane), all = bcast4(incl, 60 + (lane & 3)), ref = bcast4(incl, 28 + (lane & 3));
            f32x4 pre = incl - tot;
            f32x4 c1, c2;
            c1 = vexp2(ref); c2 = vexp2(all - ref);
#pragma unroll
            for (int i = 0; i < 4; ++i) { pre += g[i];
                const f32x4 dq = pre - ref, qt = qv[i] * vexp2(dq), kt = km[i] * vexp2(-dq), qh = qt * c1, kh = kt * c2;
                const int o = imgoff(4 * tq + i, kq >> 1) + 8 * (kq & 1);
                *(LAS u32x2*)(imgQT + o) = pack4(qt[0], qt[1], qt[2], qt[3]); *(LAS u32x2*)(imgKT + o) = pack4(kt[0], kt[1], kt[2], kt[3]); *(LAS u32x2*)(imgQH + o) = pack4(qh[0], qh[1], qh[2], qh[3]);
                *(LAS u32x2*)(imgKH + o) = pack4(kh[0], kh[1], kh[2], kh[3]); }
            if (tq == 0) *(LAS f32x4*)(DLS + 4 * kq) = all;
            asm volatile("s_waitcnt lgkmcnt(0)" ::: "memory"); __builtin_amdgcn_s_barrier(); asm volatile("" ::: "memory");
            f32x16 o;
#pragma unroll
            for (int r = 0; r < 16; ++r) o[r] = 0.f;
#pragma unroll
            for (int k4 = 0; k4 < 8; k4 += 4) { bf16x8 sa[4], qb[4];
#pragma unroll
              for (int ks = 0; ks < 4; ++ks) { sa[ks] = trfrag(imgS, 16 * (k4 + ks) + 8 * hi, 16 * (k4 + ks) + 8 * hi + 4, vb, lane); qb[ks] = rowfrag(imgQH, 32 * tb + r32, 2 * (k4 + ks) + hi); }
#pragma unroll
              for (int ks = 0; ks < 4; ++ks) o = HG_MFMA(sa[ks], qb[ks], o); }
#pragma unroll
            for (int sb = 0; sb < 2; ++sb) {
                if (sb <= tb) {
                    f32x16 at;
#pragma unroll
                    for (int r = 0; r < 16; ++r) at[r] = 0.f;
#pragma unroll
                    for (int k4 = 0; k4 < 8; k4 += 4) { bf16x8 ka[4], qa[4];
#pragma unroll
                      for (int ks = 0; ks < 4; ++ks) { ka[ks] = rowfrag(imgKT, 32 * sb + r32, 2 * (k4 + ks) + hi); qa[ks] = rowfrag(imgQT, 32 * tb + r32, 2 * (k4 + ks) + hi); }
#pragma unroll
                      for (int ks = 0; ks < 4; ++ks) at = HG_MFMA(ka[ks], qa[ks], at); }
                    if (sb == tb) {
#pragma unroll
                        for (int r = 0; r < 16; ++r) if (crow(r, hi) > r32) at[r] = 0.f; }
#pragma unroll
                    for (int st = 0; st < 2; ++st) { const int s0 = 32 * sb + 16 * st + 4 * hi;
                        o = HG_MFMA(trfrag(imgV, s0, s0 + 8, vb, lane), pack_step(at, st), o); }
                }
            }
            { const float d0 = __builtin_amdgcn_exp2f(DLS[64 * kp + r32]), d1 = __builtin_amdgcn_exp2f(DLS[64 * kp + 32 + r32]);
#pragma unroll
              for (int r = 0; r < 16; ++r) { acc0[r] *= d0; acc1[r] *= d1; } }
#pragma unroll
            for (int ks = 0; ks < 4; ++ks) {
                const bf16x8 af = trfrag(imgV, 16 * ks + 8 * hi, 16 * ks + 8 * hi + 4, vb, lane);
                acc0 = HG_MFMA(af, trfrag(imgKH, 16 * ks + 8 * hi, 16 * ks + 8 * hi + 4, 2 * kp, lane), acc0);
                acc1 = HG_MFMA(af, trfrag(imgKH, 16 * ks + 8 * hi, 16 * ks + 8 * hi + 4, 2 * kp + 1, lane), acc1);
            }
            float ss = 0.f;
#pragma unroll
            for (int r = 0; r < 16; ++r) ss += o[r] * o[r];
            ss += __shfl_xor(ss, 32);
            if (hi == 0) RSS[(32 * tb + r32) * 4 + vb] = ss;
            asm volatile("s_waitcnt lgkmcnt(0)" ::: "memory"); __builtin_amdgcn_s_barrier(); asm volatile("" ::: "memory");
            const f32x4 pr = *(const LAS f32x4*)(RSS + (32 * tb + r32) * 4);
            const float rn = 1.0f / sqrtf(((pr[0] + pr[1]) + (pr[2] + pr[3])) * (1.0f / 128.0f) + EPS);
#pragma unroll
            for (int gq = 0; gq < 4; ++gq) { const int v = 32 * vb + 8 * gq + 4 * hi;
                const f32x4 gr = unpack4(gtw[gq]), sc = (gnv[gq] * rn) * (gr * vsigm(gr));
                *(GAS u32x2*)(F.XN + orow * D + 512 + h * 128 + v) = pack4(o[4 * gq] * sc[0], o[4 * gq + 1] * sc[1], o[4 * gq + 2] * sc[2], o[4 * gq + 3] * sc[3]); }
            asm volatile("s_waitcnt lgkmcnt(0)" ::: "memory"); __builtin_amdgcn_s_barrier(); asm volatile("" ::: "memory");
        }
    }
#undef HG_P3_LOAD
}
#undef HG_MFMA
}

struct Args { const float* in[13]; float* out; unsigned char* ws; int ph_lo, ph_hi; };
__global__ void __launch_bounds__(NWAVES * 64, 2) skel_fwd(Args args) {
    extern __shared__ __attribute__((aligned(16))) unsigned char lds[];
    Frame F;
    F.lds = (LAS unsigned char*)lds; F.MISC = (volatile LAS unsigned*)(F.lds + MISC_OFF);
    F.tid = threadIdx.x; F.lane = F.tid & 63; F.wave = __builtin_amdgcn_readfirstlane(F.tid >> 6);
    F.G = gridDim.x; { const int bx = blockIdx.x; F.vcu = (F.G % 8 == 0) ? (bx % 8) * (F.G / 8) + bx / 8 : bx; }
    unsigned char* ws = args.ws;
    F.ctl = (gu32*)(ws + WS_CTL);
    F.x = args.in[0]; F.n1g = args.in[1]; F.w_in = args.in[2]; F.gq = args.in[3]; F.gk = args.in[4]; F.lbt = args.in[5]; F.hgn = args.in[6]; F.w_br = args.in[7]; F.w_out = args.in[8];
    F.n2g = args.in[9]; F.w_gate = args.in[10]; F.w_up = args.in[11]; F.w_dn = args.in[12]; F.out = args.out;
    F.WIN = (bf16*)(ws + WS_WIN); F.WBR = (bf16*)(ws + WS_WBR); F.WOUT = (bf16*)(ws + WS_WOUT); F.WGU = (bf16*)(ws + WS_WGU); F.WDN = (bf16*)(ws + WS_WDN);
    F.XN = (bf16*)(ws + WS_XN); F.Q = (bf16*)(ws + WS_Q); F.K = (bf16*)(ws + WS_K); F.V = (bf16*)(ws + WS_V); F.HQ = (bf16*)(ws + WS_HQ); F.LOGF = (float*)(ws + WS_LOGF);
    F.HI = (bf16*)(ws + WS_HI); F.HGG = (bf16*)(ws + WS_HGG); F.GS = (bf16*)(ws + WS_GS); F.GH = (bf16*)(ws + WS_GH); F.MIXED = (bf16*)(ws + WS_MIXED); F.STASH = (bf16*)(ws + WS_STASH); F.ACT = (bf16*)(ws + WS_ACT);
    for (int u = F.tid; u < (LDS_BYTES - LDSCTL_OFF) / 4; u += NWAVES * 64) ((LAS unsigned*)(F.lds + LDSCTL_OFF))[u] = 0u;
    __syncthreads();
    XcdBarrier bar; bar.bar = (unsigned*)(F.ctl + CW_BAR); bar.x = 0; bar.st = nullptr;
    if (MK_ONE_LAUNCH) bar = xcd_barrier_post((unsigned*)(F.ctl + CW_BAR), F.MISC + 8);
    const int lo = args.ph_lo, hi = args.ph_hi;
#define IN(k) (lo <= (k) && (k) < hi)
#define SEAM(k) do { if (IN(k) && IN((k) + 1)) xcd_barrier(bar); } while (0)

    if (IN(0)) { p0_prologue<0>(F); } SEAM(0);
    if (IN(1)) {
        if (((int)blockIdx.x >> 3) & 1) { p0_prologue<1>(F); asm volatile("s_waitcnt vmcnt(0) lgkmcnt(0)" ::: "memory"); } __syncthreads();
        pg8::Gemm g{F.XN, F.WIN, M, NIN, D, D, D}; pg8::StaticOrder S; S.init(M, NIN, F.G, (int)blockIdx.x);
        pg8::EpiProj E{F.Q, F.K, F.V, F.HQ, F.HI, F.HGG, F.GS, F.GH, F.LOGF, F.gq, F.gk, F.lbt, QSCALE, EPS};
        pg8::gemm_phase<pg8::EpiProj, pg8::StaticOrder, true, true>(F.lds + RING_OFF, g, S, E);
    } SEAM(1);
    bf16* HL = (bf16*)F.out; float* HDl = (float*)((unsigned char*)F.out + 64 * MiB);
    if (IN(2)) { hg::pass1(F, HL, HDl); __syncthreads(); sba::attn_phase(F); } SEAM(2);
    if (IN(3)) { hg::pass3(F, HL, HDl); } SEAM(3);
    if (IN(4)) {
        pg8::Gemm g{F.XN, F.WBR, M, D, D, D, D}; pg8::StaticOrder S; S.init(M, D, F.G, (int)blockIdx.x);
        pg8::EpiGateK E{(const unsigned char*)F.GS, (const unsigned char*)F.GH, F.MIXED};
        pg8::gemm_phase<pg8::EpiGateK, pg8::StaticOrder, true, true>(F.lds + RING_OFF, g, S, E);
    } SEAM(4);
    float* rowss = (float*)(ws + WS_CTL + 524288);
    if (IN(5)) {
        pg8::Gemm g{F.MIXED, F.WOUT, M, D, D, D, D}; pg8::StaticOrder S; S.init(M, D, F.G, (int)blockIdx.x);
        pg8::EpiResSq E{F.x, F.XN, rowss};
        pg8::gemm_phase<pg8::EpiResSq, pg8::StaticOrder, true, true>(F.lds + RING_OFF, g, S, E);
    } SEAM(5);
    if (IN(6)) {
        pg8::Gemm g{F.XN, F.WGU, M, NIN, D, D, D}; pg8::StaticOrder S; S.init(M, NIN, F.G, (int)blockIdx.x);
        pg8::EpiSwiglu E{F.ACT, FFN, rowss, EPS};
        pg8::gemm_phase<pg8::EpiSwiglu, pg8::StaticOrder, true, true>(F.lds + RING_OFF, g, S, E);
    } SEAM(6);
    if (IN(7)) {
        pg8::Gemm g{F.ACT, F.WDN, M, D, FFN, FFN, FFN}; pg8::StaticOrder S; S.init(M, D, F.G, (int)blockIdx.x);
        pg8::EpiResHn E{F.XN, F.out};
        pg8::gemm_phase<pg8::EpiResHn, pg8::StaticOrder, true, true>(F.lds + RING_OFF, g, S, E);
    }
#undef IN
#undef SEAM
}

extern "C" void kernel_launch(void* const* d_in, const int* in_sizes, int n_in, void* d_out, int out_size, void* d_ws, size_t ws_size, hipStream_t stream) {
    static int grid = 0;
    if (grid == 0) {
        if (n_in != 13 || in_sizes[0] != M * D || out_size != M * D || ws_size < WS_END) { fprintf(stderr, "kernel_launch: unexpected shapes / workspace (n_in %d, ws %zu); nothing launched\n", n_in, ws_size); grid = -1; return; }
        int dev = 0, cus = 0;
        if (hipGetDevice(&dev) != hipSuccess || hipDeviceGetAttribute(&cus, hipDeviceAttributeMultiprocessorCount, dev) != hipSuccess) { grid = -1; return; }
        if (hipFuncSetAttribute((const void*)skel_fwd, hipFuncAttributeMaxDynamicSharedMemorySize, LDS_BYTES) != hipSuccess) { grid = -1; return; }
        int per_cu = 0;
        if (hipOccupancyMaxActiveBlocksPerMultiprocessor(&per_cu, (const void*)skel_fwd, NWAVES * 64, LDS_BYTES) != hipSuccess || per_cu < 1) { fprintf(stderr, "kernel_launch: occupancy query says %d\n", per_cu); }
        (void)hipGetLastError();
        grid = cus;
    }
    if (grid < 0) return;
    (void)hipMemsetAsync((char*)d_ws + WS_CTL, 0, CTL_ZERO_BYTES, stream);
    Args a{};
    for (int i = 0; i < 13; ++i) a.in[i] = (const float*)d_in[i];
    a.out = (float*)d_out; a.ws = (unsigned char*)d_ws;
    if (MK_ONE_LAUNCH) { a.ph_lo = 0; a.ph_hi = N_PHASES; hipLaunchKernelGGL(skel_fwd, dim3(grid), dim3(NWAVES * 64), LDS_BYTES, stream, a); }
    else for (int p = 0; p < N_PHASES; ++p) { a.ph_lo = p; a.ph_hi = p + 1; hipLaunchKernelGGL(skel_fwd, dim3(grid), dim3(NWAVES * 64), LDS_BYTES, stream, a); }
}
```

```cpp
#include <hip/hip_runtime.h>
#include <cstdio>
#include <cstdint>
namespace pg8 {
#define PG8_LAS __attribute__((address_space(3)))
typedef unsigned short bf16_t;
typedef short bf16x8 __attribute__((ext_vector_type(8)));
typedef float f32x4 __attribute__((ext_vector_type(4)));
typedef unsigned u32x4 __attribute__((ext_vector_type(4)));
constexpr int BM = 256, BK = 64, HALF = 128, HTB = HALF * BK * 2  , STAGE_BYTES = 8 * HTB, NXCD = 8, WGM = 4;

__host__ __device__ __forceinline__ int lds_byte(int r, int c) { const int st = (r >> 4) * 2 + (c >> 5), rr = r & 15, cc = c & 31, ob = rr * 64 + cc * 2; return st * 1024 + (ob ^ (((ob >> 9) & 1) << 5)); }
__host__ __device__ __forceinline__ void stage_rc(int b, int& R, int& C) { const int st = b / 1024, sb = b % 1024, swz = sb ^ (((sb >> 9) & 1) << 5); R = (st >> 1) * 16 + swz / 64; C = (st & 1) * 32 + (swz % 64) / 2; }
__host__ __device__ __forceinline__ int perm32(int rho) { const int n = rho >> 4, i = rho & 15; return 8 * (i >> 2) + 4 * n + (i & 3); }

struct Unit { int pm, pn; };
struct Gemm { const bf16_t* A; const bf16_t* Bt; int M, N, K, lda, ldb; };

struct StaticOrder {
    int nM, nN, nwg, G, c;
    __host__ __device__ void init(int M, int N, int G_, int c_) { nM = M / BM; nN = N / BM; nwg = nM * nN; G = G_; c = c_; }
    __host__ __device__ bool next(int i, Unit& u) const {
        const long L = (long)i * G + c; if (L >= nwg) return false;
        int wgid = (int)L; { const int q = nwg / NXCD, r = nwg % NXCD, xcd = wgid % NXCD, off = wgid / NXCD; wgid = (xcd < r ? xcd * (q + 1) : r * (q + 1) + (xcd - r) * q) + off; }
        const int nig = WGM * nN, gid = wgid / nig, fm = gid * WGM, gsz = (nM - fm) < WGM ? (nM - fm) : WGM;
        u.pm = fm + ((wgid % nig) % gsz); u.pn = (wgid % nig) / gsz; return true;
    }
    __device__ __forceinline__ void a_ready(const Unit&) const {}
    __device__ __forceinline__ void done(const Unit&) const {}
};

typedef float f32x2_t __attribute__((ext_vector_type(2))); typedef __bf16 bf16x2_t __attribute__((ext_vector_type(2)));
__device__ __forceinline__ unsigned cvt_pk_bf16(float lo, float hi) { const f32x2_t v = {lo, hi}; const bf16x2_t b = __builtin_convertvector(v, bf16x2_t); return __builtin_bit_cast(unsigned, b); }
typedef unsigned u32x2 __attribute__((ext_vector_type(2)));
__device__ __forceinline__ float ex2(float x) { return __builtin_amdgcn_exp2f(x); }
__device__ __forceinline__ float sigm(float x) { return __builtin_amdgcn_rcpf(1.0f + ex2(x * -1.4426950408889634f)); }
__device__ __forceinline__ u32x4 pack8(const f32x4 a, const f32x4 b) { u32x4 w; w.x = cvt_pk_bf16(a[0], a[1]); w.y = cvt_pk_bf16(a[2], a[3]); w.z = cvt_pk_bf16(b[0], b[1]); w.w = cvt_pk_bf16(b[2], b[3]); return w; }
__device__ __forceinline__ f32x4 bf4_lo(const u32x4 w) { return (f32x4){__uint_as_float(w.x << 16), __uint_as_float(w.x & 0xffff0000u), __uint_as_float(w.y << 16), __uint_as_float(w.y & 0xffff0000u)}; }
__device__ __forceinline__ f32x4 bf4_hi(const u32x4 w) { return (f32x4){__uint_as_float(w.z << 16), __uint_as_float(w.z & 0xffff0000u), __uint_as_float(w.w << 16), __uint_as_float(w.w & 0xffff0000u)}; }

__device__ __forceinline__ u32x2 pack8_fp8(const f32x4 a, const f32x4 b) { u32x2 w; int t = __builtin_amdgcn_cvt_pk_fp8_f32(a[0], a[1], 0, false); t = __builtin_amdgcn_cvt_pk_fp8_f32(a[2], a[3], t, true); w.x = (unsigned)t;
    t = __builtin_amdgcn_cvt_pk_fp8_f32(b[0], b[1], 0, false); t = __builtin_amdgcn_cvt_pk_fp8_f32(b[2], b[3], t, true); w.y = (unsigned)t; return w; }
__device__ __forceinline__ f32x4 fp8x4(unsigned w) { typedef float f2_ __attribute__((ext_vector_type(2))); const f2_ lo = __builtin_amdgcn_cvt_pk_f32_fp8((int)w, false), hi = __builtin_amdgcn_cvt_pk_f32_fp8((int)w, true); return (f32x4){lo.x, lo.y, hi.x, hi.y}; }
struct EpiProj {
    static constexpr bool PERM = true, AFTER_DRAIN = false, MID = false;
    bf16_t *Q, *Kq, *V, *HQ, *HI, *HGG, *GS, *GH; float* LOGF; const float *gq, *gk, *lbt; float qscale, eps;
    __device__ __forceinline__ void operator()(const f32x4 (&acc)[2][2][4][2], const Unit& u, int wr, int wc, int fr, int fq) const {
        const int pn = u.pn, row0 = u.pm * BM + wr * 64 + fr;
        if (pn < 4) {
            const bool isq = pn < 2; const int head = 4 * (pn & 1) + wc;
            bf16_t* base = (isq ? Q : Kq) + head * 64 + 8 * fq; const float* g = (isq ? gq : gk) + 8 * fq; const float sc = isq ? qscale : 1.0f;
            f32x4 gv[2][2];
#pragma unroll
            for (int bj = 0; bj < 2; ++bj)
#pragma unroll
                for (int n = 0; n < 2; ++n) gv[bj][n] = *(const f32x4*)(g + 32 * bj + 4 * n) * sc;
#pragma unroll
            for (int ai = 0; ai < 2; ++ai)
#pragma unroll
                for (int m = 0; m < 4; ++m) {
                    float ss = 0.f;
#pragma unroll
                    for (int bj = 0; bj < 2; ++bj)
#pragma unroll
                        for (int n = 0; n < 2; ++n) { const f32x4 x = acc[ai][bj][m][n]; ss += (x[0] * x[0] + x[1] * x[1]) + (x[2] * x[2] + x[3] * x[3]); }
                    ss += __shfl_xor(ss, 16); ss += __shfl_xor(ss, 32);
                    const float rs = 1.0f / sqrtf(ss * (1.0f / 64.0f) + eps);
                    bf16_t* rowp = base + (size_t)(row0 + ai * HALF + m * 16) * 512;
#pragma unroll
                    for (int bj = 0; bj < 2; ++bj) *(u32x4*)(rowp + 32 * bj) = pack8(acc[ai][bj][m][0] * rs * gv[bj][0], acc[ai][bj][m][1] * rs * gv[bj][1]);
                }
        } else if (pn == 8 || pn == 9) {
            store_tile<0>(acc, (bf16_t*)LOGF, 512, row0, 256 * (pn - 8) + 32 * wc + 8 * fq);
        } else {
            const int cw = 32 * wc + 8 * fq;
            if (pn < 6) store_tile<0>(acc, V, 512, row0, 256 * (pn - 4) + cw);
            else if (pn < 8) store_tile<0>(acc, HQ, 512, row0, 256 * (pn - 6) + cw);
            else if (pn < 12) store_tile<0>(acc, HI, 512, row0, 256 * (pn - 10) + cw);
            else if (pn < 14) store_tile<0>(acc, HGG, 512, row0, 256 * (pn - 12) + cw);
            else if (pn < 18) store_tile8(acc, (unsigned char*)GS, row0, 256 * (pn - 14) + cw);
            else store_tile8(acc, (unsigned char*)GH, row0, 256 * (pn - 18) + cw);
        }
    }
    static __device__ __forceinline__ void store_tile8(const f32x4 (&acc)[2][2][4][2], unsigned char* ob, int row0, int cb) {
#pragma unroll
        for (int ai = 0; ai < 2; ++ai)
#pragma unroll
            for (int m = 0; m < 4; ++m) { unsigned char* rowp = ob + (size_t)(row0 + ai * HALF + m * 16) * 1024 + cb;
#pragma unroll
                for (int bj = 0; bj < 2; ++bj) *(u32x2*)(rowp + 128 * bj) = pack8_fp8(acc[ai][bj][m][0], acc[ai][bj][m][1]); }
    }
    template <int MODE  > static __device__ __forceinline__ void store_tile(const f32x4 (&acc)[2][2][4][2], bf16_t* ob, int ld, int row0, int cb) {
#pragma unroll
        for (int ai = 0; ai < 2; ++ai)
#pragma unroll
            for (int m = 0; m < 4; ++m) { bf16_t* rowp = ob + (size_t)(row0 + ai * HALF + m * 16) * ld + cb;
#pragma unroll
                for (int bj = 0; bj < 2; ++bj) { f32x4 v[2];
#pragma unroll
                    for (int n = 0; n < 2; ++n) { const f32x4 x = acc[ai][bj][m][n];
                        if (MODE == 0) v[n] = x;
                        else {
#pragma unroll
                            for (int j = 0; j < 4; ++j) { const float s = sigm(x[j]); v[n][j] = MODE == 1 ? x[j] * s : s; } } }
                    *(u32x4*)(rowp + 128 * bj) = pack8(v[0], v[1]); } }
    }
};
struct EpiGateK {
    static constexpr bool PERM = true, AFTER_DRAIN = false, MID = true;
    const unsigned char* gs; const unsigned char* gh; bf16_t* out;
    __device__ __forceinline__ void mid(f32x4 (&acc)[2][2][4][2], const Unit& u, int wr, int wc, int fr_, int fq_) const {
        int fr = fr_, fq = fq_; asm volatile("" : "+v"(fr), "+v"(fq));
        const int row0 = u.pm * BM + wr * 64 + fr, col0 = u.pn * BM + wc * 32 + 8 * fq;
#pragma unroll
        for (int ai = 0; ai < 2; ++ai) {
            u32x2 a[4][2], b[4][2];
#pragma unroll
            for (int m = 0; m < 4; ++m)
#pragma unroll
                for (int bj = 0; bj < 2; ++bj) { const size_t off = (size_t)(row0 + ai * HALF + m * 16) * 1024 + col0 + bj * HALF; a[m][bj] = *(const u32x2*)(gs + off); b[m][bj] = *(const u32x2*)(gh + off); }
            asm volatile("" ::: "memory");
#pragma unroll
            for (int m = 0; m < 4; ++m)
#pragma unroll
                for (int bj = 0; bj < 2; ++bj) {
                    const f32x4 es0 = fp8x4(a[m][bj].x) * -1.4426950408889634f, es1 = fp8x4(a[m][bj].y) * -1.4426950408889634f, eh0 = fp8x4(b[m][bj].x) * -1.4426950408889634f, eh1 = fp8x4(b[m][bj].y) * -1.4426950408889634f;
                    f32x4 n0, n1, d0, d1;
#pragma unroll
                    for (int j = 0; j < 4; ++j) { n0[j] = ex2(eh0[j]); n1[j] = ex2(eh1[j]); d0[j] = ex2(es0[j]); d1[j] = ex2(es1[j]); }
                    n0 = n0 + 1.0f; n1 = n1 + 1.0f; d0 = d0 + 1.0f; d1 = d1 + 1.0f;
#pragma unroll
                    for (int j = 0; j < 4; ++j) { d0[j] = __builtin_amdgcn_rcpf(d0[j]); d1[j] = __builtin_amdgcn_rcpf(d1[j]); }
                    acc[ai][bj][m][0] = acc[ai][bj][m][0] * (n0 * d0); acc[ai][bj][m][1] = acc[ai][bj][m][1] * (n1 * d1); }
            asm volatile("" ::: "memory");
        }
    }
    __device__ __forceinline__ void operator()(const f32x4 (&acc)[2][2][4][2], const Unit& u, int wr, int wc, int fr, int fq) const {
        const int row0 = u.pm * BM + wr * 64 + fr, col0 = u.pn * BM + wc * 32 + 8 * fq;
#pragma unroll
        for (int ai = 0; ai < 2; ++ai) {
            u32x2 b[4][2];
#pragma unroll
            for (int m = 0; m < 4; ++m)
#pragma unroll
                for (int bj = 0; bj < 2; ++bj) b[m][bj] = *(const u32x2*)(gh + (size_t)(row0 + ai * HALF + m * 16) * 1024 + col0 + bj * HALF);
            asm volatile("" ::: "memory");
#pragma unroll
            for (int m = 0; m < 4; ++m)
#pragma unroll
                for (int bj = 0; bj < 2; ++bj) { f32x4 g0 = fp8x4(b[m][bj].x), g1 = fp8x4(b[m][bj].y);
#pragma unroll
                    for (int j = 0; j < 4; ++j) { g0[j] = sigm(g0[j]); g1[j] = sigm(g1[j]); }
                    *(u32x4*)(out + (size_t)(row0 + ai * HALF + m * 16) * 1024 + col0 + bj * HALF) = pack8(acc[ai][bj][m][0] * g0, acc[ai][bj][m][1] * g1); }
            asm volatile("" ::: "memory");
        }
    }
};
struct EpiResHn {
    static constexpr bool PERM = false, AFTER_DRAIN = false, MID = false;
    const bf16_t* hn; float* out;
    __device__ __forceinline__ void operator()(const f32x4 (&acc)[2][2][4][2], const Unit& u, int wr, int wc, int fr, int fq) const {
        const int row0 = u.pm * BM + wr * 64 + fr, col0 = u.pn * BM + wc * 32 + 4 * fq;
#pragma unroll
        for (int ai = 0; ai < 2; ++ai) {
            u32x2 pre[4][2][2];
#pragma unroll
            for (int m = 0; m < 4; ++m) {
#pragma unroll
                for (int bj = 0; bj < 2; ++bj)
#pragma unroll
                    for (int n = 0; n < 2; ++n) pre[m][bj][n] = *(const u32x2*)(hn + (size_t)(row0 + ai * HALF + m * 16) * 1024 + col0 + bj * HALF + n * 16); }
            asm volatile("" ::: "memory");
#pragma unroll
            for (int m = 0; m < 4; ++m)
#pragma unroll
                for (int bj = 0; bj < 2; ++bj)
#pragma unroll
                    for (int n = 0; n < 2; ++n) { const u32x2 w = pre[m][bj][n];
                        const f32x4 h = (f32x4){__uint_as_float(w.x << 16), __uint_as_float(w.x & 0xffff0000u), __uint_as_float(w.y << 16), __uint_as_float(w.y & 0xffff0000u)};
                        *(f32x4*)(out + (size_t)(row0 + ai * HALF + m * 16) * 1024 + col0 + bj * HALF + n * 16) = h + acc[ai][bj][m][n]; }
            asm volatile("" ::: "memory");
        }
    }
};
struct EpiResSq {
    static constexpr bool PERM = false, AFTER_DRAIN = false, MID = false;
    const float* base; bf16_t* hb; float* rowss;
    __device__ __forceinline__ void operator()(const f32x4 (&acc)[2][2][4][2], const Unit& u, int wr, int wc, int fr, int fq) const {
        const int row0 = u.pm * BM + wr * 64 + fr, col0 = u.pn * BM + wc * 32 + 4 * fq;
#pragma unroll
        for (int ai = 0; ai < 2; ++ai) {
            f32x4 pre[4][2][2];
#pragma unroll
            for (int m = 0; m < 4; ++m)
#pragma unroll
                for (int bj = 0; bj < 2; ++bj)
#pragma unroll
                    for (int n = 0; n < 2; ++n) pre[m][bj][n] = *(const f32x4*)(base + (size_t)(row0 + ai * HALF + m * 16) * 1024 + col0 + bj * HALF + n * 16);
            asm volatile("" ::: "memory");
#pragma unroll
            for (int m = 0; m < 4; ++m) { float s = 0.f;
#pragma unroll
                for (int bj = 0; bj < 2; ++bj)
#pragma unroll
                    for (int n = 0; n < 2; ++n) { const f32x4 h = pre[m][bj][n] + acc[ai][bj][m][n]; s += (h[0] * h[0] + h[1] * h[1]) + (h[2] * h[2] + h[3] * h[3]);
                        u32x2 w; w.x = cvt_pk_bf16(h[0], h[1]); w.y = cvt_pk_bf16(h[2], h[3]); *(u32x2*)(hb + (size_t)(row0 + ai * HALF + m * 16) * 1024 + col0 + bj * HALF + n * 16) = w; }
                s += __shfl_xor(s, 16); s += __shfl_xor(s, 32);
                if (fq == 0) __hip_atomic_fetch_add(rowss + row0 + ai * HALF + m * 16, s, __ATOMIC_RELAXED, __HIP_MEMORY_SCOPE_AGENT); }
            asm volatile("" ::: "memory");
        }
    }
};
struct EpiSwiglu {
    static constexpr bool PERM = true, AFTER_DRAIN = false, MID = false;
    bf16_t* out; int ldc; const float* rowss; float eps;
    __device__ __forceinline__ void operator()(const f32x4 (&acc)[2][2][4][2], const Unit& u, int wr, int wc, int fr, int fq) const {
        const int row0 = u.pm * BM + wr * 64 + fr, col0 = u.pn * HALF + wc * 32 + 8 * fq;
        float rs[2][4];
#pragma unroll
        for (int ai = 0; ai < 2; ++ai)
#pragma unroll
            for (int m = 0; m < 4; ++m) rs[ai][m] = rowss[row0 + ai * HALF + m * 16];
#pragma unroll
        for (int ai = 0; ai < 2; ++ai)
#pragma unroll
            for (int m = 0; m < 4; ++m) { f32x4 v[2]; const float r = 1.0f / sqrtf(rs[ai][m] * (1.0f / 1024.0f) + eps), cr = -1.4426950408889634f * r, r2 = r * r;
#pragma unroll
                for (int n = 0; n < 2; ++n) {
                    const f32x4 g4 = acc[ai][0][m][n], u4 = acc[ai][1][m][n], t = g4 * cr;
                    f32x4 d; d[0] = ex2(t[0]); d[1] = ex2(t[1]); d[2] = ex2(t[2]); d[3] = ex2(t[3]); d = d + 1.0f;
                    f32x4 s; s[0] = __builtin_amdgcn_rcpf(d[0]); s[1] = __builtin_amdgcn_rcpf(d[1]); s[2] = __builtin_amdgcn_rcpf(d[2]); s[3] = __builtin_amdgcn_rcpf(d[3]);
                    v[n] = (g4 * u4) * (s * r2); }
                *(u32x4*)(out + (size_t)(row0 + ai * HALF + m * 16) * ldc + col0) = pack8(v[0], v[1]); }
    }
};
template <class Epi, class Sched, bool ALIGN_EPI = false, bool SP2 = false>
__device__ __forceinline__ void gemm_phase(PG8_LAS unsigned char* lds, const Gemm g, const Sched& S, const Epi& E) {
    const int tid = threadIdx.x, wid = __builtin_amdgcn_readfirstlane(tid >> 6), lane = tid & 63, wr = wid >> 2, wc = wid & 3, fr = lane & 15, fq = lane >> 4;
    const int K = g.K, nt = K / BK;
    unsigned voffA[2], voffB[2];
#pragma unroll
    for (int i = 0; i < 2; ++i) { int R, C; stage_rc(tid * 16 + i * 8192, R, C); const int Rb = Epi::PERM ? ((R & ~31) + perm32(R & 31)) : R;
        voffA[i] = (unsigned)(R * g.lda + C) * 2u; voffB[i] = (unsigned)(Rb * g.ldb + C) * 2u; }
    const size_t kstep = (size_t)(BK * 2);
    const size_t hstepA = (size_t)HALF * g.lda * 2, hstepB = (size_t)HALF * g.ldb * 2;
    const size_t tstepA = 2 * hstepA, tstepB = 2 * hstepB;
    const unsigned ldsw = (unsigned)wid * 1024u;
    const int aoff = lds_byte(wr * 64 + fr, fq * 8), boff = lds_byte(wc * 32 + fr, fq * 8);
#define PG8_SA(b, h) (((b) * 2 + (h)) * HTB)
#define PG8_SB(b, h) ((4 + (b) * 2 + (h)) * HTB)
#define PG8_STAGE(bufoff, gbase, voff) do { _Pragma("unroll") for (int _i = 0; _i < 2; ++_i) \
        __builtin_amdgcn_global_load_lds((const unsigned*)((const char*)(gbase) + (voff)[_i]), (PG8_LAS unsigned*)(lds + (bufoff) + ldsw + _i * 8192), 16, 0, 0); } while (0)
#define PG8_LDA(dst, b, h) do { _Pragma("unroll") for (int m = 0; m < 4; ++m) _Pragma("unroll") for (int k = 0; k < 2; ++k) dst[m][k] = *(const PG8_LAS bf16x8*)(lds + PG8_SA(b, h) + aoff + m * 2048 + k * 1024); } while (0)
#define PG8_LDB(dst, b, h) do { _Pragma("unroll") for (int n = 0; n < 2; ++n) _Pragma("unroll") for (int k = 0; k < 2; ++k) dst[n][k] = *(const PG8_LAS bf16x8*)(lds + PG8_SB(b, h) + boff + n * 2048 + k * 1024); } while (0)
#define PG8_MMA(ai, bj, At, Bt) do { __builtin_amdgcn_s_setprio(1); _Pragma("unroll") for (int m = 0; m < 4; ++m) _Pragma("unroll") for (int n = 0; n < 2; ++n) _Pragma("unroll") for (int k = 0; k < 2; ++k) \
        acc[ai][bj][m][n] = __builtin_amdgcn_mfma_f32_16x16x32_bf16(Bt[n][k], At[m][k], acc[ai][bj][m][n], 0, 0, 0); __builtin_amdgcn_s_setprio(0); } while (0)
#define PG8_WAIT_V(n) asm volatile("s_waitcnt vmcnt(" #n ")" ::: "memory")
#define PG8_WAIT_L(n) asm volatile("s_waitcnt lgkmcnt(" #n ")" ::: "memory")
#define PG8_BAR __builtin_amdgcn_s_barrier()
#define PG8_SCHED __builtin_amdgcn_sched_barrier(0)
    Unit cur, nxt; int ui = 0;
    if (!S.next(0, cur)) return;
    f32x4 acc[2][2][4][2];
#pragma unroll
    for (int a = 0; a < 2; ++a)
#pragma unroll
        for (int b = 0; b < 2; ++b)
#pragma unroll
            for (int m = 0; m < 4; ++m)
#pragma unroll
                for (int n = 0; n < 2; ++n) acc[a][b][m][n] = (f32x4){0.f, 0.f, 0.f, 0.f};
    bf16x8 At[4][2], B0[2][2], B1[2][2];
    const char* cA = (const char*)g.A + (size_t)cur.pm * tstepA; const char* cB = (const char*)g.Bt + (size_t)cur.pn * tstepB;
    S.a_ready(cur);
    if constexpr (SP2) {
        PG8_STAGE(PG8_SB(0, 0), cB, voffB); PG8_STAGE(PG8_SB(0, 1), cB + hstepB, voffB); PG8_STAGE(PG8_SA(0, 0), cA, voffA); PG8_STAGE(PG8_SA(0, 1), cA + hstepA, voffA);
        if (wr == 1) PG8_BAR;
        PG8_WAIT_V(2); PG8_BAR;
        PG8_STAGE(PG8_SB(1, 0), cB + kstep, voffB); PG8_STAGE(PG8_SA(1, 0), cA + kstep, voffA); PG8_STAGE(PG8_SB(1, 1), cB + hstepB + kstep, voffB);
        PG8_WAIT_V(6); PG8_BAR;
    } else {
        PG8_STAGE(PG8_SB(0, 0), cB, voffB); PG8_STAGE(PG8_SA(0, 0), cA, voffA); PG8_STAGE(PG8_SB(0, 1), cB + hstepB, voffB); PG8_STAGE(PG8_SA(0, 1), cA + hstepA, voffA);
        if (wr == 1) PG8_BAR;
        PG8_WAIT_V(4); PG8_BAR;
        PG8_STAGE(PG8_SB(1, 0), cB + kstep, voffB); PG8_STAGE(PG8_SA(1, 0), cA + kstep, voffA); PG8_STAGE(PG8_SB(1, 1), cB + hstepB + kstep, voffB);
        PG8_WAIT_V(6); PG8_BAR;
    }
    for (;;) {
        const bool has_next = S.next(ui + 1, nxt);
        const char* nA = has_next ? (const char*)g.A + (size_t)nxt.pm * tstepA : cA; const char* nB = has_next ? (const char*)g.Bt + (size_t)nxt.pn * tstepB : cB;
        for (int t = 0; t < nt; t += 2) {
            if constexpr (Epi::MID) { if (t == nt / 2) E.mid(acc, cur, wr, wc, fr, fq); }
            const bool last = (t == nt - 2);
            const char* a1 = cA + (size_t)(t + 1) * kstep;
            const char* a2 = last ? nA : cA + (size_t)(t + 2) * kstep; const char* b2 = last ? nB : cB + (size_t)(t + 2) * kstep;
            const char* a3 = a2 + kstep; const char* b3 = b2 + kstep;
            if (last && has_next) S.a_ready(nxt);
            if constexpr (SP2) {
            PG8_LDB(B0, 0, 0); PG8_LDB(B1, 0, 1); PG8_SCHED; PG8_LDA(At, 0, 0); PG8_STAGE(PG8_SA(1, 1), a1 + hstepA, voffA);
            PG8_WAIT_V(8); PG8_WAIT_L(0); PG8_BAR; PG8_MMA(0, 0, At, B0); PG8_MMA(0, 1, At, B1); PG8_BAR; PG8_SCHED;
            PG8_LDA(At, 0, 1); PG8_STAGE(PG8_SB(0, 0), b2, voffB); PG8_STAGE(PG8_SB(0, 1), b2 + hstepB, voffB); PG8_STAGE(PG8_SA(0, 0), a2, voffA);
            PG8_WAIT_V(8); PG8_WAIT_L(0); PG8_BAR; PG8_MMA(1, 0, At, B0); PG8_MMA(1, 1, At, B1); PG8_BAR; PG8_SCHED;
            PG8_LDB(B0, 1, 0); PG8_LDB(B1, 1, 1); PG8_SCHED; PG8_LDA(At, 1, 0); PG8_STAGE(PG8_SA(0, 1), a2 + hstepA, voffA);
            PG8_WAIT_V(8); PG8_WAIT_L(0); PG8_BAR; PG8_MMA(0, 0, At, B0); PG8_MMA(0, 1, At, B1); PG8_BAR; PG8_SCHED;
            PG8_LDA(At, 1, 1); PG8_STAGE(PG8_SB(1, 0), b3, voffB); PG8_STAGE(PG8_SB(1, 1), b3 + hstepB, voffB); PG8_STAGE(PG8_SA(1, 0), a3, voffA);
            PG8_WAIT_V(8); PG8_WAIT_L(0); PG8_BAR; PG8_MMA(1, 0, At, B0); PG8_MMA(1, 1, At, B1); PG8_BAR; PG8_SCHED;
            } else {
            PG8_LDB(B0, 0, 0); PG8_SCHED; PG8_LDA(At, 0, 0); PG8_STAGE(PG8_SA(1, 1), a1 + hstepA, voffA);
            PG8_WAIT_L(8); PG8_BAR; PG8_WAIT_L(0); PG8_MMA(0, 0, At, B0); PG8_BAR; PG8_SCHED;
            PG8_LDB(B1, 0, 1); PG8_STAGE(PG8_SB(0, 0), b2, voffB);
            PG8_BAR; PG8_WAIT_L(0); PG8_MMA(0, 1, At, B1); PG8_BAR;
            PG8_LDA(At, 0, 1); PG8_STAGE(PG8_SA(0, 0), a2, voffA);
            PG8_BAR; PG8_WAIT_L(0); PG8_MMA(1, 0, At, B0); PG8_BAR; PG8_SCHED;
            PG8_STAGE(PG8_SB(0, 1), b2 + hstepB, voffB);
            PG8_WAIT_V(6); PG8_BAR; PG8_MMA(1, 1, At, B1); PG8_BAR;
            PG8_LDB(B0, 1, 0); PG8_SCHED; PG8_LDA(At, 1, 0); PG8_STAGE(PG8_SA(0, 1), a2 + hstepA, voffA);
            PG8_WAIT_L(8); PG8_BAR; PG8_WAIT_L(0); PG8_MMA(0, 0, At, B0); PG8_BAR; PG8_SCHED;
            PG8_LDB(B1, 1, 1); PG8_STAGE(PG8_SB(1, 0), b3, voffB);
            PG8_BAR; PG8_WAIT_L(0); PG8_MMA(0, 1, At, B1); PG8_BAR;
            PG8_LDA(At, 1, 1); PG8_STAGE(PG8_SA(1, 0), a3, voffA);
            PG8_BAR; PG8_WAIT_L(0); PG8_MMA(1, 0, At, B0); PG8_BAR; PG8_SCHED;
            PG8_STAGE(PG8_SB(1, 1), b3 + hstepB, voffB);
            PG8_WAIT_V(6); PG8_BAR; PG8_MMA(1, 1, At, B1); PG8_BAR;
            }
        }
        if constexpr (ALIGN_EPI) { if (wr == 0) PG8_BAR; }
        if constexpr (!Epi::AFTER_DRAIN) { E(acc, cur, wr, wc, fr, fq); S.done(cur); }
        if (!has_next) break;
#pragma unroll
        for (int a = 0; a < 2; ++a)
#pragma unroll
            for (int b = 0; b < 2; ++b)
#pragma unroll
                for (int m = 0; m < 4; ++m)
#pragma unroll
                    for (int n = 0; n < 2; ++n) acc[a][b][m][n] = (f32x4){0.f, 0.f, 0.f, 0.f};
        cur = nxt; cA = nA; cB = nB; ++ui;
        if constexpr (ALIGN_EPI) { if (wr == 1) PG8_BAR; }
    }
    PG8_WAIT_V(0);
    if constexpr (!ALIGN_EPI) { if (wr == 0) PG8_BAR; }
    PG8_BAR;
    if constexpr (Epi::AFTER_DRAIN) { E.fused(acc, cur, wr, wc, fr, fq, lds, wid, lane); S.done(cur); }
#undef PG8_SA
#undef PG8_SB
#undef PG8_STAGE
#undef PG8_LDA
#undef PG8_LDB
#undef PG8_MMA
#undef PG8_WAIT_V
#undef PG8_WAIT_L
#undef PG8_BAR
#undef PG8_SCHED
}
}
constexpr int NWAVES = 8;
#ifndef MK_ONE_LAUNCH
#define MK_ONE_LAUNCH 1
#endif
constexpr int N_PHASES = 8;

constexpr int BATCH = 8, SEQ = 4096, D = 1024, M = BATCH * SEQ;
constexpr int SBH = 8, SBD = 64, SBW = 512, HGH = 4, HGD = 128, HGW = 512, NIN = 5632, FFN = 2816;
constexpr float EPS = 1e-6f;
constexpr float QSCALE = 0.125f * 1.4426950408889634f;

constexpr size_t MiB = 1u << 20;
constexpr size_t WS_CTL = 0, CTL_ZERO_BYTES = 1 * MiB;
constexpr size_t WS_WIN = 1 * MiB, WS_WBR = 12 * MiB, WS_WOUT = 14 * MiB, WS_WGU = 16 * MiB, WS_WDN = 27 * MiB;
constexpr size_t WS_XN = 33 * MiB;
constexpr size_t WS_Q = 97 * MiB, WS_K = 129 * MiB, WS_V = 161 * MiB, WS_HQ = 193 * MiB, WS_LOGF = 225 * MiB, WS_HI = 289 * MiB, WS_HGG = 321 * MiB, WS_GS = 353 * MiB, WS_GH = 417 * MiB;
constexpr size_t WS_MIXED = 97 * MiB, WS_STASH = 161 * MiB;
constexpr size_t WS_ACT = 225 * MiB;
constexpr size_t WS_END = 481 * MiB;
static_assert(WS_ACT + (size_t)M * FFN * 2 <= WS_GH + 64 * MiB && WS_WDN + (size_t)D * FFN * 2 <= WS_XN, "d_ws map");
constexpr int CW_TMO = 0, CW_CODE = 1, CW_BAR = 4096, CW_SEAM = 16384;

constexpr int RING_OFF = 0, RING_BYTES = 131072;
constexpr int LDSCTL_OFF = RING_BYTES, MISC_OFF = LDSCTL_OFF + 320;
constexpr int LDS_BYTES = 147456;
#define GAS __attribute__((address_space(1)))
#define LAS __attribute__((address_space(3)))
typedef unsigned short bf16;
typedef unsigned v4u __attribute__((ext_vector_type(4)));
typedef float f32x4 __attribute__((ext_vector_type(4)));
typedef short bf16x8 __attribute__((ext_vector_type(8)));
typedef GAS unsigned gu32;
typedef GAS unsigned long long gu64;
#define RLX_AGENT __ATOMIC_RELAXED, __HIP_MEMORY_SCOPE_AGENT
#define LDS_WAIT() asm volatile("s_waitcnt lgkmcnt(0)" ::: "memory")
#define VM_WAIT() asm volatile("s_waitcnt vmcnt(0)" ::: "memory")
__device__ __forceinline__ unsigned long long rt() { return __builtin_amdgcn_s_memrealtime(); }
__device__ __forceinline__ unsigned f2bf(float f) { unsigned u = __builtin_bit_cast(unsigned, f); return (u + 0x7fffu + ((u >> 16) & 1u)) >> 16; }
__device__ __forceinline__ unsigned pk2(float lo, float hi) { return f2bf(lo) | (f2bf(hi) << 16); }

#define XB_TMO      128
#define XB_XCNT(j)  (256  + 64 * (j))
#define XB_XSUB(j)  (1280 + 64 * (j))
#define XB_XGEN(j)  (2304 + 64 * (j))
#define XB_TOP      3328
#define XB_TOPGEN   3392
#define XCD_BAR_WORDS 3456
#define XB_SPIN_CAP (1u << 18)

__device__ __forceinline__ unsigned xb_ld(unsigned* p)              { return __hip_atomic_load(p, __ATOMIC_RELAXED, __HIP_MEMORY_SCOPE_AGENT); }
__device__ __forceinline__ unsigned xb_add(unsigned* p, unsigned v) { return __hip_atomic_fetch_add(p, v, __ATOMIC_RELAXED, __HIP_MEMORY_SCOPE_AGENT); }
__device__ __forceinline__ unsigned xb_xcc_id() { return (unsigned)__builtin_amdgcn_s_getreg((3 << 11) | 20) & 0xFu; }
#define XB_SPIN(cond, bar) do { unsigned _sp = 0; while (cond) { __builtin_amdgcn_s_sleep(1); \
    if ((++_sp & 255u) == 0u) { if (xb_ld(&(bar)[XB_TMO])) break; if (_sp > XB_SPIN_CAP) { atomicAdd(&(bar)[XB_TMO], 1u); break; } } } } while (0)

struct XcdBarrier {
    unsigned* bar; unsigned x;
    volatile LAS unsigned* st;
};

__device__ __forceinline__ XcdBarrier xcd_barrier_post(unsigned* bar, volatile LAS unsigned* st) {
    XcdBarrier b; b.bar = bar; b.x = xb_xcc_id(); b.st = st;
    if (threadIdx.x == 0) (void)xb_add(&bar[XB_XCNT(b.x)], 1u);
    return b;
}
__device__ __forceinline__ void xcd_barrier_complete(unsigned* bar, unsigned x, unsigned& nloc, unsigned& nx) {
    const unsigned G = gridDim.x * gridDim.y * gridDim.z;
    unsigned sum, cnt, mine, sp = 0u;
    for (;;) {
        sum = 0u; cnt = 0u; mine = 0u;
#pragma unroll
        for (unsigned j = 0; j < 16; ++j) { const unsigned c = xb_ld(&bar[XB_XCNT(j)]); sum += c; cnt += (c > 0u) ? 1u : 0u; mine = (j == x) ? c : mine; }
        if (sum == G) break;
        __builtin_amdgcn_s_sleep(1);
        if ((++sp & 255u) == 0u) { if (xb_ld(&bar[XB_TMO])) break; if (sp > XB_SPIN_CAP) { atomicAdd(&bar[XB_TMO], 1u); break; } }
    }
    nloc = mine > 0u ? mine : 1u; nx = cnt > 0u ? cnt : 1u;
}

__device__ __forceinline__ void xcd_barrier(const XcdBarrier& b) {
    asm volatile("s_waitcnt vmcnt(0)" ::: "memory");
    __syncthreads();
    if (threadIdx.x == 0) {
        unsigned* bar = b.bar;
        __builtin_amdgcn_s_waitcnt(0);
        unsigned nloc = b.st[0], nx = b.st[1];
        if (nloc == 0u) { xcd_barrier_complete(bar, b.x, nloc, nx); b.st[0] = nloc; b.st[1] = nx; }
        const unsigned old = xb_add(&bar[XB_XSUB(b.x)], 1u);
        const unsigned gen = old / nloc;
        if (old + 1u == (gen + 1u) * nloc) {
            __builtin_amdgcn_fence(__ATOMIC_RELEASE, "agent");
            asm volatile("s_waitcnt vmcnt(0)" ::: "memory");
            const unsigned og = xb_add(&bar[XB_TOP], 1u);
            const unsigned tg = og / nx;
            if (og + 1u == (tg + 1u) * nx) xb_add(&bar[XB_TOPGEN], 1u);
            else XB_SPIN(xb_ld(&bar[XB_TOPGEN]) == tg, bar);
            __builtin_amdgcn_fence(__ATOMIC_ACQUIRE, "agent");
            xb_add(&bar[XB_XGEN(b.x)], 1u);
            asm volatile("s_waitcnt vmcnt(0)" ::: "memory");
        } else {
            XB_SPIN(xb_ld(&bar[XB_XGEN(b.x)]) == gen, bar);
            __builtin_amdgcn_fence(__ATOMIC_ACQUIRE, "agent");
            asm volatile("s_waitcnt vmcnt(0)" ::: "memory");
        }
    }
    __syncthreads();
}
struct Frame {
    LAS unsigned char* lds; volatile LAS unsigned* MISC; gu32* ctl;
    int tid, lane, wave, vcu, G;
    const float *x, *n1g, *w_in, *gq, *gk, *lbt, *hgn, *w_br, *w_out, *n2g, *w_gate, *w_up, *w_dn; float* out;
    bf16 *WIN, *WBR, *WOUT, *WGU, *WDN, *XN, *Q, *K, *V, *HQ, *HI, *HGG, *GS, *GH, *MIXED, *STASH, *ACT; float* LOGF;
};
__device__ __forceinline__ float wave_sum(float v) {
#pragma unroll
    for (int o = 1; o < 64; o <<= 1) v += __shfl_xor(v, o);
    return v;
}
__device__ __forceinline__ float bf2f(unsigned short h) { return __uint_as_float((unsigned)h << 16); }
__device__ __forceinline__ void p0_transpose_item(const float* W, int Nsrc, int ns, bf16* WT, int ldd, int nd, int k0, LAS float* scr, int lane, const float* kscale = nullptr) {
    { float wv[32];
#pragma unroll
      for (int i = 0; i < 32; ++i) { const int kk = 2 * i + (lane >> 5); wv[i] = W[(size_t)(k0 + kk) * Nsrc + ns + (lane & 31)]; }
      if (kscale) {
#pragma unroll
          for (int i = 0; i < 32; ++i) wv[i] *= kscale[k0 + 2 * i + (lane >> 5)]; }
#pragma unroll
      for (int i = 0; i < 32; ++i) { const int kk = 2 * i + (lane >> 5); scr[kk * 33 + (lane & 31)] = wv[i]; } }
    LDS_WAIT(); asm volatile("" ::: "memory");
    const int c = lane & 7;
#pragma unroll
    for (int j = 0; j < 4; ++j) { const int n = (lane >> 3) + 8 * j; const LAS float* s = scr + (8 * c) * 33 + n;
        v4u o; o.x = pk2(s[0 * 33], s[1 * 33]); o.y = pk2(s[2 * 33], s[3 * 33]); o.z = pk2(s[4 * 33], s[5 * 33]); o.w = pk2(s[6 * 33], s[7 * 33]);
        *(GAS v4u*)(WT + (size_t)(nd + n) * ldd + k0 + 8 * c) = o; }
    LDS_WAIT(); asm volatile("" ::: "memory");
}
template <int PART> __device__ __forceinline__ void p0_prologue(Frame& F) {
    LAS float* scr = (LAS float*)(F.lds + RING_OFF + F.wave * 16384);
    const int gw = PART == 0 ? F.vcu * NWAVES + F.wave : (((int)blockIdx.x >> 4) * 8 + ((int)blockIdx.x & 7)) * NWAVES + F.wave, NGW = PART == 0 ? F.G * NWAVES : (F.G / 2) * NWAVES;
    constexpr int I_IN = 16 * 176, I_BR = 16 * 32, I_OUT = 16 * 32, I_G = 16 * 88, I_U = 16 * 88, I_DN = 44 * 32;
    constexpr int NITEMS = I_IN + I_BR + I_OUT + I_G + I_U + I_DN;
    for (int it = (PART == 0 ? gw : I_IN + gw); it < (PART == 0 ? I_IN : NITEMS); it += NGW) {
        int r = it;
        if (r < I_IN) { const int kb = r / 176, nb = r % 176; int sb = nb;
            if (nb < 32) { const int pn = nb >> 3, rem = nb & 7, bj = rem >> 2, wc = rem & 3; sb = 8 * pn + 2 * wc + bj; }
            p0_transpose_item(F.w_in, NIN, 32 * sb, F.WIN, D, 32 * nb, 64 * kb, scr, F.lane); continue; } r -= I_IN;
        if (r < I_BR) { p0_transpose_item(F.w_br, D, 32 * (r % 32), F.WBR, D, 32 * (r % 32), 64 * (r / 32), scr, F.lane); continue; } r -= I_BR;
        if (r < I_OUT) { p0_transpose_item(F.w_out, D, 32 * (r % 32), F.WOUT, D, 32 * (r % 32), 64 * (r / 32), scr, F.lane); continue; } r -= I_OUT;
        if (r < I_G + I_U) { const bool up = r >= I_G; if (up) r -= I_G; const int kb = r / 88, sb = r % 88;
            p0_transpose_item(up ? F.w_up : F.w_gate, FFN, 32 * sb, F.WGU, D, 256 * (sb >> 2) + (up ? 128 : 0) + 32 * (sb & 3), 64 * kb, scr, F.lane, F.n2g); continue; } r -= I_G + I_U;
        p0_transpose_item(F.w_dn, D, 32 * (r % 32), F.WDN, FFN, 32 * (r % 32), 64 * (r / 32), scr, F.lane);
    }
    if (PART == 0) {
        const GAS f32x4* gr = (const GAS f32x4*)F.n1g + F.lane; f32x4 gv[4];
#pragma unroll
        for (int j = 0; j < 4; ++j) gv[j] = gr[64 * j];
        for (int m0 = gw * 8; m0 < M; m0 += NGW * 8) {
            f32x4 v[8][4];
#pragma unroll
            for (int r = 0; r < 8; ++r)
#pragma unroll
                for (int j = 0; j < 4; ++j) v[r][j] = ((const GAS f32x4*)(F.x + (size_t)(m0 + r) * D) + F.lane)[64 * j];
#pragma unroll
            for (int r = 0; r < 8; ++r) { float s = 0.f;
#pragma unroll
                for (int j = 0; j < 4; ++j) s += (v[r][j].x * v[r][j].x + v[r][j].y * v[r][j].y) + (v[r][j].z * v[r][j].z + v[r][j].w * v[r][j].w);
                const float rs = 1.0f / sqrtf(wave_sum(s) * (1.0f / 1024.0f) + EPS);
                GAS unsigned long long* o8 = (GAS unsigned long long*)(F.XN + (size_t)(m0 + r) * D) + F.lane;
#pragma unroll
                for (int j = 0; j < 4; ++j) o8[64 * j] = (unsigned long long)pk2(v[r][j].x * rs * gv[j].x, v[r][j].y * rs * gv[j].y) | ((unsigned long long)pk2(v[r][j].z * rs * gv[j].z, v[r][j].w * rs * gv[j].w) << 32); }
        }
    }
}

namespace sba {
typedef short bf16x8 __attribute__((ext_vector_type(8)));
typedef short s16x4 __attribute__((ext_vector_type(4)));
typedef float f32x16 __attribute__((ext_vector_type(16)));
typedef unsigned u32x4 __attribute__((ext_vector_type(4)));
typedef unsigned u32x2 __attribute__((ext_vector_type(2)));
#define SBA_MFMA(a, b, c) __builtin_amdgcn_mfma_f32_32x32x16_bf16((a), (b), (c), 0, 0, 0)
__device__ __forceinline__ int crow(int r, int hi) { return (r & 3) + 8 * (r >> 2) + 4 * hi; }
__device__ __forceinline__ bf16x8 pack_step(const f32x16& x, int s) {
    u32x4 p; p.x = pg8::cvt_pk_bf16(x[8 * s], x[8 * s + 1]); p.y = pg8::cvt_pk_bf16(x[8 * s + 2], x[8 * s + 3]); p.z = pg8::cvt_pk_bf16(x[8 * s + 4], x[8 * s + 5]); p.w = pg8::cvt_pk_bf16(x[8 * s + 6], x[8 * s + 7]);
    return __builtin_bit_cast(bf16x8, p); }
typedef short v4i16_t __attribute__((ext_vector_type(4)));
__device__ __forceinline__ s16x4 vtr(LAS const unsigned char* p) { return __builtin_bit_cast(s16x4, __builtin_amdgcn_ds_read_tr16_b64_v4i16((LAS v4i16_t*)p)); }

__device__ __forceinline__ void attn_phase(Frame& F) {
    const int lane = F.lane, r32 = lane & 31, hi = lane >> 5;
    LAS unsigned char* vst = F.lds + F.wave * 4096;
    LAS const unsigned char* vp0 = vst + ((lane >> 4) & 1) * 32 + (lane & 3) * 8 + (4 * hi + ((lane & 15) >> 2)) * 64;
    float gm = fabsf(F.gq[lane]), km = fabsf(F.gk[lane]);
#pragma unroll
    for (int o = 1; o < 64; o <<= 1) { gm = fmaxf(gm, __shfl_xor(gm, o)); km = fmaxf(km, __shfl_xor(km, o)); }
    const float THR = 152.0f + 1.02f * (QSCALE * 64.0f) * gm * km;
    bf16x8 tf0, tf1;
#pragma unroll
    for (int j = 0; j < 8; ++j) { const int k0 = 8 * (j >> 2) + 4 * hi + (j & 3); tf0[j] = (k0 >= r32) ? (short)0x3F80 : (short)0; tf1[j] = (16 + k0 >= r32) ? (short)0x3F80 : (short)0; }
    const int gw = F.vcu * NWAVES + F.wave, NGW = F.G * NWAVES;
    for (int u = gw; u < BATCH * SBH * (SEQ / 32); u += NGW) {
        const int bh = u >> 7, qblk = u & 127, b = bh >> 3, h = bh & 7, t0 = qblk * 32;
        const size_t rowb = (size_t)b * SEQ;
        bf16x8 qf[4];
        { const bf16* qp = F.Q + (rowb + t0 + r32) * SBW + h * 64 + 8 * hi;
#pragma unroll
          for (int d0 = 0; d0 < 4; ++d0) qf[d0] = *(const GAS bf16x8*)(qp + 16 * d0); }
        const bf16* kbase = F.K + rowb * SBW + h * 64 + 8 * hi; const bf16* vbase = F.V + rowb * SBW + h * 64 + (lane & 7) * 8;
        f32x16 o0, o1;
#pragma unroll
        for (int r = 0; r < 16; ++r) { o0[r] = 0.f; o1[r] = 0.f; }
        float Rc = 0.f;
        int ht = qblk; bool diag = true;
        bf16x8 kn[4]; u32x4 vn[4];
#define SBA_LOAD(HT) do { _Pragma("unroll") for (int d0 = 0; d0 < 4; ++d0) kn[d0] = *(const GAS bf16x8*)(kbase + (size_t)(32 * (HT) + r32) * SBW + 16 * d0); \
        _Pragma("unroll") for (int i = 0; i < 4; ++i) vn[i] = *(const GAS u32x4*)(vbase + (size_t)(32 * (HT) + 8 * i + (lane >> 3)) * SBW); } while (0)
        SBA_LOAD(ht);
        for (;;) {
#pragma unroll
            for (int i = 0; i < 4; ++i) { const int key = 8 * i + (lane >> 3), ch = lane & 7; *(LAS u32x4*)(vst + (ch >> 2) * 2048 + (key >> 4) * 1024 + (key & 15) * 64 + (ch & 3) * 16) = vn[i]; }
            bf16x8 kc[4];
#pragma unroll
            for (int d0 = 0; d0 < 4; ++d0) kc[d0] = kn[d0];
            if (ht > 0) SBA_LOAD(ht - 1);
            f32x16 z;
#pragma unroll
            for (int r = 0; r < 16; ++r) z[r] = 0.f;
#pragma unroll
            for (int d0 = 0; d0 < 4; ++d0) z = SBA_MFMA(kc[d0], qf[d0], z);
            f32x16 s;
#pragma unroll
            for (int r = 0; r < 16; ++r) s[r] = __builtin_amdgcn_exp2f(z[r]);
            s = s + 1.0f;
#pragma unroll
            for (int r = 0; r < 16; ++r) s[r] = __builtin_amdgcn_logf(s[r]);
            if (diag) {
#pragma unroll
                for (int r = 0; r < 16; ++r) if (crow(r, hi) >= r32) s[r] = 0.f; }
            const bf16x8 x0 = pack_step(s, 0), x1 = pack_step(s, 1);
            f32x16 c;
#pragma unroll
            for (int r = 0; r < 16; ++r) c[r] = Rc;
            c = SBA_MFMA(tf0, x0, c); c = SBA_MFMA(tf1, x1, c);
            z = z - c;
#pragma unroll
            for (int r = 0; r < 16; ++r) z[r] = __builtin_amdgcn_exp2f(z[r]);
            if (diag) {
#pragma unroll
                for (int r = 0; r < 16; ++r) if (crow(r, hi) >= r32) z[r] = 0.f; }
            const bf16x8 w0 = pack_step(z, 0), w1 = pack_step(z, 1);
            { const s16x4 l00 = vtr(vp0), h00 = vtr(vp0 + 512), l01 = vtr(vp0 + 1024), h01 = vtr(vp0 + 1536), l10 = vtr(vp0 + 2048), h10 = vtr(vp0 + 2560), l11 = vtr(vp0 + 3072), h11 = vtr(vp0 + 3584);
#define SBA_VF(l, h) (bf16x8){l[0], l[1], l[2], l[3], h[0], h[1], h[2], h[3]}
              o0 = SBA_MFMA(SBA_VF(l00, h00), w0, o0); o0 = SBA_MFMA(SBA_VF(l01, h01), w1, o0);
              o1 = SBA_MFMA(SBA_VF(l10, h10), w0, o1); o1 = SBA_MFMA(SBA_VF(l11, h11), w1, o1);
#undef SBA_VF
            }
            Rc = __shfl(c[0], r32);
            if (ht == 0) break;
            if (__all(Rc >= THR)) break;
            --ht; diag = false;
        }
#undef SBA_LOAD
        bf16* op = F.XN + (rowb + t0 + r32) * D + h * 64 + 4 * hi;
#pragma unroll
        for (int g = 0; g < 4; ++g) {
            u32x2 a, c; a.x = pg8::cvt_pk_bf16(o0[4 * g], o0[4 * g + 1]); a.y = pg8::cvt_pk_bf16(o0[4 * g + 2], o0[4 * g + 3]); c.x = pg8::cvt_pk_bf16(o1[4 * g], o1[4 * g + 1]); c.y = pg8::cvt_pk_bf16(o1[4 * g + 2], o1[4 * g + 3]);
            *(GAS u32x2*)(op + 8 * g) = a; *(GAS u32x2*)(op + 32 + 8 * g) = c; }
    }
}
#undef SBA_MFMA
}

namespace hg {
typedef short bf16x8 __attribute__((ext_vector_type(8)));
typedef short s16x4 __attribute__((ext_vector_type(4)));
typedef float f32x16 __attribute__((ext_vector_type(16)));
typedef unsigned u32x4 __attribute__((ext_vector_type(4)));
typedef unsigned u32x2 __attribute__((ext_vector_type(2)));
#define HG_MFMA(a, b, c) __builtin_amdgcn_mfma_f32_32x32x16_bf16((a), (b), (c), 0, 0, 0)
constexpr float LOG2E = 1.4426950408889634f;
__device__ __forceinline__ int imgoff(int row, int ch) { return 256 * row + 16 * (ch ^ (((row & 3) << 2) | ((row >> 2) & 3))); }
__device__ __forceinline__ int crow(int r, int hi) { return (r & 3) + 8 * (r >> 2) + 4 * hi; }
__device__ __forceinline__ s16x4 vtr(LAS const unsigned char* p) { return __builtin_bit_cast(s16x4, __builtin_amdgcn_ds_read_tr16_b64_v4i16((LAS sba::v4i16_t*)p)); }
__device__ __forceinline__ bf16x8 cat8(s16x4 lo, s16x4 hh) { return (bf16x8){lo[0], lo[1], lo[2], lo[3], hh[0], hh[1], hh[2], hh[3]}; }
__device__ __forceinline__ bf16x8 trfrag(LAS const unsigned char* img, int r0, int r1, int c, int lane) {
    const int blk = (lane >> 4) & 1, q = (lane & 15) >> 2, p = lane & 3, ch = 4 * c + 2 * blk + (p >> 1), by = 8 * (p & 1);
    return cat8(vtr(img + imgoff(r0 + q, ch) + by), vtr(img + imgoff(r1 + q, ch) + by));
}
__device__ __forceinline__ bf16x8 rowfrag(LAS const unsigned char* img, int row, int ch) { return *(const LAS bf16x8*)(img + imgoff(row, ch)); }
__device__ __forceinline__ u32x2 pack4(float a, float b, float c, float d) { u32x2 w; w.x = pg8::cvt_pk_bf16(a, b); w.y = pg8::cvt_pk_bf16(c, d); return w; }
__device__ __forceinline__ f32x4 unpack4(u32x2 w) { return (f32x4){__uint_as_float(w.x << 16), __uint_as_float(w.x & 0xffff0000u), __uint_as_float(w.y << 16), __uint_as_float(w.y & 0xffff0000u)}; }
__device__ __forceinline__ bf16x8 pack_step(const f32x16& x, int s) { return sba::pack_step(x, s); }
__device__ __forceinline__ f32x4 vexp2(const f32x4 x) { return (f32x4){__builtin_amdgcn_exp2f(x[0]), __builtin_amdgcn_exp2f(x[1]), __builtin_amdgcn_exp2f(x[2]), __builtin_amdgcn_exp2f(x[3])}; }
__device__ __forceinline__ f32x4 vrcp(const f32x4 x) { return (f32x4){__builtin_amdgcn_rcpf(x[0]), __builtin_amdgcn_rcpf(x[1]), __builtin_amdgcn_rcpf(x[2]), __builtin_amdgcn_rcpf(x[3])}; }
__device__ __forceinline__ f32x4 vlog2(const f32x4 x) { return (f32x4){__builtin_amdgcn_logf(x[0]), __builtin_amdgcn_logf(x[1]), __builtin_amdgcn_logf(x[2]), __builtin_amdgcn_logf(x[3])}; }
__device__ __forceinline__ f32x4 vsigm(const f32x4 x) { return vrcp(vexp2(x * -1.4426950408889634f) + 1.0f); }


constexpr int NUNIT = BATCH * HGH * (SEQ / 64);
__device__ __forceinline__ f32x4 scan16(f32x4 v, int lane) {
#pragma unroll
    for (int d = 4; d < 64; d <<= 1) { f32x4 t;
#pragma unroll
        for (int j = 0; j < 4; ++j) t[j] = __shfl_up(v[j], d);
        if (lane >= d) v += t; }
    return v; }
__device__ __forceinline__ f32x4 bcast4(const f32x4 v, int src) { return (f32x4){__shfl(v[0], src), __shfl(v[1], src), __shfl(v[2], src), __shfl(v[3], src)}; }

struct HgAddr {
    int RB;
    int TB1, TB2;
    int PB1, PB2;
    int W0;
    int VB;
    int SB, SL;
};
__device__ __forceinline__ HgAddr hg_addr(int tid, int lane, int wave) {
    HgAddr A; const int r32 = lane & 31, hi = lane >> 5, blk = (lane >> 4) & 1, q = (lane & 15) >> 2, p = lane & 3, l2 = 2 * blk + (p >> 1), by = 8 * (p & 1);
    const int s = (((r32 & 3) << 2) | ((r32 >> 2) & 3));
    A.RB = 256 * r32 + 16 * (hi ^ (s & 1)) + 32 * (s >> 1);
    A.TB1 = 256 * (8 * hi + q) + 64 * q + 16 * (l2 ^ (2 * hi)) + by; A.TB2 = 256 * (8 * hi + 4 + q) + 64 * q + 16 * (l2 ^ (2 * hi + 1)) + by;
    A.PB1 = 256 * (4 * hi + q) + 64 * q + 16 * (l2 ^ hi) + by;       A.PB2 = 256 * (8 + 4 * hi + q) + 64 * q + 16 * (l2 ^ (2 + hi)) + by;
    const int kq = 4 * wave + (lane & 3), tq = lane >> 2;
    A.W0 = 1024 * tq + 16 * ((kq >> 1) ^ (tq & 3)) + 8 * (kq & 1);
    const int vr = tid >> 4; A.VB = 256 * vr + 16 * ((tid & 15) ^ (((vr & 3) << 2) | ((vr >> 2) & 3)));
    const int vb = wave & 3; A.SB = 256 * r32 + 16 * ((4 * vb) ^ (s & 12)) + 8 * hi; A.SL = s & 3;
    return A;
}
__device__ __forceinline__ bf16x8 trf(LAS const unsigned char* img, int o1, int o2) { return cat8(vtr(img + o1), vtr(img + o2)); }
__device__ __forceinline__ f32x4 gl_of(const f32x4 x, const f32x4 lb, f32x4& km) {
    const f32x4 f = lb + (1.0f - lb) * vsigm(x); km = 1.0f - f; return vlog2(f); }
constexpr int NSEG = BATCH * HGH * 8;
__device__ __forceinline__ void pass1(Frame& F, bf16* L, float* Dl) {
    const int tid = F.tid, lane = F.lane, kq = 4 * F.wave + (lane & 3), tq = lane >> 2, r32 = lane & 31, hi = lane >> 5;
    LAS unsigned char* imgK = F.lds; LAS unsigned char* imgV = F.lds + 16384; LAS float* DLS = (LAS float*)(F.lds + 40960);
    const int vb = F.wave & 3, kp = F.wave >> 2;
    const HgAddr A = hg_addr(tid, lane, F.wave);
    const int tv1 = A.TB1 ^ (64 * vb), tv2 = A.TB2 ^ (64 * vb), ta1 = A.TB1 ^ (128 * kp), ta2 = A.TB2 ^ (128 * kp), tb1 = A.TB1 ^ (128 * kp + 64), tb2 = A.TB2 ^ (128 * kp + 64);
    u32x2 gx[4]; u32x4 vv[2];
#define HG_P1_LOAD(UNIT) do { const int bh_ = (UNIT) >> 6, c_ = (UNIT) & 63, b_ = bh_ >> 2, h_ = bh_ & 3; const size_t r0_ = (size_t)b_ * SEQ + c_ * 64; \
        _Pragma("unroll") for (int i = 0; i < 4; ++i) gx[i] = *(const GAS u32x2*)((const bf16*)F.LOGF + (r0_ + 4 * tq + i) * HGW + h_ * 128 + 4 * kq); \
        _Pragma("unroll") for (int j = 0; j < 2; ++j) { const int id = tid + 512 * j; vv[j] = *(const GAS u32x4*)(F.HI + (r0_ + (id >> 4)) * HGW + h_ * 128 + 8 * (id & 15)); } } while (0)
    for (int seg = F.vcu; seg < NSEG; seg += F.G) {
        const int h = (seg >> 3) & 3, unit0 = seg * 8;
        f32x4 lb; { const f32x4 t0 = *(const GAS f32x4*)(F.lbt + h * 128 + 4 * kq), t1 = *(const GAS f32x4*)(F.lbt + 512 + h * 128 + 4 * kq);
#pragma unroll
            for (int j = 0; j < 4; ++j) lb[j] = pg8::sigm(t0[j] - t1[j]); }
        f32x16 acc0, acc1; f32x4 dsum = (f32x4){0.f, 0.f, 0.f, 0.f};
#pragma unroll
        for (int r = 0; r < 16; ++r) { acc0[r] = 0.f; acc1[r] = 0.f; }
        HG_P1_LOAD(unit0);
        for (int cc = 0; cc < 8; ++cc) {
            f32x4 g[4], km[4];
#pragma unroll
            for (int i = 0; i < 4; ++i) g[i] = gl_of(unpack4(gx[i]), lb, km[i]);
#pragma unroll
            for (int j = 0; j < 2; ++j) *(LAS u32x4*)(imgV + A.VB + 8192 * j) = vv[j];
            asm volatile("" : "+v"(g[0]), "+v"(g[1]), "+v"(g[2]), "+v"(g[3]), "+v"(km[0]), "+v"(km[1]), "+v"(km[2]), "+v"(km[3]) :: "memory");
            __builtin_amdgcn_sched_barrier(0); { const int nu = cc < 7 ? unit0 + cc + 1 : unit0 + cc; HG_P1_LOAD(nu); } __builtin_amdgcn_sched_barrier(0);
            f32x4 rs[4]; rs[3] = (f32x4){0.f, 0.f, 0.f, 0.f}; rs[2] = g[3]; rs[1] = g[3] + g[2]; rs[0] = rs[1] + g[1];
            const f32x4 tot = rs[0] + g[0];
            const f32x4 incl = scan16(tot, lane), all = bcast4(incl, 60 + (lane & 3)), suf = all - incl;
#pragma unroll
            for (int i = 0; i < 4; ++i) { const f32x4 kh = km[i] * vexp2(suf + rs[i]);
                *(LAS u32x2*)(imgK + (A.W0 ^ (64 * i)) + 256 * i) = pack4(kh[0], kh[1], kh[2], kh[3]); }
            if (tq == 0) { *(LAS f32x4*)(DLS + 4 * kq) = all; dsum += all; }
            asm volatile("s_waitcnt lgkmcnt(0)" ::: "memory"); __builtin_amdgcn_s_barrier(); asm volatile("" ::: "memory");
            { const float d0 = __builtin_amdgcn_exp2f(DLS[64 * kp + r32]), d1 = __builtin_amdgcn_exp2f(DLS[64 * kp + 32 + r32]);
#pragma unroll
              for (int r = 0; r < 16; ++r) { acc0[r] *= d0; acc1[r] *= d1; } }
#pragma unroll
            for (int ks = 0; ks < 4; ++ks) {
                const bf16x8 af = trf(imgV + 4096 * ks, tv1, tv2);
                acc0 = HG_MFMA(af, trf(imgK + 4096 * ks, ta1, ta2), acc0);
                acc1 = HG_MFMA(af, trf(imgK + 4096 * ks, tb1, tb2), acc1);
            }
            asm volatile("s_waitcnt lgkmcnt(0)" ::: "memory"); __builtin_amdgcn_s_barrier(); asm volatile("" ::: "memory");
        }
        bf16* lp = L + (size_t)seg * 16384 + 32 * vb + 4 * hi;
#pragma unroll
        for (int gq = 0; gq < 4; ++gq) {
            *(GAS u32x2*)(lp + (size_t)(64 * kp + r32) * 128 + 8 * gq) = pack4(acc0[4 * gq], acc0[4 * gq + 1], acc0[4 * gq + 2], acc0[4 * gq + 3]);
            *(GAS u32x2*)(lp + (size_t)(64 * kp + 32 + r32) * 128 + 8 * gq) = pack4(acc1[4 * gq], acc1[4 * gq + 1], acc1[4 * gq + 2], acc1[4 * gq + 3]); }
        if (tq == 0) *(GAS f32x4*)(Dl + (size_t)seg * 128 + 4 * kq) = dsum;
    }
#undef HG_P1_LOAD
}
__device__ __forceinline__ void pass3(Frame& F, const bf16* Lseg, const float* Dseg) {
    const int tid = F.tid, lane = F.lane, kq = 4 * F.wave + (lane & 3), tq = lane >> 2, r32 = lane & 31, hi = lane >> 5;
    LAS unsigned char* imgQT = F.lds; LAS unsigned char* imgKT = F.lds + 16384; LAS unsigned char* imgQH = F.lds + 32768; LAS unsigned char* imgV = F.lds + 49152; LAS unsigned char* imgS = F.lds + 65536;
    LAS unsigned char* imgKH = F.lds + 98304; LAS float* RSS = (LAS float*)(F.lds + 122880); LAS float* DLS = (LAS float*)(F.lds + 123904);
    const int tb = F.wave >> 2, vb = F.wave & 3, kp = F.wave >> 2;
    const HgAddr A = hg_addr(tid, lane, F.wave);
    const int tv1 = A.TB1 ^ (64 * vb), tv2 = A.TB2 ^ (64 * vb), ta1 = A.TB1 ^ (128 * kp), ta2 = A.TB2 ^ (128 * kp), tb1 = A.TB1 ^ (128 * kp + 64), tb2 = A.TB2 ^ (128 * kp + 64), pv1 = A.PB1 ^ (64 * vb), pv2 = A.PB2 ^ (64 * vb);
    u32x2 gx[4]; u32x2 qw[4]; u32x4 vv[2];
#define HG_P3_LOAD(UNIT) do { const int bh_ = (UNIT) >> 6, c_ = (UNIT) & 63, b_ = bh_ >> 2, h_ = bh_ & 3; const size_t r0_ = (size_t)b_ * SEQ + c_ * 64; \
        _Pragma("unroll") for (int i = 0; i < 4; ++i) { gx[i] = *(const GAS u32x2*)((const bf16*)F.LOGF + (r0_ + 4 * tq + i) * HGW + h_ * 128 + 4 * kq); qw[i] = *(const GAS u32x2*)(F.HQ + (r0_ + 4 * tq + i) * HGW + h_ * 128 + 4 * kq); } \
        _Pragma("unroll") for (int j = 0; j < 2; ++j) { const int id = tid + 512 * j; vv[j] = *(const GAS u32x4*)(F.HI + (r0_ + (id >> 4)) * HGW + h_ * 128 + 8 * (id & 15)); } } while (0)
    for (int seg = F.vcu; seg < NSEG; seg += F.G) {
        const int bh = seg >> 3, sj = seg & 7, b = bh >> 2, h = bh & 3, unit0 = seg * 8;
        HG_P3_LOAD(unit0);
        f32x4 lb; { const f32x4 t0 = *(const GAS f32x4*)(F.lbt + h * 128 + 4 * kq), t1 = *(const GAS f32x4*)(F.lbt + 512 + h * 128 + 4 * kq);
#pragma unroll
            for (int j = 0; j < 4; ++j) lb[j] = pg8::sigm(t0[j] - t1[j]); }
        f32x16 acc0, acc1;
#pragma unroll
        for (int r = 0; r < 16; ++r) { acc0[r] = 0.f; acc1[r] = 0.f; }
        if (sj > 0) {
            float d0v[7], d1v[7]; u32x2 l0v[7][4], l1v[7][4];
#pragma unroll
            for (int i = 0; i < 7; ++i) { const int sg = bh * 8 + (i < sj ? i : sj - 1);
                d0v[i] = Dseg[(size_t)sg * 128 + 64 * kp + r32]; d1v[i] = Dseg[(size_t)sg * 128 + 64 * kp + 32 + r32];
                const bf16* lp = Lseg + (size_t)sg * 16384 + 32 * vb + 4 * hi;
#pragma unroll
                for (int gq = 0; gq < 4; ++gq) { l0v[i][gq] = *(const GAS u32x2*)(lp + (size_t)(64 * kp + r32) * 128 + 8 * gq); l1v[i][gq] = *(const GAS u32x2*)(lp + (size_t)(64 * kp + 32 + r32) * 128 + 8 * gq); } }
#pragma unroll
            for (int i = 0; i < 7; ++i) { const bool on = i < sj; const float d0 = on ? __builtin_amdgcn_exp2f(d0v[i]) : 1.0f, d1 = on ? __builtin_amdgcn_exp2f(d1v[i]) : 1.0f;
#pragma unroll
                for (int gq = 0; gq < 4; ++gq) { const f32x4 l0 = unpack4(l0v[i][gq]), l1 = unpack4(l1v[i][gq]);
#pragma unroll
                    for (int j = 0; j < 4; ++j) { acc0[4 * gq + j] = acc0[4 * gq + j] * d0 + (on ? l0[j] : 0.f); acc1[4 * gq + j] = acc1[4 * gq + j] * d1 + (on ? l1[j] : 0.f); } } }
        }
        for (int cc = 0; cc < 8; ++cc) {
            const int c = sj * 8 + cc; const size_t row0 = (size_t)b * SEQ + c * 64;
            const size_t orow = row0 + 32 * tb + r32;
            u32x2 gtw[4]; f32x4 gnv[4];
#pragma unroll
            for (int gq = 0; gq < 4; ++gq) { gtw[gq] = *(const GAS u32x2*)(F.HGG + orow * HGW + h * 128 + 32 * vb + 8 * gq + 4 * hi); gnv[gq] = *(const GAS f32x4*)(F.hgn + 32 * vb + 8 * gq + 4 * hi); }
            f32x4 g[4], km[4]; f32x4 qv[4];
#pragma unroll
            for (int i = 0; i < 4; ++i) { g[i] = gl_of(unpack4(gx[i]), lb, km[i]); const f32x4 qr = unpack4(qw[i]); qv[i] = qr * vsigm(qr); }
#pragma unroll
            for (int j = 0; j < 2; ++j) *(LAS u32x4*)(imgV + A.VB + 8192 * j) = vv[j];
#pragma unroll
            for (int gq = 0; gq < 4; ++gq) { const int so = 16384 * kp + A.SB + 16 * (gq ^ A.SL);
                *(LAS u32x2*)(imgS + so) = pack4(acc0[4 * gq], acc0[4 * gq + 1], acc0[4 * gq + 2], acc0[4 * gq + 3]);
                *(LAS u32x2*)(imgS + so + 8192) = pack4(acc1[4 * gq], acc1[4 * gq + 1], acc1[4 * gq + 2], acc1[4 * gq + 3]); }
            asm volatile("" : "+v"(g[0]), "+v"(g[1]), "+v"(g[2]), "+v"(g[3]), "+v"(qv[0]), "+v"(qv[1]), "+v"(qv[2]), "+v"(qv[3]), "+v"(km[0]), "+v"(km[1]), "+v"(km[2]), "+v"(km[3]) :: "memory");
            __builtin_amdgcn_sched_barrier(0); { const int nu = cc < 7 ? unit0 + cc + 1 : unit0 + cc; HG_P3_LOAD(nu); } __builtin_amdgcn_sched_barrier(0);
            const f32x4 tot = (g[0] + g[1]) + (g[2] + g[3]), incl = scan16(tot, lane), all = bcast4(incl, 60 + (lane & 3)), ref = bcast4(incl, 28 + (lane & 3));
            f32x4 pre = incl - tot;
            const f32x4 c1 = vexp2(ref), c2 = vexp2(all - ref);
#pragma unroll
            for (int i = 0; i < 4; ++i) { pre += g[i];
                const f32x4 dq = pre - ref, qt = qv[i] * vexp2(dq), kt = km[i] * vexp2(-dq), qh = qt * c1, kh = kt * c2;
                const int o = (A.W0 ^ (64 * i)) + 256 * i;
                *(LAS u32x2*)(imgQT + o) = pack4(qt[0], qt[1], qt[2], qt[3]); *(LAS u32x2*)(imgKT + o) = pack4(kt[0], kt[1], kt[2], kt[3]); *(LAS u32x2*)(imgQH + o) = pack4(qh[0], qh[1], qh[2], qh[3]);
                *(LAS u32x2*)(imgKH + o) = pack4(kh[0], kh[1], kh[2], kh[3]); }
            if (tq == 0) *(LAS f32x4*)(DLS + 4 * kq) = all;
            asm volatile("s_waitcnt lgkmcnt(0)" ::: "memory"); __builtin_amdgcn_s_barrier(); asm volatile("" ::: "memory");
            int X[8];
#pragma unroll
            for (int ks = 0; ks < 8; ++ks) X[ks] = A.RB ^ (32 * ks);
            f32x16 o;
#pragma unroll
            for (int r = 0; r < 16; ++r) o[r] = 0.f;
#pragma unroll
            for (int k4 = 0; k4 < 8; k4 += 4) { bf16x8 sa[4], qb[4];
#pragma unroll
              for (int ks = 0; ks < 4; ++ks) { sa[ks] = trf(imgS + 4096 * (k4 + ks), tv1, tv2); qb[ks] = *(const LAS bf16x8*)(imgQH + 8192 * tb + X[k4 + ks]); }
#pragma unroll
              for (int ks = 0; ks < 4; ++ks) o = HG_MFMA(sa[ks], qb[ks], o); }
#pragma unroll
            for (int sb = 0; sb < 2; ++sb) {
                if (sb <= tb) {
                    f32x16 at;
#pragma unroll
                    for (int r = 0; r < 16; ++r) at[r] = 0.f;
#pragma unroll
                    for (int k4 = 0; k4 < 8; k4 += 4) { bf16x8 ka[4], qa[4];
#pragma unroll
                      for (int ks = 0; ks < 4; ++ks) { ka[ks] = *(const LAS bf16x8*)(imgKT + 8192 * sb + X[k4 + ks]); qa[ks] = *(const LAS bf16x8*)(imgQT + 8192 * tb + X[k4 + ks]); }
#pragma unroll
                      for (int ks = 0; ks < 4; ++ks) at = HG_MFMA(ka[ks], qa[ks], at); }
                    if (sb == tb) {
#pragma unroll
                        for (int r = 0; r < 16; ++r) if (crow(r, hi) > r32) at[r] = 0.f; }
#pragma unroll
                    for (int st = 0; st < 2; ++st) o = HG_MFMA(trf(imgV + 8192 * sb + 4096 * st, pv1, pv2), pack_step(at, st), o);
                }
            }
            { const float d0 = __builtin_amdgcn_exp2f(DLS[64 * kp + r32]), d1 = __builtin_amdgcn_exp2f(DLS[64 * kp + 32 + r32]);
#pragma unroll
              for (int r = 0; r < 16; ++r) { acc0[r] *= d0; acc1[r] *= d1; } }
#pragma unroll
            for (int ks = 0; ks < 4; ++ks) {
                const bf16x8 af = trf(imgV + 4096 * ks, tv1, tv2);
                acc0 = HG_MFMA(af, trf(imgKH + 4096 * ks, ta1, ta2), acc0);
                acc1 = HG_MFMA(af, trf(imgKH + 4096 * ks, tb1, tb2), acc1);
            }
            float ss = 0.f;
#pragma unroll
            for (int r = 0; r < 16; ++r) ss += o[r] * o[r];
            ss += __shfl_xor(ss, 32);
            if (hi == 0) RSS[(32 * tb + r32) * 4 + vb] = ss;
            asm volatile("s_waitcnt lgkmcnt(0)" ::: "memory"); __builtin_amdgcn_s_barrier(); asm volatile("" ::: "memory");
            const f32x4 pr = *(const LAS f32x4*)(RSS + (32 * tb + r32) * 4);
            const float rn = 1.0f / sqrtf(((pr[0] + pr[1]) + (pr[2] + pr[3])) * (1.0f / 128.0f) + EPS);
#pragma unroll
            for (int gq = 0; gq < 4; ++gq) { const int v = 32 * vb + 8 * gq + 4 * hi;
                const f32x4 gr = unpack4(gtw[gq]), sc = (gnv[gq] * rn) * (gr * vsigm(gr));
                *(GAS u32x2*)(F.XN + orow * D + 512 + h * 128 + v) = pack4(o[4 * gq] * sc[0], o[4 * gq + 1] * sc[1], o[4 * gq + 2] * sc[2], o[4 * gq + 3] * sc[3]); }
            asm volatile("s_waitcnt lgkmcnt(0)" ::: "memory"); __builtin_amdgcn_s_barrier(); asm volatile("" ::: "memory");
        }
    }
#undef HG_P3_LOAD
}
#undef HG_MFMA
}

struct Args { const float* in[13]; float* out; unsigned char* ws; int ph_lo, ph_hi; };
__global__ void __launch_bounds__(NWAVES * 64, 2) skel_fwd(Args args) {
    extern __shared__ __attribute__((aligned(16))) unsigned char lds[];
    Frame F;
    F.lds = (LAS unsigned char*)lds; F.MISC = (volatile LAS unsigned*)(F.lds + MISC_OFF);
    F.tid = threadIdx.x; F.lane = F.tid & 63; F.wave = __builtin_amdgcn_readfirstlane(F.tid >> 6);
    F.G = gridDim.x; { const int bx = blockIdx.x; F.vcu = (F.G % 8 == 0) ? (bx % 8) * (F.G / 8) + bx / 8 : bx; }
    unsigned char* ws = args.ws;
    F.ctl = (gu32*)(ws + WS_CTL);
    F.x = args.in[0]; F.n1g = args.in[1]; F.w_in = args.in[2]; F.gq = args.in[3]; F.gk = args.in[4]; F.lbt = args.in[5]; F.hgn = args.in[6]; F.w_br = args.in[7]; F.w_out = args.in[8];
    F.n2g = args.in[9]; F.w_gate = args.in[10]; F.w_up = args.in[11]; F.w_dn = args.in[12]; F.out = args.out;
    F.WIN = (bf16*)(ws + WS_WIN); F.WBR = (bf16*)(ws + WS_WBR); F.WOUT = (bf16*)(ws + WS_WOUT); F.WGU = (bf16*)(ws + WS_WGU); F.WDN = (bf16*)(ws + WS_WDN);
    F.XN = (bf16*)(ws + WS_XN); F.Q = (bf16*)(ws + WS_Q); F.K = (bf16*)(ws + WS_K); F.V = (bf16*)(ws + WS_V); F.HQ = (bf16*)(ws + WS_HQ); F.LOGF = (float*)(ws + WS_LOGF);
    F.HI = (bf16*)(ws + WS_HI); F.HGG = (bf16*)(ws + WS_HGG); F.GS = (bf16*)(ws + WS_GS); F.GH = (bf16*)(ws + WS_GH); F.MIXED = (bf16*)(ws + WS_MIXED); F.STASH = (bf16*)(ws + WS_STASH); F.ACT = (bf16*)(ws + WS_ACT);
    for (int u = F.tid; u < (LDS_BYTES - LDSCTL_OFF) / 4; u += NWAVES * 64) ((LAS unsigned*)(F.lds + LDSCTL_OFF))[u] = 0u;
    __syncthreads();
    XcdBarrier bar; bar.bar = (unsigned*)(F.ctl + CW_BAR); bar.x = 0; bar.st = nullptr;
    if (MK_ONE_LAUNCH) bar = xcd_barrier_post((unsigned*)(F.ctl + CW_BAR), F.MISC + 8);
    const int lo = args.ph_lo, hi = args.ph_hi;
#define IN(k) (lo <= (k) && (k) < hi)
#define SEAM(k) do { if (IN(k) && IN((k) + 1)) xcd_barrier(bar); } while (0)

    if (IN(0)) { p0_prologue<0>(F); } SEAM(0);
    if (IN(1)) {
        if (((int)blockIdx.x >> 3) & 1) { p0_prologue<1>(F); asm volatile("s_waitcnt vmcnt(0) lgkmcnt(0)" ::: "memory"); } __syncthreads();
        pg8::Gemm g{F.XN, F.WIN, M, NIN, D, D, D}; pg8::StaticOrder S; S.init(M, NIN, F.G, (int)blockIdx.x);
        pg8::EpiProj E{F.Q, F.K, F.V, F.HQ, F.HI, F.HGG, F.GS, F.GH, F.LOGF, F.gq, F.gk, F.lbt, QSCALE, EPS};
        pg8::gemm_phase<pg8::EpiProj, pg8::StaticOrder, true, true>(F.lds + RING_OFF, g, S, E);
    } SEAM(1);
    bf16* HL = (bf16*)F.out; float* HDl = (float*)((unsigned char*)F.out + 64 * MiB);
    if (IN(2)) { hg::pass1(F, HL, HDl); __syncthreads(); sba::attn_phase(F); } SEAM(2);
    if (IN(3)) { hg::pass3(F, HL, HDl); } SEAM(3);
    if (IN(4)) {
        pg8::Gemm g{F.XN, F.WBR, M, D, D, D, D}; pg8::StaticOrder S; S.init(M, D, F.G, (int)blockIdx.x);
        pg8::EpiGateK E{(const unsigned char*)F.GS, (const unsigned char*)F.GH, F.MIXED};
        pg8::gemm_phase<pg8::EpiGateK, pg8::StaticOrder, true, true>(F.lds + RING_OFF, g, S, E);
    } SEAM(4);
    float* rowss = (float*)(ws + WS_CTL + 524288);
    if (IN(5)) {
        pg8::Gemm g{F.MIXED, F.WOUT, M, D, D, D, D}; pg8::StaticOrder S; S.init(M, D, F.G, (int)blockIdx.x);
        pg8::EpiResSq E{F.x, F.XN, rowss};
        pg8::gemm_phase<pg8::EpiResSq, pg8::StaticOrder, true, true>(F.lds + RING_OFF, g, S, E);
    } SEAM(5);
    if (IN(6)) {
        pg8::Gemm g{F.XN, F.WGU, M, NIN, D, D, D}; pg8::StaticOrder S; S.init(M, NIN, F.G, (int)blockIdx.x);
        pg8::EpiSwiglu E{F.ACT, FFN, rowss, EPS};
        pg8::gemm_phase<pg8::EpiSwiglu, pg8::StaticOrder, true, true>(F.lds + RING_OFF, g, S, E);
    } SEAM(6);
    if (IN(7)) {
        pg8::Gemm g{F.ACT, F.WDN, M, D, FFN, FFN, FFN}; pg8::StaticOrder S; S.init(M, D, F.G, (int)blockIdx.x);
        pg8::EpiResHn E{F.XN, F.out};
        pg8::gemm_phase<pg8::EpiResHn, pg8::StaticOrder, true, true>(F.lds + RING_OFF, g, S, E);
    }
#undef IN
#undef SEAM
}

extern "C" void kernel_launch(void* const* d_in, const int* in_sizes, int n_in, void* d_out, int out_size, void* d_ws, size_t ws_size, hipStream_t stream) {
    static int grid = 0;
    if (grid == 0) {
        if (n_in != 13 || in_sizes[0] != M * D || out_size != M * D || ws_size < WS_END) { fprintf(stderr, "kernel_launch: unexpected shapes / workspace (n_in %d, ws %zu); nothing launched\n", n_in, ws_size); grid = -1; return; }
        int dev = 0, cus = 0;
        if (hipGetDevice(&dev) != hipSuccess || hipDeviceGetAttribute(&cus, hipDeviceAttributeMultiprocessorCount, dev) != hipSuccess) { grid = -1; return; }
        if (hipFuncSetAttribute((const void*)skel_fwd, hipFuncAttributeMaxDynamicSharedMemorySize, LDS_BYTES) != hipSuccess) { grid = -1; return; }
        int per_cu = 0;
        if (hipOccupancyMaxActiveBlocksPerMultiprocessor(&per_cu, (const void*)skel_fwd, NWAVES * 64, LDS_BYTES) != hipSuccess || per_cu < 1) { fprintf(stderr, "kernel_launch: occupancy query says %d\n", per_cu); }
        (void)hipGetLastError();
        grid = cus;
    }
    if (grid < 0) return;
    (void)hipMemsetAsync((char*)d_ws + WS_CTL, 0, CTL_ZERO_BYTES, stream);
    Args a{};
    for (int i = 0; i < 13; ++i) a.in[i] = (const float*)d_in[i];
    a.out = (float*)d_out; a.ws = (unsigned char*)d_ws;
    if (MK_ONE_LAUNCH) { a.ph_lo = 0; a.ph_hi = N_PHASES; hipLaunchKernelGGL(skel_fwd, dim3(grid), dim3(NWAVES * 64), LDS_BYTES, stream, a); }
    else for (int p = 0; p < N_PHASES; ++p) { a.ph_lo = p; a.ph_hi = p + 1; hipLaunchKernelGGL(skel_fwd, dim3(grid), dim3(NWAVES * 64), LDS_BYTES, stream, a); }
}
```

```cpp
#include <hip/hip_runtime.h>
#include <cstdio>
#include <cstdint>
namespace pg8 {
#define PG8_LAS __attribute__((address_space(3)))
typedef unsigned short bf16_t;
typedef short bf16x8 __attribute__((ext_vector_type(8)));
typedef float f32x4 __attribute__((ext_vector_type(4)));
typedef unsigned u32x4 __attribute__((ext_vector_type(4)));
constexpr int BM = 256, BK = 64, HALF = 128, HTB = HALF * BK * 2  , STAGE_BYTES = 8 * HTB, NXCD = 8, WGM = 4;

__host__ __device__ __forceinline__ int lds_byte(int r, int c) { const int st = (r >> 4) * 2 + (c >> 5), rr = r & 15, cc = c & 31, ob = rr * 64 + cc * 2; return st * 1024 + (ob ^ (((ob >> 9) & 1) << 5)); }
__host__ __device__ __forceinline__ void stage_rc(int b, int& R, int& C) { const int st = b / 1024, sb = b % 1024, swz = sb ^ (((sb >> 9) & 1) << 5); R = (st >> 1) * 16 + swz / 64; C = (st & 1) * 32 + (swz % 64) / 2; }
__host__ __device__ __forceinline__ int perm32(int rho) { const int n = rho >> 4, i = rho & 15; return 8 * (i >> 2) + 4 * n + (i & 3); }

struct Unit { int pm, pn; };
struct Gemm { const bf16_t* A; const bf16_t* Bt; int M, N, K, lda, ldb; };

struct StaticOrder {
    int nM, nN, nwg, G, c;
    __host__ __device__ void init(int M, int N, int G_, int c_) { nM = M / BM; nN = N / BM; nwg = nM * nN; G = G_; c = c_; }
    __host__ __device__ bool next(int i, Unit& u) const {
        const long L = (long)i * G + c; if (L >= nwg) return false;
        int wgid = (int)L; { const int q = nwg / NXCD, r = nwg % NXCD, xcd = wgid % NXCD, off = wgid / NXCD; wgid = (xcd < r ? xcd * (q + 1) : r * (q + 1) + (xcd - r) * q) + off; }
        const int nig = WGM * nN, gid = wgid / nig, fm = gid * WGM, gsz = (nM - fm) < WGM ? (nM - fm) : WGM;
        u.pm = fm + ((wgid % nig) % gsz); u.pn = (wgid % nig) / gsz; return true;
    }
    __device__ __forceinline__ void a_ready(const Unit&) const {}
    __device__ __forceinline__ void done(const Unit&) const {}
};

typedef float f32x2_t __attribute__((ext_vector_type(2))); typedef __bf16 bf16x2_t __attribute__((ext_vector_type(2)));
__device__ __forceinline__ unsigned cvt_pk_bf16(float lo, float hi) { const f32x2_t v = {lo, hi}; const bf16x2_t b = __builtin_convertvector(v, bf16x2_t); return __builtin_bit_cast(unsigned, b); }
typedef unsigned u32x2 __attribute__((ext_vector_type(2)));
__device__ __forceinline__ float ex2(float x) { return __builtin_amdgcn_exp2f(x); }
__device__ __forceinline__ float sigm(float x) { return __builtin_amdgcn_rcpf(1.0f + ex2(x * -1.4426950408889634f)); }
__device__ __forceinline__ u32x4 pack8(const f32x4 a, const f32x4 b) { u32x4 w; w.x = cvt_pk_bf16(a[0], a[1]); w.y = cvt_pk_bf16(a[2], a[3]); w.z = cvt_pk_bf16(b[0], b[1]); w.w = cvt_pk_bf16(b[2], b[3]); return w; }
__device__ __forceinline__ f32x4 bf4_lo(const u32x4 w) { return (f32x4){__uint_as_float(w.x << 16), __uint_as_float(w.x & 0xffff0000u), __uint_as_float(w.y << 16), __uint_as_float(w.y & 0xffff0000u)}; }
__device__ __forceinline__ f32x4 bf4_hi(const u32x4 w) { return (f32x4){__uint_as_float(w.z << 16), __uint_as_float(w.z & 0xffff0000u), __uint_as_float(w.w << 16), __uint_as_float(w.w & 0xffff0000u)}; }

__device__ __forceinline__ u32x2 pack8_fp8(const f32x4 a, const f32x4 b) { u32x2 w; int t = __builtin_amdgcn_cvt_pk_fp8_f32(a[0], a[1], 0, false); t = __builtin_amdgcn_cvt_pk_fp8_f32(a[2], a[3], t, true); w.x = (unsigned)t;
    t = __builtin_amdgcn_cvt_pk_fp8_f32(b[0], b[1], 0, false); t = __builtin_amdgcn_cvt_pk_fp8_f32(b[2], b[3], t, true); w.y = (unsigned)t; return w; }
__device__ __forceinline__ f32x4 fp8x4(unsigned w) { typedef float f2_ __attribute__((ext_vector_type(2))); const f2_ lo = __builtin_amdgcn_cvt_pk_f32_fp8((int)w, false), hi = __builtin_amdgcn_cvt_pk_f32_fp8((int)w, true); return (f32x4){lo.x, lo.y, hi.x, hi.y}; }
struct EpiProj {
    static constexpr bool PERM = true, AFTER_DRAIN = false, MID = false;
    bf16_t *Q, *Kq, *V, *HQ, *HI, *HGG, *GS, *GH; float* LOGF; const float *gq, *gk, *lbt; float qscale, eps;
    __device__ __forceinline__ void operator()(const f32x4 (&acc)[2][2][4][2], const Unit& u, int wr, int wc, int fr, int fq) const {
        const int pn = u.pn, row0 = u.pm * BM + wr * 64 + fr;
        if (pn < 4) {
            const bool isq = pn < 2; const int head = 4 * (pn & 1) + wc;
            bf16_t* base = (isq ? Q : Kq) + head * 64 + 8 * fq; const float* g = (isq ? gq : gk) + 8 * fq; const float sc = isq ? qscale : 1.0f;
            f32x4 gv[2][2];
#pragma unroll
            for (int bj = 0; bj < 2; ++bj)
#pragma unroll
                for (int n = 0; n < 2; ++n) gv[bj][n] = *(const f32x4*)(g + 32 * bj + 4 * n) * sc;
#pragma unroll
            for (int ai = 0; ai < 2; ++ai)
#pragma unroll
                for (int m = 0; m < 4; ++m) {
                    float ss = 0.f;
#pragma unroll
                    for (int bj = 0; bj < 2; ++bj)
#pragma unroll
                        for (int n = 0; n < 2; ++n) { const f32x4 x = acc[ai][bj][m][n]; ss += (x[0] * x[0] + x[1] * x[1]) + (x[2] * x[2] + x[3] * x[3]); }
                    ss += __shfl_xor(ss, 16); ss += __shfl_xor(ss, 32);
                    const float rs = 1.0f / sqrtf(ss * (1.0f / 64.0f) + eps);
                    bf16_t* rowp = base + (size_t)(row0 + ai * HALF + m * 16) * 512;
#pragma unroll
                    for (int bj = 0; bj < 2; ++bj) *(u32x4*)(rowp + 32 * bj) = pack8(acc[ai][bj][m][0] * rs * gv[bj][0], acc[ai][bj][m][1] * rs * gv[bj][1]);
                }
        } else if (pn == 8 || pn == 9) {
            store_tile<0>(acc, (bf16_t*)LOGF, 512, row0, 256 * (pn - 8) + 32 * wc + 8 * fq);
        } else {
            const int cw = 32 * wc + 8 * fq;
            if (pn < 6) store_tile<0>(acc, V, 512, row0, 256 * (pn - 4) + cw);
            else if (pn < 8) store_tile<0>(acc, HQ, 512, row0, 256 * (pn - 6) + cw);
            else if (pn < 12) store_tile<0>(acc, HI, 512, row0, 256 * (pn - 10) + cw);
            else if (pn < 14) store_tile<0>(acc, HGG, 512, row0, 256 * (pn - 12) + cw);
            else if (pn < 18) store_tile8(acc, (unsigned char*)GS, row0, 256 * (pn - 14) + cw);
            else store_tile8(acc, (unsigned char*)GH, row0, 256 * (pn - 18) + cw);
        }
    }
    static __device__ __forceinline__ void store_tile8(const f32x4 (&acc)[2][2][4][2], unsigned char* ob, int row0, int cb) {
#pragma unroll
        for (int ai = 0; ai < 2; ++ai)
#pragma unroll
            for (int m = 0; m < 4; ++m) { unsigned char* rowp = ob + (size_t)(row0 + ai * HALF + m * 16) * 1024 + cb;
#pragma unroll
                for (int bj = 0; bj < 2; ++bj) *(u32x2*)(rowp + 128 * bj) = pack8_fp8(acc[ai][bj][m][0], acc[ai][bj][m][1]); }
    }
    template <int MODE  > static __device__ __forceinline__ void store_tile(const f32x4 (&acc)[2][2][4][2], bf16_t* ob, int ld, int row0, int cb) {
#pragma unroll
        for (int ai = 0; ai < 2; ++ai)
#pragma unroll
            for (int m = 0; m < 4; ++m) { bf16_t* rowp = ob + (size_t)(row0 + ai * HALF + m * 16) * ld + cb;
#pragma unroll
                for (int bj = 0; bj < 2; ++bj) { f32x4 v[2];
#pragma unroll
                    for (int n = 0; n < 2; ++n) { const f32x4 x = acc[ai][bj][m][n];
                        if (MODE == 0) v[n] = x;
                        else {
#pragma unroll
                            for (int j = 0; j < 4; ++j) { const float s = sigm(x[j]); v[n][j] = MODE == 1 ? x[j] * s : s; } } }
                    *(u32x4*)(rowp + 128 * bj) = pack8(v[0], v[1]); } }
    }
};
struct EpiGateK {
    static constexpr bool PERM = true, AFTER_DRAIN = false, MID = true;
    const unsigned char* gs; const unsigned char* gh; bf16_t* out;
    __device__ __forceinline__ void mid(f32x4 (&acc)[2][2][4][2], const Unit& u, int wr, int wc, int fr_, int fq_) const {
        int fr = fr_, fq = fq_; asm volatile("" : "+v"(fr), "+v"(fq));
        const int row0 = u.pm * BM + wr * 64 + fr, col0 = u.pn * BM + wc * 32 + 8 * fq;
#pragma unroll
        for (int ai = 0; ai < 2; ++ai) {
            u32x2 a[4][2], b[4][2];
#pragma unroll
            for (int m = 0; m < 4; ++m)
#pragma unroll
                for (int bj = 0; bj < 2; ++bj) { const size_t off = (size_t)(row0 + ai * HALF + m * 16) * 1024 + col0 + bj * HALF; a[m][bj] = *(const u32x2*)(gs + off); b[m][bj] = *(const u32x2*)(gh + off); }
            asm volatile("" ::: "memory");
#pragma unroll
            for (int m = 0; m < 4; ++m)
#pragma unroll
                for (int bj = 0; bj < 2; ++bj) {
                    const f32x4 es0 = fp8x4(a[m][bj].x) * -1.4426950408889634f, es1 = fp8x4(a[m][bj].y) * -1.4426950408889634f, eh0 = fp8x4(b[m][bj].x) * -1.4426950408889634f, eh1 = fp8x4(b[m][bj].y) * -1.4426950408889634f;
                    f32x4 n0, n1, d0, d1;
#pragma unroll
                    for (int j = 0; j < 4; ++j) { n0[j] = ex2(eh0[j]); n1[j] = ex2(eh1[j]); d0[j] = ex2(es0[j]); d1[j] = ex2(es1[j]); }
                    n0 = n0 + 1.0f; n1 = n1 + 1.0f; d0 = d0 + 1.0f; d1 = d1 + 1.0f;
#pragma unroll
                    for (int j = 0; j < 4; ++j) { d0[j] = __builtin_amdgcn_rcpf(d0[j]); d1[j] = __builtin_amdgcn_rcpf(d1[j]); }
                    acc[ai][bj][m][0] = acc[ai][bj][m][0] * (n0 * d0); acc[ai][bj][m][1] = acc[ai][bj][m][1] * (n1 * d1); }
            asm volatile("" ::: "memory");
        }
    }
    __device__ __forceinline__ void operator()(const f32x4 (&acc)[2][2][4][2], const Unit& u, int wr, int wc, int fr, int fq) const {
        const int row0 = u.pm * BM + wr * 64 + fr, col0 = u.pn * BM + wc * 32 + 8 * fq;
#pragma unroll
        for (int ai = 0; ai < 2; ++ai) {
            u32x2 b[4][2];
#pragma unroll
            for (int m = 0; m < 4; ++m)
#pragma unroll
                for (int bj = 0; bj < 2; ++bj) b[m][bj] = *(const u32x2*)(gh + (size_t)(row0 + ai * HALF + m * 16) * 1024 + col0 + bj * HALF);
            asm volatile("" ::: "memory");
#pragma unroll
            for (int m = 0; m < 4; ++m)
#pragma unroll
                for (int bj = 0; bj < 2; ++bj) { f32x4 g0 = fp8x4(b[m][bj].x), g1 = fp8x4(b[m][bj].y);
#pragma unroll
                    for (int j = 0; j < 4; ++j) { g0[j] = sigm(g0[j]); g1[j] = sigm(g1[j]); }
                    *(u32x4*)(out + (size_t)(row0 + ai * HALF + m * 16) * 1024 + col0 + bj * HALF) = pack8(acc[ai][bj][m][0] * g0, acc[ai][bj][m][1] * g1); }
            asm volatile("" ::: "memory");
        }
    }
};
struct EpiResHn {
    static constexpr bool PERM = false, AFTER_DRAIN = false, MID = false;
    const bf16_t* hn; float* out;
    __device__ __forceinline__ void operator()(const f32x4 (&acc)[2][2][4][2], const Unit& u, int wr, int wc, int fr, int fq) const {
        const int row0 = u.pm * BM + wr * 64 + fr, col0 = u.pn * BM + wc * 32 + 4 * fq;
#pragma unroll
        for (int ai = 0; ai < 2; ++ai) {
            u32x2 pre[4][2][2];
#pragma unroll
            for (int m = 0; m < 4; ++m) {
#pragma unroll
                for (int bj = 0; bj < 2; ++bj)
#pragma unroll
                    for (int n = 0; n < 2; ++n) pre[m][bj][n] = *(const u32x2*)(hn + (size_t)(row0 + ai * HALF + m * 16) * 1024 + col0 + bj * HALF + n * 16); }
            asm volatile("" ::: "memory");
#pragma unroll
            for (int m = 0; m < 4; ++m)
#pragma unroll
                for (int bj = 0; bj < 2; ++bj)
#pragma unroll
                    for (int n = 0; n < 2; ++n) { const u32x2 w = pre[m][bj][n];
                        const f32x4 h = (f32x4){__uint_as_float(w.x << 16), __uint_as_float(w.x & 0xffff0000u), __uint_as_float(w.y << 16), __uint_as_float(w.y & 0xffff0000u)};
                        *(f32x4*)(out + (size_t)(row0 + ai * HALF + m * 16) * 1024 + col0 + bj * HALF + n * 16) = h + acc[ai][bj][m][n]; }
            asm volatile("" ::: "memory");
        }
    }
};
struct EpiResSq {
    static constexpr bool PERM = false, AFTER_DRAIN = false, MID = false;
    const float* base; bf16_t* hb; float* rowss;
    __device__ __forceinline__ void operator()(const f32x4 (&acc)[2][2][4][2], const Unit& u, int wr, int wc, int fr, int fq) const {
        const int row0 = u.pm * BM + wr * 64 + fr, col0 = u.pn * BM + wc * 32 + 4 * fq;
#pragma unroll
        for (int ai = 0; ai < 2; ++ai) {
            f32x4 pre[4][2][2];
#pragma unroll
            for (int m = 0; m < 4; ++m)
#pragma unroll
                for (int bj = 0; bj < 2; ++bj)
#pragma unroll
                    for (int n = 0; n < 2; ++n) pre[m][bj][n] = *(const f32x4*)(base + (size_t)(row0 + ai * HALF + m * 16) * 1024 + col0 + bj * HALF + n * 16);
            asm volatile("" ::: "memory");
#pragma unroll
            for (int m = 0; m < 4; ++m) { float s = 0.f;
#pragma unroll
                for (int bj = 0; bj < 2; ++bj)
#pragma unroll
                    for (int n = 0; n < 2; ++n) { const f32x4 h = pre[m][bj][n] + acc[ai][bj][m][n]; s += (h[0] * h[0] + h[1] * h[1]) + (h[2] * h[2] + h[3] * h[3]);
                        u32x2 w; w.x = cvt_pk_bf16(h[0], h[1]); w.y = cvt_pk_bf16(h[2], h[3]); *(u32x2*)(hb + (size_t)(row0 + ai * HALF + m * 16) * 1024 + col0 + bj * HALF + n * 16) = w; }
                s += __shfl_xor(s, 16); s += __shfl_xor(s, 32);
                if (fq == 0) __hip_atomic_fetch_add(rowss + row0 + ai * HALF + m * 16, s, __ATOMIC_RELAXED, __HIP_MEMORY_SCOPE_AGENT); }
            asm volatile("" ::: "memory");
        }
    }
};
struct EpiSwiglu {
    static constexpr bool PERM = true, AFTER_DRAIN = false, MID = false;
    bf16_t* out; int ldc; const float* rowss; float eps;
    __device__ __forceinline__ void operator()(const f32x4 (&acc)[2][2][4][2], const Unit& u, int wr, int wc, int fr, int fq) const {
        const int row0 = u.pm * BM + wr * 64 + fr, col0 = u.pn * HALF + wc * 32 + 8 * fq;
        float rs[2][4];
#pragma unroll
        for (int ai = 0; ai < 2; ++ai)
#pragma unroll
            for (int m = 0; m < 4; ++m) rs[ai][m] = rowss[row0 + ai * HALF + m * 16];
#pragma unroll
        for (int ai = 0; ai < 2; ++ai)
#pragma unroll
            for (int m = 0; m < 4; ++m) { f32x4 v[2]; const float r = 1.0f / sqrtf(rs[ai][m] * (1.0f / 1024.0f) + eps), cr = -1.4426950408889634f * r, r2 = r * r;
#pragma unroll
                for (int n = 0; n < 2; ++n) {
                    const f32x4 g4 = acc[ai][0][m][n], u4 = acc[ai][1][m][n], t = g4 * cr;
                    f32x4 d; d[0] = ex2(t[0]); d[1] = ex2(t[1]); d[2] = ex2(t[2]); d[3] = ex2(t[3]); d = d + 1.0f;
                    f32x4 s; s[0] = __builtin_amdgcn_rcpf(d[0]); s[1] = __builtin_amdgcn_rcpf(d[1]); s[2] = __builtin_amdgcn_rcpf(d[2]); s[3] = __builtin_amdgcn_rcpf(d[3]);
                    v[n] = (g4 * u4) * (s * r2); }
                *(u32x4*)(out + (size_t)(row0 + ai * HALF + m * 16) * ldc + col0) = pack8(v[0], v[1]); }
    }
};
template <class Epi, class Sched, bool ALIGN_EPI = false, bool SP2 = false>
__device__ __forceinline__ void gemm_phase(PG8_LAS unsigned char* lds, const Gemm g, const Sched& S, const Epi& E) {
    const int tid = threadIdx.x, wid = __builtin_amdgcn_readfirstlane(tid >> 6), lane = tid & 63, wr = wid >> 2, wc = wid & 3, fr = lane & 15, fq = lane >> 4;
    const int K = g.K, nt = K / BK;
    unsigned voffA[2], voffB[2];
#pragma unroll
    for (int i = 0; i < 2; ++i) { int R, C; stage_rc(tid * 16 + i * 8192, R, C); const int Rb = Epi::PERM ? ((R & ~31) + perm32(R & 31)) : R;
        voffA[i] = (unsigned)(R * g.lda + C) * 2u; voffB[i] = (unsigned)(Rb * g.ldb + C) * 2u; }
    const size_t kstep = (size_t)(BK * 2);
    const size_t hstepA = (size_t)HALF * g.lda * 2, hstepB = (size_t)HALF * g.ldb * 2;
    const size_t tstepA = 2 * hstepA, tstepB = 2 * hstepB;
    const unsigned ldsw = (unsigned)wid * 1024u;
    const int aoff = lds_byte(wr * 64 + fr, fq * 8), boff = lds_byte(wc * 32 + fr, fq * 8);
#define PG8_SA(b, h) (((b) * 2 + (h)) * HTB)
#define PG8_SB(b, h) ((4 + (b) * 2 + (h)) * HTB)
#define PG8_STAGE(bufoff, gbase, voff) do { _Pragma("unroll") for (int _i = 0; _i < 2; ++_i) \
        __builtin_amdgcn_global_load_lds((const unsigned*)((const char*)(gbase) + (voff)[_i]), (PG8_LAS unsigned*)(lds + (bufoff) + ldsw + _i * 8192), 16, 0, 0); } while (0)
#define PG8_LDA(dst, b, h) do { _Pragma("unroll") for (int m = 0; m < 4; ++m) _Pragma("unroll") for (int k = 0; k < 2; ++k) dst[m][k] = *(const PG8_LAS bf16x8*)(lds + PG8_SA(b, h) + aoff + m * 2048 + k * 1024); } while (0)
#define PG8_LDB(dst, b, h) do { _Pragma("unroll") for (int n = 0; n < 2; ++n) _Pragma("unroll") for (int k = 0; k < 2; ++k) dst[n][k] = *(const PG8_LAS bf16x8*)(lds + PG8_SB(b, h) + boff + n * 2048 + k * 1024); } while (0)
#define PG8_MMA(ai, bj, At, Bt) do { __builtin_amdgcn_s_setprio(1); _Pragma("unroll") for (int m = 0; m < 4; ++m) _Pragma("unroll") for (int n = 0; n < 2; ++n) _Pragma("unroll") for (int k = 0; k < 2; ++k) \
        acc[ai][bj][m][n] = __builtin_amdgcn_mfma_f32_16x16x32_bf16(Bt[n][k], At[m][k], acc[ai][bj][m][n], 0, 0, 0); __builtin_amdgcn_s_setprio(0); } while (0)
#define PG8_WAIT_V(n) asm volatile("s_waitcnt vmcnt(" #n ")" ::: "memory")
#define PG8_WAIT_L(n) asm volatile("s_waitcnt lgkmcnt(" #n ")" ::: "memory")
#define PG8_BAR __builtin_amdgcn_s_barrier()
#define PG8_SCHED __builtin_amdgcn_sched_barrier(0)
    Unit cur, nxt; int ui = 0;
    if (!S.next(0, cur)) return;
    f32x4 acc[2][2][4][2];
#pragma unroll
    for (int a = 0; a < 2; ++a)
#pragma unroll
        for (int b = 0; b < 2; ++b)
#pragma unroll
            for (int m = 0; m < 4; ++m)
#pragma unroll
                for (int n = 0; n < 2; ++n) acc[a][b][m][n] = (f32x4){0.f, 0.f, 0.f, 0.f};
    bf16x8 At[4][2], B0[2][2], B1[2][2];
    const char* cA = (const char*)g.A + (size_t)cur.pm * tstepA; const char* cB = (const char*)g.Bt + (size_t)cur.pn * tstepB;
    S.a_ready(cur);
    if constexpr (SP2) {
        PG8_STAGE(PG8_SB(0, 0), cB, voffB); PG8_STAGE(PG8_SB(0, 1), cB + hstepB, voffB); PG8_STAGE(PG8_SA(0, 0), cA, voffA); PG8_STAGE(PG8_SA(0, 1), cA + hstepA, voffA);
        if (wr == 1) PG8_BAR;
        PG8_WAIT_V(2); PG8_BAR;
        PG8_STAGE(PG8_SB(1, 0), cB + kstep, voffB); PG8_STAGE(PG8_SA(1, 0), cA + kstep, voffA); PG8_STAGE(PG8_SB(1, 1), cB + hstepB + kstep, voffB);
        PG8_WAIT_V(6); PG8_BAR;
    } else {
        PG8_STAGE(PG8_SB(0, 0), cB, voffB); PG8_STAGE(PG8_SA(0, 0), cA, voffA); PG8_STAGE(PG8_SB(0, 1), cB + hstepB, voffB); PG8_STAGE(PG8_SA(0, 1), cA + hstepA, voffA);
        if (wr == 1) PG8_BAR;
        PG8_WAIT_V(4); PG8_BAR;
        PG8_STAGE(PG8_SB(1, 0), cB + kstep, voffB); PG8_STAGE(PG8_SA(1, 0), cA + kstep, voffA); PG8_STAGE(PG8_SB(1, 1), cB + hstepB + kstep, voffB);
        PG8_WAIT_V(6); PG8_BAR;
    }
    for (;;) {
        const bool has_next = S.next(ui + 1, nxt);
        const char* nA = has_next ? (const char*)g.A + (size_t)nxt.pm * tstepA : cA; const char* nB = has_next ? (const char*)g.Bt + (size_t)nxt.pn * tstepB : cB;
        for (int t = 0; t < nt; t += 2) {
            if constexpr (Epi::MID) { if (t == nt / 2) E.mid(acc, cur, wr, wc, fr, fq); }
            const bool last = (t == nt - 2);
            const char* a1 = cA + (size_t)(t + 1) * kstep;
            const char* a2 = last ? nA : cA + (size_t)(t + 2) * kstep; const char* b2 = last ? nB : cB + (size_t)(t + 2) * kstep;
            const char* a3 = a2 + kstep; const char* b3 = b2 + kstep;
            if (last && has_next) S.a_ready(nxt);
            if constexpr (SP2) {
            PG8_LDB(B0, 0, 0); PG8_LDB(B1, 0, 1); PG8_SCHED; PG8_LDA(At, 0, 0); PG8_STAGE(PG8_SA(1, 1), a1 + hstepA, voffA);
            PG8_WAIT_V(8); PG8_WAIT_L(0); PG8_BAR; PG8_MMA(0, 0, At, B0); PG8_MMA(0, 1, At, B1); PG8_BAR; PG8_SCHED;
            PG8_LDA(At, 0, 1); PG8_STAGE(PG8_SB(0, 0), b2, voffB); PG8_STAGE(PG8_SB(0, 1), b2 + hstepB, voffB); PG8_STAGE(PG8_SA(0, 0), a2, voffA);
            PG8_WAIT_V(8); PG8_WAIT_L(0); PG8_BAR; PG8_MMA(1, 0, At, B0); PG8_MMA(1, 1, At, B1); PG8_BAR; PG8_SCHED;
            PG8_LDB(B0, 1, 0); PG8_LDB(B1, 1, 1); PG8_SCHED; PG8_LDA(At, 1, 0); PG8_STAGE(PG8_SA(0, 1), a2 + hstepA, voffA);
            PG8_WAIT_V(8); PG8_WAIT_L(0); PG8_BAR; PG8_MMA(0, 0, At, B0); PG8_MMA(0, 1, At, B1); PG8_BAR; PG8_SCHED;
            PG8_LDA(At, 1, 1); PG8_STAGE(PG8_SB(1, 0), b3, voffB); PG8_STAGE(PG8_SB(1, 1), b3 + hstepB, voffB); PG8_STAGE(PG8_SA(1, 0), a3, voffA);
            PG8_WAIT_V(8); PG8_WAIT_L(0); PG8_BAR; PG8_MMA(1, 0, At, B0); PG8_MMA(1, 1, At, B1); PG8_BAR; PG8_SCHED;
            } else {
            PG8_LDB(B0, 0, 0); PG8_SCHED; PG8_LDA(At, 0, 0); PG8_STAGE(PG8_SA(1, 1), a1 + hstepA, voffA);
            PG8_WAIT_L(8); PG8_BAR; PG8_WAIT_L(0); PG8_MMA(0, 0, At, B0); PG8_BAR; PG8_SCHED;
            PG8_LDB(B1, 0, 1); PG8_STAGE(PG8_SB(0, 0), b2, voffB);
            PG8_BAR; PG8_WAIT_L(0); PG8_MMA(0, 1, At, B1); PG8_BAR;
            PG8_LDA(At, 0, 1); PG8_STAGE(PG8_SA(0, 0), a2, voffA);
            PG8_BAR; PG8_WAIT_L(0); PG8_MMA(1, 0, At, B0); PG8_BAR; PG8_SCHED;
            PG8_STAGE(PG8_SB(0, 1), b2 + hstepB, voffB);
            PG8_WAIT_V(6); PG8_BAR; PG8_MMA(1, 1, At, B1); PG8_BAR;
            PG8_LDB(B0, 1, 0); PG8_SCHED; PG8_LDA(At, 1, 0); PG8_STAGE(PG8_SA(0, 1), a2 + hstepA, voffA);
            PG8_WAIT_L(8); PG8_BAR; PG8_WAIT_L(0); PG8_MMA(0, 0, At, B0); PG8_BAR; PG8_SCHED;
            PG8_LDB(B1, 1, 1); PG8_STAGE(PG8_SB(1, 0), b3, voffB);
            PG8_BAR; PG8_WAIT_L(0); PG8_MMA(0, 1, At, B1); PG8_BAR;
            PG8_LDA(At, 1, 1); PG8_STAGE(PG8_SA(1, 0), a3, voffA);
            PG8_BAR; PG8_WAIT_L(0); PG8_MMA(1, 0, At, B0); PG8_BAR; PG8_SCHED;
            PG8_STAGE(PG8_SB(1, 1), b3 + hstepB, voffB);
            PG8_WAIT_V(6); PG8_BAR; PG8_MMA(1, 1, At, B1); PG8_BAR;
            }
        }
        if constexpr (ALIGN_EPI) { if (wr == 0) PG8_BAR; }
        if constexpr (!Epi::AFTER_DRAIN) { E(acc, cur, wr, wc, fr, fq); S.done(cur); }
        if (!has_next) break;
#pragma unroll
        for (int a = 0; a < 2; ++a)
#pragma unroll
            for (int b = 0; b < 2; ++b)
#pragma unroll
                for (int m = 0; m < 4; ++m)
#pragma unroll
                    for (int n = 0; n < 2; ++n) acc[a][b][m][n] = (f32x4){0.f, 0.f, 0.f, 0.f};
        cur = nxt; cA = nA; cB = nB; ++ui;
        if constexpr (ALIGN_EPI) { if (wr == 1) PG8_BAR; }
    }
    PG8_WAIT_V(0);
    if constexpr (!ALIGN_EPI) { if (wr == 0) PG8_BAR; }
    PG8_BAR;
    if constexpr (Epi::AFTER_DRAIN) { E.fused(acc, cur, wr, wc, fr, fq, lds, wid, lane); S.done(cur); }
#undef PG8_SA
#undef PG8_SB
#undef PG8_STAGE
#undef PG8_LDA
#undef PG8_LDB
#undef PG8_MMA
#undef PG8_WAIT_V
#undef PG8_WAIT_L
#undef PG8_BAR
#undef PG8_SCHED
}
}
constexpr int NWAVES = 8;
#ifndef MK_ONE_LAUNCH
#define MK_ONE_LAUNCH 1
#endif
constexpr int N_PHASES = 8;

constexpr int BATCH = 8, SEQ = 4096, D = 1024, M = BATCH * SEQ;
constexpr int SBH = 8, SBD = 64, SBW = 512, HGH = 4, HGD = 128, HGW = 512, NIN = 5632, FFN = 2816;
constexpr float EPS = 1e-6f;
constexpr float QSCALE = 0.125f * 1.4426950408889634f;

constexpr size_t MiB = 1u << 20;
constexpr size_t WS_CTL = 0, CTL_ZERO_BYTES = 1 * MiB;
constexpr size_t WS_WIN = 1 * MiB, WS_WBR = 12 * MiB, WS_WOUT = 14 * MiB, WS_WGU = 16 * MiB, WS_WDN = 27 * MiB;
constexpr size_t WS_XN = 33 * MiB;
constexpr size_t WS_Q = 97 * MiB, WS_K = 129 * MiB, WS_V = 161 * MiB, WS_HQ = 193 * MiB, WS_LOGF = 225 * MiB, WS_HI = 289 * MiB, WS_HGG = 321 * MiB, WS_GS = 353 * MiB, WS_GH = 417 * MiB;
constexpr size_t WS_MIXED = 97 * MiB, WS_STASH = 161 * MiB;
constexpr size_t WS_ACT = 225 * MiB;
constexpr size_t WS_END = 481 * MiB;
static_assert(WS_ACT + (size_t)M * FFN * 2 <= WS_GH + 64 * MiB && WS_WDN + (size_t)D * FFN * 2 <= WS_XN, "d_ws map");
constexpr int CW_TMO = 0, CW_CODE = 1, CW_BAR = 4096, CW_SEAM = 16384;

constexpr int RING_OFF = 0, RING_BYTES = 131072;
constexpr int LDSCTL_OFF = RING_BYTES, MISC_OFF = LDSCTL_OFF + 320;
constexpr int LDS_BYTES = 147456;
#define GAS __attribute__((address_space(1)))
#define LAS __attribute__((address_space(3)))
typedef unsigned short bf16;
typedef unsigned v4u __attribute__((ext_vector_type(4)));
typedef float f32x4 __attribute__((ext_vector_type(4)));
typedef short bf16x8 __attribute__((ext_vector_type(8)));
typedef GAS unsigned gu32;
typedef GAS unsigned long long gu64;
#define RLX_AGENT __ATOMIC_RELAXED, __HIP_MEMORY_SCOPE_AGENT
#define LDS_WAIT() asm volatile("s_waitcnt lgkmcnt(0)" ::: "memory")
#define VM_WAIT() asm volatile("s_waitcnt vmcnt(0)" ::: "memory")
__device__ __forceinline__ unsigned long long rt() { return __builtin_amdgcn_s_memrealtime(); }
__device__ __forceinline__ unsigned f2bf(float f) { unsigned u = __builtin_bit_cast(unsigned, f); return (u + 0x7fffu + ((u >> 16) & 1u)) >> 16; }
__device__ __forceinline__ unsigned pk2(float lo, float hi) { return f2bf(lo) | (f2bf(hi) << 16); }

#define XB_TMO      128
#define XB_XCNT(j)  (256  + 64 * (j))
#define XB_XSUB(j)  (1280 + 64 * (j))
#define XB_XGEN(j)  (2304 + 64 * (j))
#define XB_TOP      3328
#define XB_TOPGEN   3392
#define XCD_BAR_WORDS 3456
#define XB_SPIN_CAP (1u << 18)

__device__ __forceinline__ unsigned xb_ld(unsigned* p)              { return __hip_atomic_load(p, __ATOMIC_RELAXED, __HIP_MEMORY_SCOPE_AGENT); }
__device__ __forceinline__ unsigned xb_add(unsigned* p, unsigned v) { return __hip_atomic_fetch_add(p, v, __ATOMIC_RELAXED, __HIP_MEMORY_SCOPE_AGENT); }
__device__ __forceinline__ unsigned xb_xcc_id() { return (unsigned)__builtin_amdgcn_s_getreg((3 << 11) | 20) & 0xFu; }
#define XB_SPIN(cond, bar) do { unsigned _sp = 0; while (cond) { __builtin_amdgcn_s_sleep(1); \
    if ((++_sp & 255u) == 0u) { if (xb_ld(&(bar)[XB_TMO])) break; if (_sp > XB_SPIN_CAP) { atomicAdd(&(bar)[XB_TMO], 1u); break; } } } } while (0)

struct XcdBarrier {
    unsigned* bar; unsigned x;
    volatile LAS unsigned* st;
};

__device__ __forceinline__ XcdBarrier xcd_barrier_post(unsigned* bar, volatile LAS unsigned* st) {
    XcdBarrier b; b.bar = bar; b.x = xb_xcc_id(); b.st = st;
    if (threadIdx.x == 0) (void)xb_add(&bar[XB_XCNT(b.x)], 1u);
    return b;
}
__device__ __forceinline__ void xcd_barrier_complete(unsigned* bar, unsigned x, unsigned& nloc, unsigned& nx) {
    const unsigned G = gridDim.x * gridDim.y * gridDim.z;
    unsigned sum, cnt, mine, sp = 0u;
    for (;;) {
        sum = 0u; cnt = 0u; mine = 0u;
#pragma unroll
        for (unsigned j = 0; j < 16; ++j) { const unsigned c = xb_ld(&bar[XB_XCNT(j)]); sum += c; cnt += (c > 0u) ? 1u : 0u; mine = (j == x) ? c : mine; }
        if (sum == G) break;
        __builtin_amdgcn_s_sleep(1);
        if ((++sp & 255u) == 0u) { if (xb_ld(&bar[XB_TMO])) break; if (sp > XB_SPIN_CAP) { atomicAdd(&bar[XB_TMO], 1u); break; } }
    }
    nloc = mine > 0u ? mine : 1u; nx = cnt > 0u ? cnt : 1u;
}

__device__ __forceinline__ void xcd_barrier(const XcdBarrier& b) {
    asm volatile("s_waitcnt vmcnt(0)" ::: "memory");
    __syncthreads();
    if (threadIdx.x == 0) {
        unsigned* bar = b.bar;
        __builtin_amdgcn_s_waitcnt(0);
        unsigned nloc = b.st[0], nx = b.st[1];
        if (nloc == 0u) { xcd_barrier_complete(bar, b.x, nloc, nx); b.st[0] = nloc; b.st[1] = nx; }
        const unsigned old = xb_add(&bar[XB_XSUB(b.x)], 1u);
        const unsigned gen = old / nloc;
        if (old + 1u == (gen + 1u) * nloc) {
            __builtin_amdgcn_fence(__ATOMIC_RELEASE, "agent");
            asm volatile("s_waitcnt vmcnt(0)" ::: "memory");
            const unsigned og = xb_add(&bar[XB_TOP], 1u);
            const unsigned tg = og / nx;
            if (og + 1u == (tg + 1u) * nx) xb_add(&bar[XB_TOPGEN], 1u);
            else XB_SPIN(xb_ld(&bar[XB_TOPGEN]) == tg, bar);
            __builtin_amdgcn_fence(__ATOMIC_ACQUIRE, "agent");
            xb_add(&bar[XB_XGEN(b.x)], 1u);
            asm volatile("s_waitcnt vmcnt(0)" ::: "memory");
        } else {
            XB_SPIN(xb_ld(&bar[XB_XGEN(b.x)]) == gen, bar);
            __builtin_amdgcn_fence(__ATOMIC_ACQUIRE, "agent");
            asm volatile("s_waitcnt vmcnt(0)" ::: "memory");
        }
    }
    __syncthreads();
}
struct Frame {
    LAS unsigned char* lds; volatile LAS unsigned* MISC; gu32* ctl;
    int tid, lane, wave, vcu, G;
    const float *x, *n1g, *w_in, *gq, *gk, *lbt, *hgn, *w_br, *w_out, *n2g, *w_gate, *w_up, *w_dn; float* out;
    bf16 *WIN, *WBR, *WOUT, *WGU, *WDN, *XN, *Q, *K, *V, *HQ, *HI, *HGG, *GS, *GH, *MIXED, *STASH, *ACT; float* LOGF;
};
__device__ __forceinline__ float wave_sum(float v) {
#pragma unroll
    for (int o = 1; o < 64; o <<= 1) v += __shfl_xor(v, o);
    return v;
}
__device__ __forceinline__ float bf2f(unsigned short h) { return __uint_as_float((unsigned)h << 16); }
__device__ __forceinline__ void p0_transpose_item(const float* W, int Nsrc, int ns, bf16* WT, int ldd, int nd, int k0, LAS float* scr, int lane, const float* kscale = nullptr) {
    { float wv[32];
#pragma unroll
      for (int i = 0; i < 32; ++i) { const int kk = 2 * i + (lane >> 5); wv[i] = __builtin_nontemporal_load(W + (size_t)(k0 + kk) * Nsrc + ns + (lane & 31)); }
      if (kscale) {
#pragma unroll
          for (int i = 0; i < 32; ++i) wv[i] *= kscale[k0 + 2 * i + (lane >> 5)]; }
#pragma unroll
      for (int i = 0; i < 32; ++i) { const int kk = 2 * i + (lane >> 5); scr[kk * 33 + (lane & 31)] = wv[i]; } }
    LDS_WAIT(); asm volatile("" ::: "memory");
    const int c = lane & 7;
#pragma unroll
    for (int j = 0; j < 4; ++j) { const int n = (lane >> 3) + 8 * j; const LAS float* s = scr + (8 * c) * 33 + n;
        v4u o; o.x = pk2(s[0 * 33], s[1 * 33]); o.y = pk2(s[2 * 33], s[3 * 33]); o.z = pk2(s[4 * 33], s[5 * 33]); o.w = pk2(s[6 * 33], s[7 * 33]);
        *(GAS v4u*)(WT + (size_t)(nd + n) * ldd + k0 + 8 * c) = o; }
    LDS_WAIT(); asm volatile("" ::: "memory");
}
template <int PART> __device__ __forceinline__ void p0_prologue(Frame& F) {
    LAS float* scr = (LAS float*)(F.lds + RING_OFF + F.wave * 16384);
    const int gw = PART == 0 ? F.vcu * NWAVES + F.wave : (((int)blockIdx.x >> 4) * 8 + ((int)blockIdx.x & 7)) * NWAVES + F.wave, NGW = PART == 0 ? F.G * NWAVES : (F.G / 2) * NWAVES;
    constexpr int I_IN = 16 * 176, I_BR = 16 * 32, I_OUT = 16 * 32, I_G = 16 * 88, I_U = 16 * 88, I_DN = 44 * 32;
    constexpr int NITEMS = I_IN + I_BR + I_OUT + I_G + I_U + I_DN;
    for (int it = (PART == 0 ? gw : I_IN + gw); it < (PART == 0 ? I_IN : NITEMS); it += NGW) {
        int r = it;
        if (r < I_IN) { const int kb = r / 176, nb = r % 176; int sb = nb;
            if (nb < 32) { const int pn = nb >> 3, rem = nb & 7, bj = rem >> 2, wc = rem & 3; sb = 8 * pn + 2 * wc + bj; }
            p0_transpose_item(F.w_in, NIN, 32 * sb, F.WIN, D, 32 * nb, 64 * kb, scr, F.lane); continue; } r -= I_IN;
        if (r < I_BR) { p0_transpose_item(F.w_br, D, 32 * (r % 32), F.WBR, D, 32 * (r % 32), 64 * (r / 32), scr, F.lane); continue; } r -= I_BR;
        if (r < I_OUT) { p0_transpose_item(F.w_out, D, 32 * (r % 32), F.WOUT, D, 32 * (r % 32), 64 * (r / 32), scr, F.lane); continue; } r -= I_OUT;
        if (r < I_G + I_U) { const bool up = r >= I_G; if (up) r -= I_G; const int kb = r / 88, sb = r % 88;
            p0_transpose_item(up ? F.w_up : F.w_gate, FFN, 32 * sb, F.WGU, D, 256 * (sb >> 2) + (up ? 128 : 0) + 32 * (sb & 3), 64 * kb, scr, F.lane, F.n2g); continue; } r -= I_G + I_U;
        p0_transpose_item(F.w_dn, D, 32 * (r % 32), F.WDN, FFN, 32 * (r % 32), 64 * (r / 32), scr, F.lane);
    }
    if (PART == 0) {
        const GAS f32x4* gr = (const GAS f32x4*)F.n1g + F.lane; f32x4 gv[4];
#pragma unroll
        for (int j = 0; j < 4; ++j) gv[j] = gr[64 * j];
        for (int m0 = gw * 8; m0 < M; m0 += NGW * 8) {
            f32x4 v[8][4];
#pragma unroll
            for (int r = 0; r < 8; ++r)
#pragma unroll
                for (int j = 0; j < 4; ++j) v[r][j] = __builtin_nontemporal_load((const GAS f32x4*)(F.x + (size_t)(m0 + r) * D) + F.lane + 64 * j);
#pragma unroll
            for (int r = 0; r < 8; ++r) { float s = 0.f;
#pragma unroll
                for (int j = 0; j < 4; ++j) s += (v[r][j].x * v[r][j].x + v[r][j].y * v[r][j].y) + (v[r][j].z * v[r][j].z + v[r][j].w * v[r][j].w);
                const float rs = 1.0f / sqrtf(wave_sum(s) * (1.0f / 1024.0f) + EPS);
                GAS unsigned long long* o8 = (GAS unsigned long long*)(F.XN + (size_t)(m0 + r) * D) + F.lane;
#pragma unroll
                for (int j = 0; j < 4; ++j) o8[64 * j] = (unsigned long long)pk2(v[r][j].x * rs * gv[j].x, v[r][j].y * rs * gv[j].y) | ((unsigned long long)pk2(v[r][j].z * rs * gv[j].z, v[r][j].w * rs * gv[j].w) << 32); }
        }
    }
}

namespace sba {
typedef short bf16x8 __attribute__((ext_vector_type(8)));
typedef short s16x4 __attribute__((ext_vector_type(4)));
typedef float f32x16 __attribute__((ext_vector_type(16)));
typedef unsigned u32x4 __attribute__((ext_vector_type(4)));
typedef unsigned u32x2 __attribute__((ext_vector_type(2)));
#define SBA_MFMA(a, b, c) __builtin_amdgcn_mfma_f32_32x32x16_bf16((a), (b), (c), 0, 0, 0)
__device__ __forceinline__ int crow(int r, int hi) { return (r & 3) + 8 * (r >> 2) + 4 * hi; }
__device__ __forceinline__ bf16x8 pack_step(const f32x16& x, int s) {
    u32x4 p; p.x = pg8::cvt_pk_bf16(x[8 * s], x[8 * s + 1]); p.y = pg8::cvt_pk_bf16(x[8 * s + 2], x[8 * s + 3]); p.z = pg8::cvt_pk_bf16(x[8 * s + 4], x[8 * s + 5]); p.w = pg8::cvt_pk_bf16(x[8 * s + 6], x[8 * s + 7]);
    return __builtin_bit_cast(bf16x8, p); }
typedef short v4i16_t __attribute__((ext_vector_type(4)));
__device__ __forceinline__ s16x4 vtr(LAS const unsigned char* p) { return __builtin_bit_cast(s16x4, __builtin_amdgcn_ds_read_tr16_b64_v4i16((LAS v4i16_t*)p)); }

__device__ __forceinline__ void attn_phase(Frame& F) {
    const int lane = F.lane, r32 = lane & 31, hi = lane >> 5;
    LAS unsigned char* vst = F.lds + F.wave * 4096;
    LAS const unsigned char* vp0 = vst + ((lane >> 4) & 1) * 32 + (lane & 3) * 8 + (4 * hi + ((lane & 15) >> 2)) * 64;
    float gm = fabsf(F.gq[lane]), km = fabsf(F.gk[lane]);
#pragma unroll
    for (int o = 1; o < 64; o <<= 1) { gm = fmaxf(gm, __shfl_xor(gm, o)); km = fmaxf(km, __shfl_xor(km, o)); }
    const float THR = 152.0f + 1.02f * (QSCALE * 64.0f) * gm * km;
    bf16x8 tf0, tf1;
#pragma unroll
    for (int j = 0; j < 8; ++j) { const int k0 = 8 * (j >> 2) + 4 * hi + (j & 3); tf0[j] = (k0 >= r32) ? (short)0x3F80 : (short)0; tf1[j] = (16 + k0 >= r32) ? (short)0x3F80 : (short)0; }
    const int gw = F.vcu * NWAVES + F.wave, NGW = F.G * NWAVES;
    for (int u = gw; u < BATCH * SBH * (SEQ / 32); u += NGW) {
        const int bh = u >> 7, qblk = u & 127, b = bh >> 3, h = bh & 7, t0 = qblk * 32;
        const size_t rowb = (size_t)b * SEQ;
        bf16x8 qf[4];
        { const bf16* qp = F.Q + (rowb + t0 + r32) * SBW + h * 64 + 8 * hi;
#pragma unroll
          for (int d0 = 0; d0 < 4; ++d0) qf[d0] = *(const GAS bf16x8*)(qp + 16 * d0); }
        const bf16* kbase = F.K + rowb * SBW + h * 64 + 8 * hi; const bf16* vbase = F.V + rowb * SBW + h * 64 + (lane & 7) * 8;
        f32x16 o0, o1;
#pragma unroll
        for (int r = 0; r < 16; ++r) { o0[r] = 0.f; o1[r] = 0.f; }
        float Rc = 0.f;
        int ht = qblk; bool diag = true;
        bf16x8 kn[4]; u32x4 vn[4];
#define SBA_LOAD(HT) do { _Pragma("unroll") for (int d0 = 0; d0 < 4; ++d0) kn[d0] = *(const GAS bf16x8*)(kbase + (size_t)(32 * (HT) + r32) * SBW + 16 * d0); \
        _Pragma("unroll") for (int i = 0; i < 4; ++i) vn[i] = *(const GAS u32x4*)(vbase + (size_t)(32 * (HT) + 8 * i + (lane >> 3)) * SBW); } while (0)
        SBA_LOAD(ht);
        for (;;) {
#pragma unroll
            for (int i = 0; i < 4; ++i) { const int key = 8 * i + (lane >> 3), ch = lane & 7; *(LAS u32x4*)(vst + (ch >> 2) * 2048 + (key >> 4) * 1024 + (key & 15) * 64 + (ch & 3) * 16) = vn[i]; }
            bf16x8 kc[4];
#pragma unroll
            for (int d0 = 0; d0 < 4; ++d0) kc[d0] = kn[d0];
            if (ht > 0) SBA_LOAD(ht - 1);
            f32x16 z;
#pragma unroll
            for (int r = 0; r < 16; ++r) z[r] = 0.f;
#pragma unroll
            for (int d0 = 0; d0 < 4; ++d0) z = SBA_MFMA(kc[d0], qf[d0], z);
            f32x16 s;
#pragma unroll
            for (int r = 0; r < 16; ++r) s[r] = __builtin_amdgcn_exp2f(z[r]);
            s = s + 1.0f;
#pragma unroll
            for (int r = 0; r < 16; ++r) s[r] = __builtin_amdgcn_logf(s[r]);
            if (diag) {
#pragma unroll
                for (int r = 0; r < 16; ++r) if (crow(r, hi) >= r32) s[r] = 0.f; }
            const bf16x8 x0 = pack_step(s, 0), x1 = pack_step(s, 1);
            f32x16 c;
#pragma unroll
            for (int r = 0; r < 16; ++r) c[r] = Rc;
            c = SBA_MFMA(tf0, x0, c); c = SBA_MFMA(tf1, x1, c);
            z = z - c;
#pragma unroll
            for (int r = 0; r < 16; ++r) z[r] = __builtin_amdgcn_exp2f(z[r]);
            if (diag) {
#pragma unroll
                for (int r = 0; r < 16; ++r) if (crow(r, hi) >= r32) z[r] = 0.f; }
            const bf16x8 w0 = pack_step(z, 0), w1 = pack_step(z, 1);
            { const s16x4 l00 = vtr(vp0), h00 = vtr(vp0 + 512), l01 = vtr(vp0 + 1024), h01 = vtr(vp0 + 1536), l10 = vtr(vp0 + 2048), h10 = vtr(vp0 + 2560), l11 = vtr(vp0 + 3072), h11 = vtr(vp0 + 3584);
#define SBA_VF(l, h) (bf16x8){l[0], l[1], l[2], l[3], h[0], h[1], h[2], h[3]}
              o0 = SBA_MFMA(SBA_VF(l00, h00), w0, o0); o0 = SBA_MFMA(SBA_VF(l01, h01), w1, o0);
              o1 = SBA_MFMA(SBA_VF(l10, h10), w0, o1); o1 = SBA_MFMA(SBA_VF(l11, h11), w1, o1);
#undef SBA_VF
            }
            Rc = __shfl(c[0], r32);
            if (ht == 0) break;
            if (__all(Rc >= THR)) break;
            --ht; diag = false;
        }
#undef SBA_LOAD
        bf16* op = F.XN + (rowb + t0 + r32) * D + h * 64 + 4 * hi;
#pragma unroll
        for (int g = 0; g < 4; ++g) {
            u32x2 a, c; a.x = pg8::cvt_pk_bf16(o0[4 * g], o0[4 * g + 1]); a.y = pg8::cvt_pk_bf16(o0[4 * g + 2], o0[4 * g + 3]); c.x = pg8::cvt_pk_bf16(o1[4 * g], o1[4 * g + 1]); c.y = pg8::cvt_pk_bf16(o1[4 * g + 2], o1[4 * g + 3]);
            *(GAS u32x2*)(op + 8 * g) = a; *(GAS u32x2*)(op + 32 + 8 * g) = c; }
    }
}
#undef SBA_MFMA
}

namespace hg {
typedef short bf16x8 __attribute__((ext_vector_type(8)));
typedef short s16x4 __attribute__((ext_vector_type(4)));
typedef float f32x16 __attribute__((ext_vector_type(16)));
typedef unsigned u32x4 __attribute__((ext_vector_type(4)));
typedef unsigned u32x2 __attribute__((ext_vector_type(2)));
#define HG_MFMA(a, b, c) __builtin_amdgcn_mfma_f32_32x32x16_bf16((a), (b), (c), 0, 0, 0)
constexpr float LOG2E = 1.4426950408889634f;
__device__ __forceinline__ int imgoff(int row, int ch) { return 256 * row + 16 * (ch ^ (((row & 3) << 2) | ((row >> 2) & 3))); }
__device__ __forceinline__ int crow(int r, int hi) { return (r & 3) + 8 * (r >> 2) + 4 * hi; }
__device__ __forceinline__ s16x4 vtr(LAS const unsigned char* p) { return __builtin_bit_cast(s16x4, __builtin_amdgcn_ds_read_tr16_b64_v4i16((LAS sba::v4i16_t*)p)); }
__device__ __forceinline__ bf16x8 cat8(s16x4 lo, s16x4 hh) { return (bf16x8){lo[0], lo[1], lo[2], lo[3], hh[0], hh[1], hh[2], hh[3]}; }
__device__ __forceinline__ bf16x8 trfrag(LAS const unsigned char* img, int r0, int r1, int c, int lane) {
    const int blk = (lane >> 4) & 1, q = (lane & 15) >> 2, p = lane & 3, ch = 4 * c + 2 * blk + (p >> 1), by = 8 * (p & 1);
    return cat8(vtr(img + imgoff(r0 + q, ch) + by), vtr(img + imgoff(r1 + q, ch) + by));
}
__device__ __forceinline__ bf16x8 rowfrag(LAS const unsigned char* img, int row, int ch) { return *(const LAS bf16x8*)(img + imgoff(row, ch)); }
__device__ __forceinline__ u32x2 pack4(float a, float b, float c, float d) { u32x2 w; w.x = pg8::cvt_pk_bf16(a, b); w.y = pg8::cvt_pk_bf16(c, d); return w; }
__device__ __forceinline__ f32x4 unpack4(u32x2 w) { return (f32x4){__uint_as_float(w.x << 16), __uint_as_float(w.x & 0xffff0000u), __uint_as_float(w.y << 16), __uint_as_float(w.y & 0xffff0000u)}; }
__device__ __forceinline__ bf16x8 pack_step(const f32x16& x, int s) { return sba::pack_step(x, s); }
__device__ __forceinline__ f32x4 vexp2(const f32x4 x) { return (f32x4){__builtin_amdgcn_exp2f(x[0]), __builtin_amdgcn_exp2f(x[1]), __builtin_amdgcn_exp2f(x[2]), __builtin_amdgcn_exp2f(x[3])}; }
__device__ __forceinline__ f32x4 vrcp(const f32x4 x) { return (f32x4){__builtin_amdgcn_rcpf(x[0]), __builtin_amdgcn_rcpf(x[1]), __builtin_amdgcn_rcpf(x[2]), __builtin_amdgcn_rcpf(x[3])}; }
__device__ __forceinline__ f32x4 vlog2(const f32x4 x) { return (f32x4){__builtin_amdgcn_logf(x[0]), __builtin_amdgcn_logf(x[1]), __builtin_amdgcn_logf(x[2]), __builtin_amdgcn_logf(x[3])}; }
__device__ __forceinline__ f32x4 vsigm(const f32x4 x) { return vrcp(vexp2(x * -1.4426950408889634f) + 1.0f); }


constexpr int NUNIT = BATCH * HGH * (SEQ / 64);
__device__ __forceinline__ f32x4 scan16(f32x4 v, int lane) {
#pragma unroll
    for (int d = 4; d < 64; d <<= 1) { f32x4 t;
#pragma unroll
        for (int j = 0; j < 4; ++j) t[j] = __shfl_up(v[j], d);
        if (lane >= d) v += t; }
    return v; }
__device__ __forceinline__ f32x4 bcast4(const f32x4 v, int src) { return (f32x4){__shfl(v[0], src), __shfl(v[1], src), __shfl(v[2], src), __shfl(v[3], src)}; }

struct HgAddr {
    int RB;
    int TB1, TB2;
    int PB1, PB2;
    int W0;
    int VB;
    int SB, SL;
};
__device__ __forceinline__ HgAddr hg_addr(int tid, int lane, int wave) {
    HgAddr A; const int r32 = lane & 31, hi = lane >> 5, blk = (lane >> 4) & 1, q = (lane & 15) >> 2, p = lane & 3, l2 = 2 * blk + (p >> 1), by = 8 * (p & 1);
    const int s = (((r32 & 3) << 2) | ((r32 >> 2) & 3));
    A.RB = 256 * r32 + 16 * (hi ^ (s & 1)) + 32 * (s >> 1);
    A.TB1 = 256 * (8 * hi + q) + 64 * q + 16 * (l2 ^ (2 * hi)) + by; A.TB2 = 256 * (8 * hi + 4 + q) + 64 * q + 16 * (l2 ^ (2 * hi + 1)) + by;
    A.PB1 = 256 * (4 * hi + q) + 64 * q + 16 * (l2 ^ hi) + by;       A.PB2 = 256 * (8 + 4 * hi + q) + 64 * q + 16 * (l2 ^ (2 + hi)) + by;
    const int kq = 4 * wave + (lane & 3), tq = lane >> 2;
    A.W0 = 1024 * tq + 16 * ((kq >> 1) ^ (tq & 3)) + 8 * (kq & 1);
    const int vr = tid >> 4; A.VB = 256 * vr + 16 * ((tid & 15) ^ (((vr & 3) << 2) | ((vr >> 2) & 3)));
    const int vb = wave & 3; A.SB = 256 * r32 + 16 * ((4 * vb) ^ (s & 12)) + 8 * hi; A.SL = s & 3;
    return A;
}
__device__ __forceinline__ bf16x8 trf(LAS const unsigned char* img, int o1, int o2) { return cat8(vtr(img + o1), vtr(img + o2)); }
__device__ __forceinline__ f32x4 gl_of(const f32x4 x, const f32x4 lb, f32x4& km) {
    const f32x4 f = lb + (1.0f - lb) * vsigm(x); km = 1.0f - f; return vlog2(f); }
constexpr int NSEG = BATCH * HGH * 8;
__device__ __forceinline__ void pass1(Frame& F, bf16* L, float* Dl) {
    const int tid = F.tid, lane = F.lane, kq = 4 * F.wave + (lane & 3), tq = lane >> 2, r32 = lane & 31, hi = lane >> 5;
    LAS unsigned char* imgK = F.lds; LAS unsigned char* imgV = F.lds + 16384; LAS float* DLS = (LAS float*)(F.lds + 40960);
    const int vb = F.wave & 3, kp = F.wave >> 2;
    const HgAddr A = hg_addr(tid, lane, F.wave);
    const int tv1 = A.TB1 ^ (64 * vb), tv2 = A.TB2 ^ (64 * vb), ta1 = A.TB1 ^ (128 * kp), ta2 = A.TB2 ^ (128 * kp), tb1 = A.TB1 ^ (128 * kp + 64), tb2 = A.TB2 ^ (128 * kp + 64);
    u32x2 gx[4]; u32x4 vv[2];
#define HG_P1_LOAD(UNIT) do { const int bh_ = (UNIT) >> 6, c_ = (UNIT) & 63, b_ = bh_ >> 2, h_ = bh_ & 3; const size_t r0_ = (size_t)b_ * SEQ + c_ * 64; \
        _Pragma("unroll") for (int i = 0; i < 4; ++i) gx[i] = *(const GAS u32x2*)((const bf16*)F.LOGF + (r0_ + 4 * tq + i) * HGW + h_ * 128 + 4 * kq); \
        _Pragma("unroll") for (int j = 0; j < 2; ++j) { const int id = tid + 512 * j; vv[j] = *(const GAS u32x4*)(F.HI + (r0_ + (id >> 4)) * HGW + h_ * 128 + 8 * (id & 15)); } } while (0)
    for (int seg = F.vcu; seg < NSEG; seg += F.G) {
        const int h = (seg >> 3) & 3, unit0 = seg * 8;
        f32x4 lb; { const f32x4 t0 = *(const GAS f32x4*)(F.lbt + h * 128 + 4 * kq), t1 = *(const GAS f32x4*)(F.lbt + 512 + h * 128 + 4 * kq);
#pragma unroll
            for (int j = 0; j < 4; ++j) lb[j] = pg8::sigm(t0[j] - t1[j]); }
        f32x16 acc0, acc1; f32x4 dsum = (f32x4){0.f, 0.f, 0.f, 0.f};
#pragma unroll
        for (int r = 0; r < 16; ++r) { acc0[r] = 0.f; acc1[r] = 0.f; }
        HG_P1_LOAD(unit0);
        for (int cc = 0; cc < 8; ++cc) {
            f32x4 g[4], km[4];
#pragma unroll
            for (int i = 0; i < 4; ++i) g[i] = gl_of(unpack4(gx[i]), lb, km[i]);
#pragma unroll
            for (int j = 0; j < 2; ++j) *(LAS u32x4*)(imgV + A.VB + 8192 * j) = vv[j];
            asm volatile("" : "+v"(g[0]), "+v"(g[1]), "+v"(g[2]), "+v"(g[3]), "+v"(km[0]), "+v"(km[1]), "+v"(km[2]), "+v"(km[3]) :: "memory");
            __builtin_amdgcn_sched_barrier(0); { const int nu = cc < 7 ? unit0 + cc + 1 : unit0 + cc; HG_P1_LOAD(nu); } __builtin_amdgcn_sched_barrier(0);
            f32x4 rs[4]; rs[3] = (f32x4){0.f, 0.f, 0.f, 0.f}; rs[2] = g[3]; rs[1] = g[3] + g[2]; rs[0] = rs[1] + g[1];
            const f32x4 tot = rs[0] + g[0];
            const f32x4 incl = scan16(tot, lane), all = bcast4(incl, 60 + (lane & 3)), suf = all - incl;
#pragma unroll
            for (int i = 0; i < 4; ++i) { const f32x4 kh = km[i] * vexp2(suf + rs[i]);
                *(LAS u32x2*)(imgK + (A.W0 ^ (64 * i)) + 256 * i) = pack4(kh[0], kh[1], kh[2], kh[3]); }
            if (tq == 0) { *(LAS f32x4*)(DLS + 4 * kq) = all; dsum += all; }
            asm volatile("s_waitcnt lgkmcnt(0)" ::: "memory"); __builtin_amdgcn_s_barrier(); asm volatile("" ::: "memory");
            { const float d0 = __builtin_amdgcn_exp2f(DLS[64 * kp + r32]), d1 = __builtin_amdgcn_exp2f(DLS[64 * kp + 32 + r32]);
#pragma unroll
              for (int r = 0; r < 16; ++r) { acc0[r] *= d0; acc1[r] *= d1; } }
#pragma unroll
            for (int ks = 0; ks < 4; ++ks) {
                const bf16x8 af = trf(imgV + 4096 * ks, tv1, tv2);
                acc0 = HG_MFMA(af, trf(imgK + 4096 * ks, ta1, ta2), acc0);
                acc1 = HG_MFMA(af, trf(imgK + 4096 * ks, tb1, tb2), acc1);
            }
            asm volatile("s_waitcnt lgkmcnt(0)" ::: "memory"); __builtin_amdgcn_s_barrier(); asm volatile("" ::: "memory");
        }
        bf16* lp = L + (size_t)seg * 16384 + 32 * vb + 4 * hi;
#pragma unroll
        for (int gq = 0; gq < 4; ++gq) {
            *(GAS u32x2*)(lp + (size_t)(64 * kp + r32) * 128 + 8 * gq) = pack4(acc0[4 * gq], acc0[4 * gq + 1], acc0[4 * gq + 2], acc0[4 * gq + 3]);
            *(GAS u32x2*)(lp + (size_t)(64 * kp + 32 + r32) * 128 + 8 * gq) = pack4(acc1[4 * gq], acc1[4 * gq + 1], acc1[4 * gq + 2], acc1[4 * gq + 3]); }
        if (tq == 0) *(GAS f32x4*)(Dl + (size_t)seg * 128 + 4 * kq) = dsum;
    }
#undef HG_P1_LOAD
}
__device__ __forceinline__ void pass3(Frame& F, const bf16* Lseg, const float* Dseg) {
    const int tid = F.tid, lane = F.lane, kq = 4 * F.wave + (lane & 3), tq = lane >> 2, r32 = lane & 31, hi = lane >> 5;
    LAS unsigned char* imgQT = F.lds; LAS unsigned char* imgKT = F.lds + 16384; LAS unsigned char* imgQH = F.lds + 32768; LAS unsigned char* imgV = F.lds + 49152; LAS unsigned char* imgS = F.lds + 65536;
    LAS unsigned char* imgKH = F.lds + 98304; LAS float* RSS = (LAS float*)(F.lds + 122880); LAS float* DLS = (LAS float*)(F.lds + 123904);
    const int tb = F.wave >> 2, vb = F.wave & 3, kp = F.wave >> 2;
    const HgAddr A = hg_addr(tid, lane, F.wave);
    const int tv1 = A.TB1 ^ (64 * vb), tv2 = A.TB2 ^ (64 * vb), ta1 = A.TB1 ^ (128 * kp), ta2 = A.TB2 ^ (128 * kp), tb1 = A.TB1 ^ (128 * kp + 64), tb2 = A.TB2 ^ (128 * kp + 64), pv1 = A.PB1 ^ (64 * vb), pv2 = A.PB2 ^ (64 * vb);
    u32x2 gx[4]; u32x2 qw[4]; u32x4 vv[2];
#define HG_P3_LOAD(UNIT) do { const int bh_ = (UNIT) >> 6, c_ = (UNIT) & 63, b_ = bh_ >> 2, h_ = bh_ & 3; const size_t r0_ = (size_t)b_ * SEQ + c_ * 64; \
        _Pragma("unroll") for (int i = 0; i < 4; ++i) { gx[i] = *(const GAS u32x2*)((const bf16*)F.LOGF + (r0_ + 4 * tq + i) * HGW + h_ * 128 + 4 * kq); qw[i] = *(const GAS u32x2*)(F.HQ + (r0_ + 4 * tq + i) * HGW + h_ * 128 + 4 * kq); } \
        _Pragma("unroll") for (int j = 0; j < 2; ++j) { const int id = tid + 512 * j; vv[j] = *(const GAS u32x4*)(F.HI + (r0_ + (id >> 4)) * HGW + h_ * 128 + 8 * (id & 15)); } } while (0)
    for (int seg = F.vcu; seg < NSEG; seg += F.G) {
        const int bh = seg >> 3, sj = seg & 7, b = bh >> 2, h = bh & 3, unit0 = seg * 8;
        HG_P3_LOAD(unit0);
        f32x4 lb; { const f32x4 t0 = *(const GAS f32x4*)(F.lbt + h * 128 + 4 * kq), t1 = *(const GAS f32x4*)(F.lbt + 512 + h * 128 + 4 * kq);
#pragma unroll
            for (int j = 0; j < 4; ++j) lb[j] = pg8::sigm(t0[j] - t1[j]); }
        f32x16 acc0, acc1;
#pragma unroll
        for (int r = 0; r < 16; ++r) { acc0[r] = 0.f; acc1[r] = 0.f; }
        if (sj > 0) {
            float d0v[7], d1v[7]; u32x2 l0v[7][4], l1v[7][4];
#pragma unroll
            for (int i = 0; i < 7; ++i) { const int sg = bh * 8 + (i < sj ? i : sj - 1);
                d0v[i] = Dseg[(size_t)sg * 128 + 64 * kp + r32]; d1v[i] = Dseg[(size_t)sg * 128 + 64 * kp + 32 + r32];
                const bf16* lp = Lseg + (size_t)sg * 16384 + 32 * vb + 4 * hi;
#pragma unroll
                for (int gq = 0; gq < 4; ++gq) { l0v[i][gq] = *(const GAS u32x2*)(lp + (size_t)(64 * kp + r32) * 128 + 8 * gq); l1v[i][gq] = *(const GAS u32x2*)(lp + (size_t)(64 * kp + 32 + r32) * 128 + 8 * gq); } }
#pragma unroll
            for (int i = 0; i < 7; ++i) { const bool on = i < sj; const float d0 = on ? __builtin_amdgcn_exp2f(d0v[i]) : 1.0f, d1 = on ? __builtin_amdgcn_exp2f(d1v[i]) : 1.0f;
#pragma unroll
                for (int gq = 0; gq < 4; ++gq) { const f32x4 l0 = unpack4(l0v[i][gq]), l1 = unpack4(l1v[i][gq]);
#pragma unroll
                    for (int j = 0; j < 4; ++j) { acc0[4 * gq + j] = acc0[4 * gq + j] * d0 + (on ? l0[j] : 0.f); acc1[4 * gq + j] = acc1[4 * gq + j] * d1 + (on ? l1[j] : 0.f); } } }
        }
        for (int cc = 0; cc < 8; ++cc) {
            const int c = sj * 8 + cc; const size_t row0 = (size_t)b * SEQ + c * 64;
            const size_t orow = row0 + 32 * tb + r32;
            u32x2 gtw[4]; f32x4 gnv[4];
#pragma unroll
            for (int gq = 0; gq < 4; ++gq) { gtw[gq] = *(const GAS u32x2*)(F.HGG + orow * HGW + h * 128 + 32 * vb + 8 * gq + 4 * hi); gnv[gq] = *(const GAS f32x4*)(F.hgn + 32 * vb + 8 * gq + 4 * hi); }
            f32x4 g[4], km[4]; f32x4 qv[4];
#pragma unroll
            for (int i = 0; i < 4; ++i) { g[i] = gl_of(unpack4(gx[i]), lb, km[i]); const f32x4 qr = unpack4(qw[i]); qv[i] = qr * vsigm(qr); }
#pragma unroll
            for (int j = 0; j < 2; ++j) *(LAS u32x4*)(imgV + A.VB + 8192 * j) = vv[j];
#pragma unroll
            for (int gq = 0; gq < 4; ++gq) { const int so = 16384 * kp + A.SB + 16 * (gq ^ A.SL);
                *(LAS u32x2*)(imgS + so) = pack4(acc0[4 * gq], acc0[4 * gq + 1], acc0[4 * gq + 2], acc0[4 * gq + 3]);
                *(LAS u32x2*)(imgS + so + 8192) = pack4(acc1[4 * gq], acc1[4 * gq + 1], acc1[4 * gq + 2], acc1[4 * gq + 3]); }
            asm volatile("" : "+v"(g[0]), "+v"(g[1]), "+v"(g[2]), "+v"(g[3]), "+v"(qv[0]), "+v"(qv[1]), "+v"(qv[2]), "+v"(qv[3]), "+v"(km[0]), "+v"(km[1]), "+v"(km[2]), "+v"(km[3]) :: "memory");
            __builtin_amdgcn_sched_barrier(0); { const int nu = cc < 7 ? unit0 + cc + 1 : unit0 + cc; HG_P3_LOAD(nu); } __builtin_amdgcn_sched_barrier(0);
            const f32x4 tot = (g[0] + g[1]) + (g[2] + g[3]), incl = scan16(tot, lane), all = bcast4(incl, 60 + (lane & 3)), ref = bcast4(incl, 28 + (lane & 3));
            f32x4 pre = incl - tot;
            const f32x4 c1 = vexp2(ref), c2 = vexp2(all - ref);
#pragma unroll
            for (int i = 0; i < 4; ++i) { pre += g[i];
                const f32x4 dq = pre - ref, qt = qv[i] * vexp2(dq), kt = km[i] * vexp2(-dq), qh = qt * c1, kh = kt * c2;
                const int o = (A.W0 ^ (64 * i)) + 256 * i;
                *(LAS u32x2*)(imgQT + o) = pack4(qt[0], qt[1], qt[2], qt[3]); *(LAS u32x2*)(imgKT + o) = pack4(kt[0], kt[1], kt[2], kt[3]); *(LAS u32x2*)(imgQH + o) = pack4(qh[0], qh[1], qh[2], qh[3]);
                *(LAS u32x2*)(imgKH + o) = pack4(kh[0], kh[1], kh[2], kh[3]); }
            if (tq == 0) *(LAS f32x4*)(DLS + 4 * kq) = all;
            asm volatile("s_waitcnt lgkmcnt(0)" ::: "memory"); __builtin_amdgcn_s_barrier(); asm volatile("" ::: "memory");
            int X[8];
#pragma unroll
            for (int ks = 0; ks < 8; ++ks) X[ks] = A.RB ^ (32 * ks);
            f32x16 o;
#pragma unroll
            for (int r = 0; r < 16; ++r) o[r] = 0.f;
#pragma unroll
            for (int k4 = 0; k4 < 8; k4 += 4) { bf16x8 sa[4], qb[4];
#pragma unroll
              for (int ks = 0; ks < 4; ++ks) { sa[ks] = trf(imgS + 4096 * (k4 + ks), tv1, tv2); qb[ks] = *(const LAS bf16x8*)(imgQH + 8192 * tb + X[k4 + ks]); }
#pragma unroll
              for (int ks = 0; ks < 4; ++ks) o = HG_MFMA(sa[ks], qb[ks], o); }
#pragma unroll
            for (int sb = 0; sb < 2; ++sb) {
                if (sb <= tb) {
                    f32x16 at;
#pragma unroll
                    for (int r = 0; r < 16; ++r) at[r] = 0.f;
#pragma unroll
                    for (int k4 = 0; k4 < 8; k4 += 4) { bf16x8 ka[4], qa[4];
#pragma unroll
                      for (int ks = 0; ks < 4; ++ks) { ka[ks] = *(const LAS bf16x8*)(imgKT + 8192 * sb + X[k4 + ks]); qa[ks] = *(const LAS bf16x8*)(imgQT + 8192 * tb + X[k4 + ks]); }
#pragma unroll
                      for (int ks = 0; ks < 4; ++ks) at = HG_MFMA(ka[ks], qa[ks], at); }
                    if (sb == tb) {
#pragma unroll
                        for (int r = 0; r < 16; ++r) if (crow(r, hi) > r32) at[r] = 0.f; }
#pragma unroll
                    for (int st = 0; st < 2; ++st) o = HG_MFMA(trf(imgV + 8192 * sb + 4096 * st, pv1, pv2), pack_step(at, st), o);
                }
            }
            { const float d0 = __builtin_amdgcn_exp2f(DLS[64 * kp + r32]), d1 = __builtin_amdgcn_exp2f(DLS[64 * kp + 32 + r32]);
#pragma unroll
              for (int r = 0; r < 16; ++r) { acc0[r] *= d0; acc1[r] *= d1; } }
#pragma unroll
            for (int ks = 0; ks < 4; ++ks) {
                const bf16x8 af = trf(imgV + 4096 * ks, tv1, tv2);
                acc0 = HG_MFMA(af, trf(imgKH + 4096 * ks, ta1, ta2), acc0);
                acc1 = HG_MFMA(af, trf(imgKH + 4096 * ks, tb1, tb2), acc1);
            }
            float ss = 0.f;
#pragma unroll
            for (int r = 0; r < 16; ++r) ss += o[r] * o[r];
            ss += __shfl_xor(ss, 32);
            if (hi == 0) RSS[(32 * tb + r32) * 4 + vb] = ss;
            asm volatile("s_waitcnt lgkmcnt(0)" ::: "memory"); __builtin_amdgcn_s_barrier(); asm volatile("" ::: "memory");
            const f32x4 pr = *(const LAS f32x4*)(RSS + (32 * tb + r32) * 4);
            const float rn = 1.0f / sqrtf(((pr[0] + pr[1]) + (pr[2] + pr[3])) * (1.0f / 128.0f) + EPS);
#pragma unroll
            for (int gq = 0; gq < 4; ++gq) { const int v = 32 * vb + 8 * gq + 4 * hi;
                const f32x4 gr = unpack4(gtw[gq]), sc = (gnv[gq] * rn) * (gr * vsigm(gr));
                *(GAS u32x2*)(F.XN + orow * D + 512 + h * 128 + v) = pack4(o[4 * gq] * sc[0], o[4 * gq + 1] * sc[1], o[4 * gq + 2] * sc[2], o[4 * gq + 3] * sc[3]); }
            asm volatile("s_waitcnt lgkmcnt(0)" ::: "memory"); __builtin_amdgcn_s_barrier(); asm volatile("" ::: "memory");
        }
    }
#undef HG_P3_LOAD
}
#undef HG_MFMA
}

struct Args { const float* in[13]; float* out; unsigned char* ws; int ph_lo, ph_hi; };
__global__ void __launch_bounds__(NWAVES * 64, 2) skel_fwd(Args args) {
    extern __shared__ __attribute__((aligned(16))) unsigned char lds[];
    Frame F;
    F.lds = (LAS unsigned char*)lds; F.MISC = (volatile LAS unsigned*)(F.lds + MISC_OFF);
    F.tid = threadIdx.x; F.lane = F.tid & 63; F.wave = __builtin_amdgcn_readfirstlane(F.tid >> 6);
    F.G = gridDim.x; { const int bx = blockIdx.x; F.vcu = (F.G % 8 == 0) ? (bx % 8) * (F.G / 8) + bx / 8 : bx; }
    unsigned char* ws = args.ws;
    F.ctl = (gu32*)(ws + WS_CTL);
    F.x = args.in[0]; F.n1g = args.in[1]; F.w_in = args.in[2]; F.gq = args.in[3]; F.gk = args.in[4]; F.lbt = args.in[5]; F.hgn = args.in[6]; F.w_br = args.in[7]; F.w_out = args.in[8];
    F.n2g = args.in[9]; F.w_gate = args.in[10]; F.w_up = args.in[11]; F.w_dn = args.in[12]; F.out = args.out;
    F.WIN = (bf16*)(ws + WS_WIN); F.WBR = (bf16*)(ws + WS_WBR); F.WOUT = (bf16*)(ws + WS_WOUT); F.WGU = (bf16*)(ws + WS_WGU); F.WDN = (bf16*)(ws + WS_WDN);
    F.XN = (bf16*)(ws + WS_XN); F.Q = (bf16*)(ws + WS_Q); F.K = (bf16*)(ws + WS_K); F.V = (bf16*)(ws + WS_V); F.HQ = (bf16*)(ws + WS_HQ); F.LOGF = (float*)(ws + WS_LOGF);
    F.HI = (bf16*)(ws + WS_HI); F.HGG = (bf16*)(ws + WS_HGG); F.GS = (bf16*)(ws + WS_GS); F.GH = (bf16*)(ws + WS_GH); F.MIXED = (bf16*)(ws + WS_MIXED); F.STASH = (bf16*)(ws + WS_STASH); F.ACT = (bf16*)(ws + WS_ACT);
    for (int u = F.tid; u < (LDS_BYTES - LDSCTL_OFF) / 4; u += NWAVES * 64) ((LAS unsigned*)(F.lds + LDSCTL_OFF))[u] = 0u;
    __syncthreads();
    XcdBarrier bar; bar.bar = (unsigned*)(F.ctl + CW_BAR); bar.x = 0; bar.st = nullptr;
    if (MK_ONE_LAUNCH) bar = xcd_barrier_post((unsigned*)(F.ctl + CW_BAR), F.MISC + 8);
    const int lo = args.ph_lo, hi = args.ph_hi;
#define IN(k) (lo <= (k) && (k) < hi)
#define SEAM(k) do { if (IN(k) && IN((k) + 1)) xcd_barrier(bar); } while (0)

    if (IN(0)) { p0_prologue<0>(F); } SEAM(0);
    if (IN(1)) {
        if (((int)blockIdx.x >> 3) & 1) { p0_prologue<1>(F); asm volatile("s_waitcnt vmcnt(0) lgkmcnt(0)" ::: "memory"); } __syncthreads();
        pg8::Gemm g{F.XN, F.WIN, M, NIN, D, D, D}; pg8::StaticOrder S; S.init(M, NIN, F.G, (int)blockIdx.x);
        pg8::EpiProj E{F.Q, F.K, F.V, F.HQ, F.HI, F.HGG, F.GS, F.GH, F.LOGF, F.gq, F.gk, F.lbt, QSCALE, EPS};
        pg8::gemm_phase<pg8::EpiProj, pg8::StaticOrder, true, true>(F.lds + RING_OFF, g, S, E);
    } SEAM(1);
    bf16* HL = (bf16*)F.out; float* HDl = (float*)((unsigned char*)F.out + 64 * MiB);
    if (IN(2)) { hg::pass1(F, HL, HDl); __syncthreads(); sba::attn_phase(F); } SEAM(2);
    if (IN(3)) { hg::pass3(F, HL, HDl); } SEAM(3);
    if (IN(4)) {
        pg8::Gemm g{F.XN, F.WBR, M, D, D, D, D}; pg8::StaticOrder S; S.init(M, D, F.G, (int)blockIdx.x);
        pg8::EpiGateK E{(const unsigned char*)F.GS, (const unsigned char*)F.GH, F.MIXED};
        pg8::gemm_phase<pg8::EpiGateK, pg8::StaticOrder, true, true>(F.lds + RING_OFF, g, S, E);
    } SEAM(4);
    float* rowss = (float*)(ws + WS_CTL + 524288);
    if (IN(5)) {
        pg8::Gemm g{F.MIXED, F.WOUT, M, D, D, D, D}; pg8::StaticOrder S; S.init(M, D, F.G, (int)blockIdx.x);
        pg8::EpiResSq E{F.x, F.XN, rowss};
        pg8::gemm_phase<pg8::EpiResSq, pg8::StaticOrder, true, true>(F.lds + RING_OFF, g, S, E);
    } SEAM(5);
    if (IN(6)) {
        pg8::Gemm g{F.XN, F.WGU, M, NIN, D, D, D}; pg8::StaticOrder S; S.init(M, NIN, F.G, (int)blockIdx.x);
        pg8::EpiSwiglu E{F.ACT, FFN, rowss, EPS};
        pg8::gemm_phase<pg8::EpiSwiglu, pg8::StaticOrder, true, true>(F.lds + RING_OFF, g, S, E);
    } SEAM(6);
    if (IN(7)) {
        pg8::Gemm g{F.ACT, F.WDN, M, D, FFN, FFN, FFN}; pg8::StaticOrder S; S.init(M, D, F.G, (int)blockIdx.x);
        pg8::EpiResHn E{F.XN, F.out};
        pg8::gemm_phase<pg8::EpiResHn, pg8::StaticOrder, true, true>(F.lds + RING_OFF, g, S, E);
    }
#undef IN
#undef SEAM
}

extern "C" void kernel_launch(void* const* d_in, const int* in_sizes, int n_in, void* d_out, int out_size, void* d_ws, size_t ws_size, hipStream_t stream) {
    static int grid = 0;
    if (grid == 0) {
        if (n_in != 13 || in_sizes[0] != M * D || out_size != M * D || ws_size < WS_END) { fprintf(stderr, "kernel_launch: unexpected shapes / workspace (n_in %d, ws %zu); nothing launched\n", n_in, ws_size); grid = -1; return; }
        int dev = 0, cus = 0;
        if (hipGetDevice(&dev) != hipSuccess || hipDeviceGetAttribute(&cus, hipDeviceAttributeMultiprocessorCount, dev) != hipSuccess) { grid = -1; return; }
        if (hipFuncSetAttribute((const void*)skel_fwd, hipFuncAttributeMaxDynamicSharedMemorySize, LDS_BYTES) != hipSuccess) { grid = -1; return; }
        int per_cu = 0;
        if (hipOccupancyMaxActiveBlocksPerMultiprocessor(&per_cu, (const void*)skel_fwd, NWAVES * 64, LDS_BYTES) != hipSuccess || per_cu < 1) { fprintf(stderr, "kernel_launch: occupancy query says %d\n", per_cu); }
        (void)hipGetLastError();
        grid = cus;
    }
    if (grid < 0) return;
    (void)hipMemsetAsync((char*)d_ws + WS_CTL, 0, CTL_ZERO_BYTES, stream);
    Args a{};
    for (int i = 0; i < 13; ++i) a.in[i] = (const float*)d_in[i];
    a.out = (float*)d_out; a.ws = (unsigned char*)d_ws;
    if (MK_ONE_LAUNCH) { a.ph_lo = 0; a.ph_hi = N_PHASES; hipLaunchKernelGGL(skel_fwd, dim3(grid), dim3(NWAVES * 64), LDS_BYTES, stream, a); }
    else for (int p = 0; p < N_PHASES; ++p) { a.ph_lo = p; a.ph_hi = p + 1; hipLaunchKernelGGL(skel_fwd, dim3(grid), dim3(NWAVES * 64), LDS_BYTES, stream, a); }
}
```
